# Optimizing an MI355X kernel written in HIP

```python
import math
import jax
import jax.numpy as jnp
from jax import lax
import numpy as np

D_MODEL = 1024
BATCH = 32
SEQ = 256
DEPTH = 2
DEC_BATCH = 2
DEC_SEQ = 1024
PAST_LEN = 512

GRID_W = 64
N_BRANCH = 4
BRANCH_W = D_MODEL // N_BRANCH
N_HEADS = 4
GLA_DK = BRANCH_W // (2 * N_HEADS)
GLA_DV = BRANCH_W // N_HEADS
GLA_KW = N_HEADS * GLA_DK
GLA_LOWRANK = 16
GLA_TAU = 16.0
DN_DK = BRANCH_W // N_HEADS
DN_DV = BRANCH_W // N_HEADS
DN_CONV = 3
HG_DK = BRANCH_W // N_HEADS
HG_DV = BRANCH_W // N_HEADS
HG_W = N_HEADS * HG_DK
DF_DH = BRANCH_W // (2 * N_HEADS)
ROPE_BASE = 10000.0
D_FF = ((8 * D_MODEL // 3 + 255) // 256) * 256
N_MOD = 9
CHUNK = 64
Q_BLOCK = 128
EPS = 1e-6
IN_SIZES = (GLA_KW, GLA_KW, BRANCH_W, BRANCH_W, 2 * GLA_LOWRANK,
            3 * BRANCH_W, 2 * N_HEADS, 2 * N_HEADS, BRANCH_W,
            HG_W, 2 * HG_W, BRANCH_W, BRANCH_W,
            BRANCH_W, BRANCH_W, BRANCH_W)
N_IN = sum(IN_SIZES)

kernel_name = 'hybrid_diffusion_prefix_step'


def rms_norm(x, w):
    xf = x.astype(jnp.float32)
    y = xf * lax.rsqrt(jnp.mean(xf * xf, axis=-1, keepdims=True) + EPS)
    return (y * w.astype(jnp.float32)).astype(x.dtype)


def l2norm(x):
    xf = x.astype(jnp.float32)
    return xf * lax.rsqrt(jnp.sum(xf * xf, axis=-1, keepdims=True) + EPS)


def split_cols(a, sizes):
    out, start = [], 0
    for s in sizes:
        out.append(a[..., start:start + s])
        start += s
    return out


def split_heads(a):
    b, t, _ = a.shape
    return a.reshape(b, t, N_HEADS, -1).transpose(0, 2, 1, 3)


def merge_heads(a):
    b, h, t, d = a.shape
    return a.transpose(0, 2, 1, 3).reshape(b, t, h * d)


def flip_t(a):
    return jnp.flip(a, axis=2)


def gated_head_norm(o, w, gate):
    return merge_heads(rms_norm(o, w)) * jax.nn.silu(gate)


def to_chunks(a):
    b, h, t = a.shape[:3]
    return jnp.moveaxis(a.reshape(b, h, t // CHUNK, CHUNK, *a.shape[3:]), 2, 0)


def from_chunks(o):
    n, b, h, c, d = o.shape
    return jnp.moveaxis(o, 0, 2).reshape(b, h, n * c, d)


def gla_chunk_scan(q, k, v, g, s0):
    f32 = jnp.float32
    mask = jnp.tril(jnp.ones((CHUNK, CHUNK), bool))[:, :, None]

    def step(s, inp):
        qc, kc, vc, gc = [a.astype(f32) for a in inp]
        b = jnp.cumsum(gc, axis=-2)
        rel = b[..., :, None, :] - b[..., None, :, :]
        dec = jnp.exp(jnp.where(mask, rel, -jnp.inf))
        attn = jnp.einsum('bhid,bhjd,bhijd->bhij', qc, kc, dec)
        o = jnp.einsum('bhid,bhde->bhie', qc * jnp.exp(b), s) + jnp.einsum('bhij,bhje->bhie', attn, vc)
        b_last = b[..., -1:, :]
        s_new = s * jnp.exp(b[..., -1, :])[..., None] + jnp.einsum('bhjd,bhje->bhde', kc * jnp.exp(b_last - b), vc)
        return s_new, o

    s_fin, o = lax.scan(step, s0.astype(f32), (to_chunks(q), to_chunks(k), to_chunks(v), to_chunks(g)))
    return from_chunks(o).astype(v.dtype), s_fin


def delta_chunk_scan(q, k, v, beta, g, s0):
    f32 = jnp.float32
    dv = v.shape[-1]
    strict = jnp.tril(jnp.ones((CHUNK, CHUNK), bool), -1)
    incl = jnp.tril(jnp.ones((CHUNK, CHUNK), bool))
    eye = jnp.eye(CHUNK, dtype=f32)

    def step(s, inp):
        qc, kc, vc, bc, gc = [a.astype(f32) for a in inp]
        d = jnp.cumsum(gc, axis=-1)
        rel = d[..., :, None] - d[..., None, :]
        dec_s = jnp.exp(jnp.where(strict, rel, -jnp.inf))
        dec_i = jnp.exp(jnp.where(incl, rel, -jnp.inf))
        a_mat = eye + bc[..., :, None] * jnp.einsum('bhid,bhjd->bhij', kc, kc) * dec_s
        rhs = jnp.concatenate([vc * bc[..., None], kc * (bc * jnp.exp(d))[..., None]], axis=-1)
        sol = lax.linalg.triangular_solve(a_mat, rhs, left_side=True, lower=True)
        u, w = sol[..., :dv], sol[..., dv:]
        v_new = u - jnp.einsum('bhid,bhde->bhie', w, s)
        qk = jnp.einsum('bhid,bhjd->bhij', qc, kc) * dec_i
        o = jnp.einsum('bhid,bhde->bhie', qc * jnp.exp(d)[..., None], s) + jnp.einsum('bhij,bhje->bhie', qk, v_new)
        d_last = d[..., -1:]
        s_new = s * jnp.exp(d_last)[..., None] + jnp.einsum('bhjd,bhje->bhde', kc * jnp.exp(d_last - d)[..., None], v_new)
        return s_new, o

    s_fin, o = lax.scan(step, s0.astype(f32), (to_chunks(q), to_chunks(k), to_chunks(v), to_chunks(beta), to_chunks(g)))
    return from_chunks(o).astype(v.dtype), s_fin


def centred_dwconv(x, w):
    pad = w.shape[0] // 2
    return lax.conv_general_dilated(x, w[:, None, :].astype(x.dtype), window_strides=(1,),
                                    padding=((pad, pad),), dimension_numbers=('NWC', 'WIO', 'NWC'),
                                    feature_group_count=x.shape[-1])


def axial_rope_tables(t_len, dh):
    f32 = jnp.float32
    rows = t_len // GRID_W
    row = jnp.repeat(jnp.arange(rows), GRID_W).astype(f32)
    col = jnp.tile(jnp.arange(GRID_W), rows).astype(f32)
    half = dh // 2
    inv = ROPE_BASE ** (-jnp.arange(0, half, 2, dtype=f32) / half)
    def angles(pos):
        a = pos[:, None] * inv[None, :]
        return jnp.concatenate([a, a], axis=-1)
    ang = jnp.concatenate([angles(row), angles(col)], axis=-1)
    return jnp.cos(ang), jnp.sin(ang)


def apply_axial_rope(x, cos, sin):
    half = x.shape[-1] // 2
    qt = half // 2
    rot = lambda a: jnp.concatenate([-a[..., qt:], a[..., :qt]], axis=-1)
    xrot = jnp.concatenate([rot(x[..., :half]), rot(x[..., half:])], axis=-1)
    return (x.astype(jnp.float32) * cos + xrot.astype(jnp.float32) * sin).astype(x.dtype)


def diff_attention(q1, q2, k1, k2, v, lam):
    b, h, tq, dh = q1.shape
    nb = tq // Q_BLOCK
    scale = dh ** -0.5
    blk = lambda a: jnp.moveaxis(a.reshape(b, h, nb, Q_BLOCK, dh), 2, 0)

    def one(qs):
        qb1, qb2 = qs
        p1 = jax.nn.softmax(jnp.einsum('bhqd,bhkd->bhqk', qb1, k1).astype(jnp.float32) * scale, axis=-1)
        p2 = jax.nn.softmax(jnp.einsum('bhqd,bhkd->bhqk', qb2, k2).astype(jnp.float32) * scale, axis=-1)
        a = (p1 - lam * p2).astype(v.dtype)
        return jnp.einsum('bhqk,bhke->bhqe', a, v)

    o = lax.map(one, (blk(q1), blk(q2)))
    return jnp.moveaxis(o, 0, 2).reshape(b, h, tq, 2 * dh)


def token_mixers(xn, p, ctx, rope):
    f32 = jnp.float32
    bsz, t_len, _ = xn.shape
    (ga_q, ga_k, ga_v, ga_r, ga_lr, dn_x, dn_b, dn_a, dn_g,
     hg_q, hg_f, hg_i, hg_g, df_q, df_k, df_v) = split_cols(xn @ p['w_in'], IN_SIZES)
    if ctx is None:
        zeros = lambda dk, dv: jnp.zeros((bsz, 2, N_HEADS, dk, dv), f32)
        s_gla, s_dn, s_hg = zeros(GLA_DK, GLA_DV), zeros(DN_DK, DN_DV), zeros(HG_DK, HG_DV)
    else:
        s_gla, s_dn, s_hg = ctx['gla'], ctx['dn'], ctx['hg']

    q = split_heads(ga_q) * GLA_DK ** -0.5
    k = split_heads(ga_k)
    v = split_heads(ga_v)
    lr = ga_lr.reshape(bsz, t_len, 2, GLA_LOWRANK)
    log_a = jax.nn.log_sigmoid(jnp.einsum('btnr,nrk->nbtk', lr, p['gla_w2']).astype(f32)
                               + p['gla_b'][:, None, None, :].astype(f32)) / GLA_TAU
    o_f, sf = gla_chunk_scan(q, k, v, split_heads(log_a[0]), s_gla[:, 0])
    o_b, sb = gla_chunk_scan(flip_t(q), flip_t(k), flip_t(v), flip_t(split_heads(log_a[1])), s_gla[:, 1])
    out_a = gated_head_norm(o_f + flip_t(o_b), p['gla_norm'], ga_r)
    st_a = jnp.stack([sf, sb], axis=1)

    cq, ck, cv = split_cols(jax.nn.silu(centred_dwconv(dn_x, p['dn_conv'])), (BRANCH_W, BRANCH_W, BRANCH_W))
    q = l2norm(split_heads(cq)) * DN_DK ** -0.5
    k = l2norm(split_heads(ck))
    v = split_heads(cv)
    beta = jax.nn.sigmoid(dn_b.astype(f32)).reshape(bsz, t_len, 2, N_HEADS).transpose(2, 0, 3, 1)
    a_in = dn_a.astype(f32).reshape(bsz, t_len, 2, N_HEADS) + p['dn_dt_bias'].astype(f32)
    g = (-jnp.exp(p['dn_a_log'].astype(f32)) * jax.nn.softplus(a_in)).transpose(2, 0, 3, 1)
    o_f, sf = delta_chunk_scan(q, k, v, beta[0], g[0], s_dn[:, 0])
    o_b, sb = delta_chunk_scan(flip_t(q), flip_t(k), flip_t(v), flip_t(beta[1]), flip_t(g[1]), s_dn[:, 1])
    out_b = gated_head_norm(o_f + flip_t(o_b), p['dn_norm'], dn_g)
    st_b = jnp.stack([sf, sb], axis=1)

    q = jax.nn.silu(split_heads(hg_q)) * HG_DK ** -0.5
    v = split_heads(hg_i)
    f = p['hg_lb'] + (1.0 - p['hg_lb']) * jax.nn.sigmoid(hg_f.astype(f32).reshape(bsz, t_len, 2, HG_W))
    log_f = jnp.log(f)
    o_f, sf = gla_chunk_scan(q, split_heads(1.0 - f[:, :, 0]), v, split_heads(log_f[:, :, 0]), s_hg[:, 0])
    o_b, sb = gla_chunk_scan(flip_t(q), flip_t(split_heads(1.0 - f[:, :, 1])), flip_t(v),
                             flip_t(split_heads(log_f[:, :, 1])), s_hg[:, 1])
    out_c = gated_head_norm(o_f + flip_t(o_b), p['hg_norm'], hg_g)
    st_c = jnp.stack([sf, sb], axis=1)

    dq = split_heads(df_q)
    df_kh = split_heads(df_k)
    df_vh = split_heads(df_v)
    q1, q2 = dq[..., :DF_DH], dq[..., DF_DH:]
    k1, k2 = df_kh[..., :DF_DH], df_kh[..., DF_DH:]
    v = df_vh
    if ctx is not None:
        cos, sin = rope
        q1, q2, k1, k2 = [apply_axial_rope(a, cos, sin) for a in (q1, q2, k1, k2)]
        ck_cache, cv_cache = ctx['diff_k'], ctx['diff_v']
        k1 = jnp.concatenate([ck_cache[..., :DF_DH], k1], axis=2)
        k2 = jnp.concatenate([ck_cache[..., DF_DH:], k2], axis=2)
        v = jnp.concatenate([cv_cache, v], axis=2)
    lv = p['diff_lambda'].astype(f32)
    lam = jnp.exp(jnp.sum(lv[0] * lv[1])) - jnp.exp(jnp.sum(lv[2] * lv[3])) + p['lam_init']
    o = diff_attention(q1, q2, k1, k2, v, lam)
    out_d = merge_heads(rms_norm(o, p['diff_norm'])) * (1.0 - p['lam_init'])

    br = jnp.stack([out_a, out_b, out_c, out_d], axis=0)
    up = jnp.einsum('nbtc,ncd->nbtd', br, p['w_branch'])
    gate = jax.nn.sigmoid(xn @ p['w_mgate']).reshape(bsz, t_len, N_BRANCH, D_MODEL)
    out = jnp.einsum('btnd,nbtd->btd', gate, up) @ p['w_out']
    if ctx is None:
        return out, (df_kh, df_vh, st_a, st_b, st_c)
    return out, None


def swiglu(x, w_up, w_down):
    gu = x @ w_up
    return (jax.nn.silu(gu[..., :D_FF]) * gu[..., D_FF:]) @ w_down


def trunk_layer(x, mod, p, ctx, rope):
    sh1, sc1, ga1, shm, scm, gam, sh2, sc2, ga2 = jnp.split(mod, N_MOD, axis=-1)
    h = rms_norm(x, p['norm'][0]) * (1.0 + sc1) + sh1
    x = x + 0.5 * ga1 * swiglu(h, p['ffn1_in'], p['ffn1_down'])
    h = rms_norm(x, p['norm'][1]) * (1.0 + scm) + shm
    mix, new_ctx = token_mixers(h, p, ctx, rope)
    x = x + gam * mix
    h = rms_norm(x, p['norm'][2]) * (1.0 + sc2) + sh2
    x = x + 0.5 * ga2 * swiglu(h, p['ffn2_in'], p['ffn2_down'])
    return x, new_ctx


def setup_inputs(seed: int = 0) -> dict:
    key = jax.random.key(seed)
    ks = jax.random.split(key, 40)
    f32 = jnp.float32
    nrm = lambda k, shape, s: jax.random.normal(k, shape, f32) * s
    H = N_HEADS
    dt = jnp.exp(jax.random.uniform(ks[20], (DEPTH, 2, H), f32, math.log(1e-3), math.log(1e-1)))
    return {
        'x_prompt': nrm(ks[0], (BATCH, SEQ, D_MODEL), 1.0),
        'x_sample': nrm(ks[1], (DEC_BATCH, DEC_SEQ, D_MODEL), 1.0),
        'cache_diff_k': nrm(ks[2], (DEC_BATCH, DEPTH, H, PAST_LEN, 2 * DF_DH), 1.0),
        'cache_diff_v': nrm(ks[3], (DEC_BATCH, DEPTH, H, PAST_LEN, 2 * DF_DH), 1.0),
        'state_gla': nrm(ks[4], (DEC_BATCH, DEPTH, 2, H, GLA_DK, GLA_DV), 0.5),
        'state_dn': nrm(ks[5], (DEC_BATCH, DEPTH, 2, H, DN_DK, DN_DV), 0.5),
        'state_hgrn': nrm(ks[6], (DEC_BATCH, DEPTH, 2, H, HG_DK, HG_DV), 0.5),
        'c': nrm(ks[7], (DEC_BATCH, D_MODEL), 1.0),
        'c_ctx': nrm(ks[8], (D_MODEL,), 1.0),
        'norm_w': 1.0 + nrm(ks[9], (DEPTH, 3, D_MODEL), 0.02),
        'w_mod': nrm(ks[10], (DEPTH, D_MODEL, N_MOD * D_MODEL), 0.5 * D_MODEL ** -0.5),
        'b_mod': nrm(ks[11], (DEPTH, N_MOD * D_MODEL), 0.02),
        'ffn1_in': nrm(ks[12], (DEPTH, D_MODEL, 2 * D_FF), D_MODEL ** -0.5),
        'ffn1_down': nrm(ks[13], (DEPTH, D_FF, D_MODEL), D_FF ** -0.5),
        'ffn2_in': nrm(ks[14], (DEPTH, D_MODEL, 2 * D_FF), D_MODEL ** -0.5),
        'ffn2_down': nrm(ks[15], (DEPTH, D_FF, D_MODEL), D_FF ** -0.5),
        'w_in': nrm(ks[16], (DEPTH, D_MODEL, N_IN), D_MODEL ** -0.5),
        'gla_w2': nrm(ks[17], (DEPTH, 2, GLA_LOWRANK, GLA_KW), GLA_LOWRANK ** -0.5),
        'gla_b': nrm(ks[18], (DEPTH, 2, GLA_KW), 0.1),
        'gla_norm': 1.0 + nrm(ks[19], (DEPTH, GLA_DV), 0.02),
        'dn_conv': nrm(ks[21], (DEPTH, DN_CONV, 3 * BRANCH_W), DN_CONV ** -0.5),
        'dn_a_log': jnp.log(jax.random.uniform(ks[22], (DEPTH, 2, H), f32, 1.0, 16.0)),
        'dn_dt_bias': dt + jnp.log(-jnp.expm1(-dt)),
        'dn_norm': 1.0 + nrm(ks[23], (DEPTH, DN_DV), 0.02),
        'hg_lb_logits': nrm(ks[24], (DEPTH, 2, HG_W), 0.5),
        'hg_norm': 1.0 + nrm(ks[25], (DEPTH, HG_DV), 0.02),
        'diff_lambda': nrm(ks[26], (DEPTH, 4, DF_DH), 0.1),
        'diff_norm': 1.0 + nrm(ks[27], (DEPTH, 2 * DF_DH), 0.02),
        'w_branch': nrm(ks[28], (DEPTH, N_BRANCH, BRANCH_W, D_MODEL), BRANCH_W ** -0.5),
        'w_mgate': nrm(ks[29], (DEPTH, D_MODEL, N_BRANCH * D_MODEL), D_MODEL ** -0.5),
        'w_out': nrm(ks[30], (DEPTH, D_MODEL, D_MODEL), D_MODEL ** -0.5),
        'final_norm': 1.0 + nrm(ks[31], (D_MODEL,), 0.02),
    }


def reference(x_prompt, x_sample, cache_diff_k, cache_diff_v, state_gla, state_dn, state_hgrn, c, c_ctx,
              norm_w, w_mod, b_mod, ffn1_in, ffn1_down, ffn2_in, ffn2_down, w_in, gla_w2, gla_b, gla_norm,
              dn_conv, dn_a_log, dn_dt_bias, dn_norm, hg_lb_logits, hg_norm, diff_lambda, diff_norm,
              w_branch, w_mgate, w_out, final_norm):
    f32 = jnp.float32
    lb_p = jax.nn.softmax(hg_lb_logits.astype(f32), axis=0)
    hg_lb = jnp.cumsum(lb_p, axis=0) - lb_p[0:1]
    rope = axial_rope_tables(x_sample.shape[1], DF_DH)
    xp, xs = x_prompt, x_sample
    new_k, new_v, new_gla, new_dn, new_hg = [], [], [], [], []
    for l in range(DEPTH):
        p = {'norm': norm_w[l], 'ffn1_in': ffn1_in[l], 'ffn1_down': ffn1_down[l],
             'ffn2_in': ffn2_in[l], 'ffn2_down': ffn2_down[l], 'w_in': w_in[l],
             'gla_w2': gla_w2[l], 'gla_b': gla_b[l], 'gla_norm': gla_norm[l],
             'dn_conv': dn_conv[l], 'dn_a_log': dn_a_log[l], 'dn_dt_bias': dn_dt_bias[l], 'dn_norm': dn_norm[l],
             'hg_lb': hg_lb[l], 'hg_norm': hg_norm[l], 'diff_lambda': diff_lambda[l], 'diff_norm': diff_norm[l],
             'w_branch': w_branch[l], 'w_mgate': w_mgate[l], 'w_out': w_out[l],
             'lam_init': 0.8 - 0.6 * math.exp(-0.3 * l)}
        mod_ctx = (jax.nn.silu(c_ctx) @ w_mod[l] + b_mod[l])[None, None, :]
        mod_lat = (jax.nn.silu(c) @ w_mod[l] + b_mod[l])[:, None, :]
        xp, (k_l, v_l, sg, sd, sh) = trunk_layer(xp, mod_ctx, p, None, None)
        new_k.append(k_l)
        new_v.append(v_l)
        new_gla.append(sg)
        new_dn.append(sd)
        new_hg.append(sh)
        ctx = {'diff_k': cache_diff_k[:, l], 'diff_v': cache_diff_v[:, l],
               'gla': state_gla[:, l], 'dn': state_dn[:, l], 'hg': state_hgrn[:, l]}
        xs, _ = trunk_layer(xs, mod_lat, p, ctx, rope)
    y_prompt = rms_norm(xp, final_norm)
    y_sample = rms_norm(xs, final_norm)
    return (y_prompt, y_sample, jnp.stack(new_k, axis=1), jnp.stack(new_v, axis=1),
            jnp.stack(new_gla, axis=1), jnp.stack(new_dn, axis=1), jnp.stack(new_hg, axis=1))
```

```cpp
#include <hip/hip_runtime.h>
#include <cstdio>
#include <cstdint>
#include <cmath>
namespace pg8 {
#define PG8_LAS __attribute__((address_space(3)))
typedef unsigned short bf16_t;
typedef short bf16x8 __attribute__((ext_vector_type(8)));
typedef float f32x4 __attribute__((ext_vector_type(4)));
typedef unsigned u32x4 __attribute__((ext_vector_type(4)));
constexpr int BM = 256, BK = 64, HALF = 128, HTB = HALF * BK * 2  , STAGE_BYTES = 8 * HTB, NXCD = 8, WGM = 8;

__host__ __device__ __forceinline__ int lds_byte(int r, int c) { const int st = (r >> 4) * 2 + (c >> 5), rr = r & 15, cc = c & 31, ob = rr * 64 + cc * 2; return st * 1024 + (ob ^ (((ob >> 9) & 1) << 5)); }
__host__ __device__ __forceinline__ void stage_rc(int b, int& R, int& C) { const int st = b / 1024, sb = b % 1024, swz = sb ^ (((sb >> 9) & 1) << 5); R = (st >> 1) * 16 + swz / 64; C = (st & 1) * 32 + (swz % 64) / 2; }
__host__ __device__ __forceinline__ int perm32(int rho) { const int n = rho >> 4, i = rho & 15; return 8 * (i >> 2) + 4 * n + (i & 3); }

struct Unit { int pm, pn; };
struct Gemm { const bf16_t* A; const bf16_t* Bt; int M, N, K; };

struct StaticOrder {
    int nM, nN, nwg, G, c;
    __host__ __device__ void init(int M, int N, int G_, int c_) { nM = M / BM; nN = N / BM; nwg = nM * nN; G = G_; c = c_; }
    __host__ __device__ bool next(int i, Unit& u) const {
        const long L = (long)i * G + c; if (L >= nwg) return false;
        int wgid = (int)L; { const int q = nwg / NXCD, r = nwg % NXCD, xcd = wgid % NXCD, off = wgid / NXCD; wgid = (xcd < r ? xcd * (q + 1) : r * (q + 1) + (xcd - r) * q) + off; }
        const int nig = WGM * nN, gid = wgid / nig, fm = gid * WGM, gsz = (nM - fm) < WGM ? (nM - fm) : WGM;
        u.pm = fm + ((wgid % nig) % gsz); u.pn = (wgid % nig) / gsz; return true;
    }
    __device__ __forceinline__ void a_ready(const Unit&) const {}
    __device__ __forceinline__ void done(const Unit&) const {}
};


__device__ __forceinline__ unsigned f2bf_rne(float f) { unsigned u = __builtin_bit_cast(unsigned, f); return (u + 0x7fffu + ((u >> 16) & 1u)) >> 16; }
__device__ __forceinline__ unsigned pk_bf16(float lo, float hi) { return f2bf_rne(lo) | (f2bf_rne(hi) << 16); }
__device__ __forceinline__ float bf_lo(unsigned w) { return __builtin_bit_cast(float, w << 16); }
__device__ __forceinline__ float bf_hi(unsigned w) { return __builtin_bit_cast(float, w & 0xffff0000u); }
__device__ __forceinline__ float fast_sigmoid(float x) { return __builtin_amdgcn_rcpf(1.0f + __expf(-x)); }

struct EpiSwiglu {
    static constexpr bool PERM = true, AFTER_DRAIN = false;
    bf16_t* O; int ldo;
    __device__ __forceinline__ void operator()(const f32x4 (&acc)[2][2][4][2], const Unit& u, int wr, int wc, int fr, int fq) const {
        const int row0 = u.pm * BM + wr * 64 + fr, col0 = u.pn * HALF + wc * 32 + 8 * fq;
#pragma unroll
        for (int ai = 0; ai < 2; ++ai)
#pragma unroll
            for (int m = 0; m < 4; ++m) {
                int row = row0 + ai * HALF + m * 16; asm volatile("" : "+v"(row));
                bf16_t* rowp = O + (size_t)row * ldo + col0;
                float v[8];
#pragma unroll
                for (int n = 0; n < 2; ++n)
#pragma unroll
                    for (int j = 0; j < 4; ++j) { const float g = acc[ai][0][m][n][j], up = acc[ai][1][m][n][j]; v[n * 4 + j] = g * fast_sigmoid(g) * up; }
                u32x4 w; w.x = pk_bf16(v[0], v[1]); w.y = pk_bf16(v[2], v[3]); w.z = pk_bf16(v[4], v[5]); w.w = pk_bf16(v[6], v[7]);
                *(u32x4*)rowp = w;
            }
    }
};

struct EpiResid {
    static constexpr bool PERM = false, AFTER_DRAIN = false;
    const float* baseP; const float* baseS; float* out; const float* scale; float mul;
    __device__ __forceinline__ void operator()(const f32x4 (&acc)[2][2][4][2], const Unit& u, int wr, int wc, int fr, int fq) const {
        const int grp = u.pm < 32 ? 0 : 1 + ((u.pm - 32) >> 2);
        const float* sc = scale + grp * 9216;
        const float* base = u.pm < 32 ? baseP : baseS - (size_t)8192 * 1024;
        const int row0 = u.pm * BM + wr * 64 + fr, col0 = u.pn * BM + wc * 32 + 4 * fq;
#pragma unroll
        for (int bj = 0; bj < 2; ++bj)
#pragma unroll
            for (int n = 0; n < 2; ++n) {
                const int col = col0 + bj * HALF + n * 16;
                const f32x4 s4 = *(const f32x4*)(sc + col) * mul;
#pragma unroll
                for (int ai = 0; ai < 2; ++ai)
#pragma unroll
                    for (int m = 0; m < 4; ++m) {
                        int row = row0 + ai * HALF + m * 16; asm volatile("" : "+v"(row));
                        const size_t off = (size_t)row * 1024 + col;
                        const f32x4 b = *(const f32x4*)(base + off);
                        *(f32x4*)(out + off) = b + s4 * acc[ai][bj][m][n];
                        if (m & 1) asm volatile("" ::: "memory");
                    }
            }
    }
};

struct EpiInproj {
    static constexpr bool PERM = true, AFTER_DRAIN = false;
    bf16_t* PB; float* PF; bf16_t* G; float* dk; float* dv; int layer;
    __device__ __forceinline__ void operator()(const f32x4 (&acc)[2][2][4][2], const Unit& u, int wr, int wc, int fr, int fq) const {
        const int row0 = u.pm * BM + wr * 64 + fr;
        if (u.pn < 13) {
            const int col0 = u.pn * BM + wc * 32 + 8 * fq;
#pragma unroll
            for (int ai = 0; ai < 2; ++ai)
#pragma unroll
                for (int m = 0; m < 4; ++m) {
                    int row = row0 + ai * HALF + m * 16; asm volatile("" : "+v"(row));
#pragma unroll
                    for (int bj = 0; bj < 2; ++bj) {
                        const f32x4 v0 = acc[ai][bj][m][0], v1 = acc[ai][bj][m][1];
                        u32x4 w; w.x = pk_bf16(v0[0], v0[1]); w.y = pk_bf16(v0[2], v0[3]); w.z = pk_bf16(v1[0], v1[1]); w.w = pk_bf16(v1[2], v1[3]);
                        *(u32x4*)(PB + (size_t)row * 3328 + col0 + bj * HALF) = w;
                        if (u.pn >= 11 && u.pm < 32) {
                            float* o = (u.pn == 11) ? dk : dv;
                            const int hd = bj * 2 + (wc >> 1), d = (wc & 1) * 32 + 8 * fq, b = row >> 8, t = row & 255;
                            float* p = o + ((size_t)(((b * 2 + layer) * 4 + hd) * 256 + t)) * 64 + d;
                            *(f32x4*)p = v0; *(f32x4*)(p + 4) = v1;
                        }
                    }
                }
        } else if (u.pn < 16) {
            const int col0 = (u.pn - 13) * BM + wc * 32 + 8 * fq;
#pragma unroll
            for (int ai = 0; ai < 2; ++ai)
#pragma unroll
                for (int m = 0; m < 4; ++m) {
                    int row = row0 + ai * HALF + m * 16; asm volatile("" : "+v"(row));
#pragma unroll
                    for (int bj = 0; bj < 2; ++bj) {
                        const int col = col0 + bj * HALF;
                        if (col < 576) { float* p = PF + (size_t)row * 576 + col; *(f32x4*)p = acc[ai][bj][m][0]; *(f32x4*)(p + 4) = acc[ai][bj][m][1]; }
                    }
                }
        } else {
            const int col0 = (u.pn - 16) * BM + wc * 32 + 8 * fq;
#pragma unroll
            for (int ai = 0; ai < 2; ++ai)
#pragma unroll
                for (int m = 0; m < 4; ++m) {
                    int row = row0 + ai * HALF + m * 16; asm volatile("" : "+v"(row));
#pragma unroll
                    for (int bj = 0; bj < 2; ++bj) {
                        float v[8];
#pragma unroll
                        for (int n = 0; n < 2; ++n)
#pragma unroll
                            for (int j = 0; j < 4; ++j) v[n * 4 + j] = fast_sigmoid(acc[ai][bj][m][n][j]);
                        u32x4 w; w.x = pk_bf16(v[0], v[1]); w.y = pk_bf16(v[2], v[3]); w.z = pk_bf16(v[4], v[5]); w.w = pk_bf16(v[6], v[7]);
                        *(u32x4*)(G + (size_t)row * 4096 + col0 + bj * HALF) = w;
                    }
                }
        }
    }
};

struct EpiMerge {
    static constexpr bool PERM = true, AFTER_DRAIN = false;
    const bf16_t* G; float* P; bf16_t* MG;
    __device__ __forceinline__ void operator()(const f32x4 (&acc)[2][2][4][2], const Unit& u, int wr, int wc, int fr, int fq) const {
        const int n = u.pm / 40, pm = u.pm - n * 40, pn = u.pn & 3;
        const int row0 = pm * BM + wr * 64 + fr, col0 = pn * BM + wc * 32 + 8 * fq;
#pragma unroll
        for (int ai = 0; ai < 2; ++ai)
#pragma unroll
            for (int m = 0; m < 4; ++m) {
                int row = row0 + ai * HALF + m * 16; asm volatile("" : "+v"(row));
#pragma unroll
                for (int bj = 0; bj < 2; ++bj) {
                    const int col = col0 + bj * HALF;
                    const u32x4 gw = *(const u32x4*)(G + (size_t)row * 4096 + n * 1024 + col);
                    f32x4 v0 = acc[ai][bj][m][0], v1 = acc[ai][bj][m][1];
                    v0[0] *= bf_lo(gw.x); v0[1] *= bf_hi(gw.x); v0[2] *= bf_lo(gw.y); v0[3] *= bf_hi(gw.y);
                    v1[0] *= bf_lo(gw.z); v1[1] *= bf_hi(gw.z); v1[2] *= bf_lo(gw.w); v1[3] *= bf_hi(gw.w);
                    float* pp = P + (size_t)row * 1024 + col;
                    if (n > 0) { v0 += *(const f32x4*)pp; v1 += *(const f32x4*)(pp + 4); }
                    if (n < 3) { *(f32x4*)pp = v0; *(f32x4*)(pp + 4) = v1; }
                    else { u32x4 w; w.x = pk_bf16(v0[0], v0[1]); w.y = pk_bf16(v0[2], v0[3]); w.z = pk_bf16(v1[0], v1[1]); w.w = pk_bf16(v1[2], v1[3]); *(u32x4*)(MG + (size_t)row * 1024 + col) = w; }
                }
                asm volatile("" ::: "memory");
            }
    }
};
struct MergeOrder {
    int c;
    __device__ __forceinline__ bool next(int i, Unit& u) const { if (c >= 160 || i >= 4) return false; u.pm = i * 40 + (c >> 2); u.pn = i * 4 + (c & 3); return true; }
    __device__ __forceinline__ void a_ready(const Unit&) const {}
    __device__ __forceinline__ void done(const Unit&) const {}
};

template <class Epi, class Sched, bool ALIGN_EPI = false, bool SP2 = false, int KC = 0>
__device__ __forceinline__ void gemm_phase(PG8_LAS unsigned char* lds, const Gemm g, const Sched& S, const Epi& E) {
    int tid_ = threadIdx.x; asm volatile("" : "+v"(tid_));
    const int tid = tid_, wid = __builtin_amdgcn_readfirstlane(tid >> 6), lane = tid & 63, wr = wid >> 2, wc = wid & 3, fr = lane & 15, fq = lane >> 4;
    const int K = KC > 0 ? KC : g.K, nt = K / BK;
    unsigned voffA[2], voffB[2];
#pragma unroll
    for (int i = 0; i < 2; ++i) { int R, C; stage_rc(tid * 16 + i * 8192, R, C); const int Rb = Epi::PERM ? ((R & ~31) + perm32(R & 31)) : R;
        voffA[i] = (unsigned)(R * K + C) * 2u; voffB[i] = (unsigned)(Rb * K + C) * 2u; }
    const size_t kstep = (size_t)(BK * 2);
    const size_t hstep = (size_t)HALF * K * 2;
    const size_t tstep = 2 * hstep;
    const unsigned ldsw = (unsigned)wid * 1024u;
    const int aoff = lds_byte(wr * 64 + fr, fq * 8), boff = lds_byte(wc * 32 + fr, fq * 8);
#define PG8_SA(b, h) (((b) * 2 + (h)) * HTB)
#define PG8_SB(b, h) ((4 + (b) * 2 + (h)) * HTB)
#define PG8_STAGE(bufoff, gbase, voff) do { _Pragma("unroll") for (int _i = 0; _i < 2; ++_i) { unsigned _vo = (voff)[_i]; asm volatile("" : "+v"(_vo));     \
        __builtin_amdgcn_global_load_lds((const unsigned*)((const char*)(gbase) + _vo), (PG8_LAS unsigned*)(lds + (bufoff) + ldsw + _i * 8192), 16, 0, 0); } } while (0)
#define PG8_LDA(dst, b, h) do { _Pragma("unroll") for (int m = 0; m < 4; ++m) _Pragma("unroll") for (int k = 0; k < 2; ++k) dst[m][k] = *(const PG8_LAS bf16x8*)(lds + PG8_SA(b, h) + aoff + m * 2048 + k * 1024); } while (0)
#define PG8_LDB(dst, b, h) do { _Pragma("unroll") for (int n = 0; n < 2; ++n) _Pragma("unroll") for (int k = 0; k < 2; ++k) dst[n][k] = *(const PG8_LAS bf16x8*)(lds + PG8_SB(b, h) + boff + n * 2048 + k * 1024); } while (0)
#define PG8_MMA(ai, bj, At, Bt) do { __builtin_amdgcn_s_setprio(1); _Pragma("unroll") for (int m = 0; m < 4; ++m) _Pragma("unroll") for (int n = 0; n < 2; ++n) _Pragma("unroll") for (int k = 0; k < 2; ++k) \
        acc[ai][bj][m][n] = __builtin_amdgcn_mfma_f32_16x16x32_bf16(Bt[n][k], At[m][k], acc[ai][bj][m][n], 0, 0, 0); __builtin_amdgcn_s_setprio(0); } while (0)
#define PG8_WAIT_V(n) asm volatile("s_waitcnt vmcnt(" #n ")" ::: "memory")
#define PG8_WAIT_L(n) asm volatile("s_waitcnt lgkmcnt(" #n ")" ::: "memory")
#define PG8_BAR __builtin_amdgcn_s_barrier()
#define PG8_SCHED __builtin_amdgcn_sched_barrier(0)
    Unit cur, nxt; int ui = 0;
    if (!S.next(0, cur)) return;
    f32x4 acc[2][2][4][2];
#pragma unroll
    for (int a = 0; a < 2; ++a)
#pragma unroll
        for (int b = 0; b < 2; ++b)
#pragma unroll
            for (int m = 0; m < 4; ++m)
#pragma unroll
                for (int n = 0; n < 2; ++n) acc[a][b][m][n] = (f32x4){0.f, 0.f, 0.f, 0.f};
    bf16x8 At[4][2], B0[2][2], B1[2][2];
    const char* cA = (const char*)g.A + (size_t)cur.pm * tstep; const char* cB = (const char*)g.Bt + (size_t)cur.pn * tstep;
    S.a_ready(cur);
    if constexpr (SP2) {
        PG8_STAGE(PG8_SB(0, 0), cB, voffB); PG8_STAGE(PG8_SB(0, 1), cB + hstep, voffB); PG8_STAGE(PG8_SA(0, 0), cA, voffA); PG8_STAGE(PG8_SA(0, 1), cA + hstep, voffA);
        if (wr == 1) PG8_BAR;
        PG8_WAIT_V(2); PG8_BAR;
        PG8_STAGE(PG8_SB(1, 0), cB + kstep, voffB); PG8_STAGE(PG8_SA(1, 0), cA + kstep, voffA); PG8_STAGE(PG8_SB(1, 1), cB + hstep + kstep, voffB);
        PG8_WAIT_V(6); PG8_BAR;
    } else {
        PG8_STAGE(PG8_SB(0, 0), cB, voffB); PG8_STAGE(PG8_SA(0, 0), cA, voffA); PG8_STAGE(PG8_SB(0, 1), cB + hstep, voffB); PG8_STAGE(PG8_SA(0, 1), cA + hstep, voffA);
        if (wr == 1) PG8_BAR;
        PG8_WAIT_V(4); PG8_BAR;
        PG8_STAGE(PG8_SB(1, 0), cB + kstep, voffB); PG8_STAGE(PG8_SA(1, 0), cA + kstep, voffA); PG8_STAGE(PG8_SB(1, 1), cB + hstep + kstep, voffB);
        PG8_WAIT_V(6); PG8_BAR;
    }
    for (;;) {
        const bool has_next = S.next(ui + 1, nxt);
        const char* nA = has_next ? (const char*)g.A + (size_t)nxt.pm * tstep : cA; const char* nB = has_next ? (const char*)g.Bt + (size_t)nxt.pn * tstep : cB;
        for (int t = 0; t < nt; t += 2) {
            const bool last = (t == nt - 2);
            const char* a1 = cA + (size_t)(t + 1) * kstep;
            const char* a2 = last ? nA : cA + (size_t)(t + 2) * kstep; const char* b2 = last ? nB : cB + (size_t)(t + 2) * kstep;
            const char* a3 = a2 + kstep; const char* b3 = b2 + kstep;
            if (last && has_next) S.a_ready(nxt);
            if constexpr (SP2) {
            PG8_LDB(B0, 0, 0); PG8_LDB(B1, 0, 1); PG8_SCHED; PG8_LDA(At, 0, 0); PG8_STAGE(PG8_SA(1, 1), a1 + hstep, voffA);
            PG8_WAIT_V(8); PG8_WAIT_L(0); PG8_BAR; PG8_MMA(0, 0, At, B0); PG8_MMA(0, 1, At, B1); PG8_BAR; PG8_SCHED;
            PG8_LDA(At, 0, 1); PG8_STAGE(PG8_SB(0, 0), b2, voffB); PG8_STAGE(PG8_SB(0, 1), b2 + hstep, voffB); PG8_STAGE(PG8_SA(0, 0), a2, voffA);
            PG8_WAIT_V(8); PG8_WAIT_L(0); PG8_BAR; PG8_MMA(1, 0, At, B0); PG8_MMA(1, 1, At, B1); PG8_BAR; PG8_SCHED;
            PG8_LDB(B0, 1, 0); PG8_LDB(B1, 1, 1); PG8_SCHED; PG8_LDA(At, 1, 0); PG8_STAGE(PG8_SA(0, 1), a2 + hstep, voffA);
            PG8_WAIT_V(8); PG8_WAIT_L(0); PG8_BAR; PG8_MMA(0, 0, At, B0); PG8_MMA(0, 1, At, B1); PG8_BAR; PG8_SCHED;
            PG8_LDA(At, 1, 1); PG8_STAGE(PG8_SB(1, 0), b3, voffB); PG8_STAGE(PG8_SB(1, 1), b3 + hstep, voffB); PG8_STAGE(PG8_SA(1, 0), a3, voffA);
            PG8_WAIT_V(8); PG8_WAIT_L(0); PG8_BAR; PG8_MMA(1, 0, At, B0); PG8_MMA(1, 1, At, B1); PG8_BAR; PG8_SCHED;
            } else {
            PG8_LDB(B0, 0, 0); PG8_SCHED; PG8_LDA(At, 0, 0); PG8_STAGE(PG8_SA(1, 1), a1 + hstep, voffA);
            PG8_WAIT_L(8); PG8_BAR; PG8_WAIT_L(0); PG8_MMA(0, 0, At, B0); PG8_BAR; PG8_SCHED;
            PG8_LDB(B1, 0, 1); PG8_STAGE(PG8_SB(0, 0), b2, voffB);
            PG8_BAR; PG8_WAIT_L(0); PG8_MMA(0, 1, At, B1); PG8_BAR;
            PG8_LDA(At, 0, 1); PG8_STAGE(PG8_SA(0, 0), a2, voffA);
            PG8_BAR; PG8_WAIT_L(0); PG8_MMA(1, 0, At, B0); PG8_BAR; PG8_SCHED;
            PG8_STAGE(PG8_SB(0, 1), b2 + hstep, voffB);
            PG8_WAIT_V(6); PG8_BAR; PG8_MMA(1, 1, At, B1); PG8_BAR;
            PG8_LDB(B0, 1, 0); PG8_SCHED; PG8_LDA(At, 1, 0); PG8_STAGE(PG8_SA(0, 1), a2 + hstep, voffA);
            PG8_WAIT_L(8); PG8_BAR; PG8_WAIT_L(0); PG8_MMA(0, 0, At, B0); PG8_BAR; PG8_SCHED;
            PG8_LDB(B1, 1, 1); PG8_STAGE(PG8_SB(1, 0), b3, voffB);
            PG8_BAR; PG8_WAIT_L(0); PG8_MMA(0, 1, At, B1); PG8_BAR;
            PG8_LDA(At, 1, 1); PG8_STAGE(PG8_SA(1, 0), a3, voffA);
            PG8_BAR; PG8_WAIT_L(0); PG8_MMA(1, 0, At, B0); PG8_BAR; PG8_SCHED;
            PG8_STAGE(PG8_SB(1, 1), b3 + hstep, voffB);
            PG8_WAIT_V(6); PG8_BAR; PG8_MMA(1, 1, At, B1); PG8_BAR;
            }
        }
        if constexpr (ALIGN_EPI) { if (wr == 0) PG8_BAR; }
        if constexpr (!Epi::AFTER_DRAIN) { int t3_ = threadIdx.x; asm volatile("" : "+v"(t3_)); const int l3_ = t3_ & 63, w3_ = __builtin_amdgcn_readfirstlane(t3_ >> 6);
            E(acc, cur, w3_ >> 2, w3_ & 3, l3_ & 15, l3_ >> 4); S.done(cur); }
        if (!has_next) break;
#pragma unroll
        for (int a = 0; a < 2; ++a)
#pragma unroll
            for (int b = 0; b < 2; ++b)
#pragma unroll
                for (int m = 0; m < 4; ++m)
#pragma unroll
                    for (int n = 0; n < 2; ++n) acc[a][b][m][n] = (f32x4){0.f, 0.f, 0.f, 0.f};
        cur = nxt; cA = nA; cB = nB; ++ui;
        if constexpr (ALIGN_EPI) { if (wr == 1) PG8_BAR; }
    }
    PG8_WAIT_V(0);
    if constexpr (!ALIGN_EPI) { if (wr == 0) PG8_BAR; }
    PG8_BAR;
    if constexpr (Epi::AFTER_DRAIN) { E.fused(acc, cur, wr, wc, fr, fq, lds, wid, lane); S.done(cur); }
#undef PG8_SA
#undef PG8_SB
#undef PG8_STAGE
#undef PG8_LDA
#undef PG8_LDB
#undef PG8_MMA
#undef PG8_WAIT_V
#undef PG8_WAIT_L
#undef PG8_BAR
#undef PG8_SCHED
}
}

#ifndef PG8_SP2
#define PG8_SP2 true
#endif
#ifndef PG8_ALIGN
#define PG8_ALIGN true
#endif
constexpr int NWAVES = 8;
#ifndef MK_ONE_LAUNCH
#define MK_ONE_LAUNCH 0
#endif

constexpr int NL = 2;
constexpr int M = 10240, MP = 8192;
constexpr int D = 1024, FF = 2816;
constexpr int NPB = 3328, NPF = 576, NGT = 4096;
constexpr int NSEQ = 34;
constexpr int NPHASE = 25;
constexpr int C_GAQ = 0, C_GAK = 128, C_GAV = 256, C_GAR = 512, C_DNX = 768, C_DNG = 1536, C_HGQ = 1792, C_HGI = 2048, C_HGG = 2304, C_DFQ = 2560, C_DFK = 2816, C_DFV = 3072;
constexpr int F_LR = 0, F_DNB = 32, F_DNA = 40, F_HGF = 48;
constexpr size_t O_Y = 0, O_DK = 10485760, O_DV = 14680064, O_SG = 18874368, O_SD = 19922944, O_SH = 22020096, O_END = 24117248;

constexpr size_t MiB = 1u << 20;
constexpr size_t WS_CTL = 0, CTL_ZERO_BYTES = 1 * MiB;
constexpr size_t WS_MODP = 1 * MiB;
constexpr size_t WS_MODF = 3 * MiB;
constexpr size_t WS_ROPE = 3 * MiB + 512 * 1024;
constexpr size_t WS_W = 4 * MiB;
constexpr size_t W_1A = 0, W_1B = W_1A + (size_t)5632 * 1024 * 2, W_IN = W_1B + (size_t)1024 * 2816 * 2, W_BR = W_IN + (size_t)8192 * 1024 * 2,
                 W_WO = W_BR + (size_t)4096 * 256 * 2, W_2A = W_WO + (size_t)1024 * 1024 * 2, W_2B = W_2A + (size_t)5632 * 1024 * 2, W_END = W_2B + (size_t)1024 * 2816 * 2;
static_assert(W_END <= 56 * MiB, "weights fit");
constexpr size_t WS_H = 60 * MiB;
constexpr size_t WS_BR = 80 * MiB;
constexpr size_t WS_GATE = 100 * MiB;
constexpr size_t WS_PB = 180 * MiB;
constexpr size_t WS_PF = 245 * MiB;
constexpr size_t WS_OSC = 268 * MiB;
constexpr size_t WS_END = 298 * MiB;
constexpr size_t WS_ACT = WS_PB, WS_PART = WS_PB;
constexpr int CW_TMO = 0, CW_CODE = 1, CW_BAR = 4096;

constexpr int RING_OFF = 0, RING_BYTES = 131072;
constexpr int LDSCTL_OFF = RING_BYTES, MISC_OFF = LDSCTL_OFF + 320;
constexpr int LDS_BYTES = 147456;

#define GAS __attribute__((address_space(1)))
#define LAS __attribute__((address_space(3)))
typedef unsigned short bf16;
typedef unsigned v4u __attribute__((ext_vector_type(4)));
typedef unsigned v2u __attribute__((ext_vector_type(2)));
typedef float f32x4 __attribute__((ext_vector_type(4)));
typedef GAS unsigned gu32;
#define RLX_AGENT __ATOMIC_RELAXED, __HIP_MEMORY_SCOPE_AGENT
#define LDS_WAIT() asm volatile("s_waitcnt lgkmcnt(0)" ::: "memory")
#define VM_WAIT() asm volatile("s_waitcnt vmcnt(0)" ::: "memory")
__device__ __forceinline__ unsigned f2bf(float f) { unsigned u = __builtin_bit_cast(unsigned, f); return (u + 0x7fffu + ((u >> 16) & 1u)) >> 16; }
__device__ __forceinline__ unsigned pk2(float lo, float hi) { return f2bf(lo) | (f2bf(hi) << 16); }
__device__ __forceinline__ float bf2f(unsigned short u) { return __builtin_bit_cast(float, (unsigned)u << 16); }
__device__ __forceinline__ float bflo(unsigned w) { return __builtin_bit_cast(float, w << 16); }
__device__ __forceinline__ float bfhi(unsigned w) { return __builtin_bit_cast(float, w & 0xffff0000u); }
__device__ __forceinline__ float sigmoidf_(float x) { return 1.0f / (1.0f + expf(-x)); }
__device__ __forceinline__ float siluf_(float x) { return x / (1.0f + expf(-x)); }
__device__ __forceinline__ float softplusf_(float x) { return fmaxf(x, 0.f) + log1pf(expf(-fabsf(x))); }
template <int PAT> __device__ __forceinline__ float swz_xor(float v) { return __builtin_bit_cast(float, __builtin_amdgcn_ds_swizzle(__builtin_bit_cast(int, v), PAT)); }
__device__ __forceinline__ float wave_sum(float v) {
    v += swz_xor<0x041F>(v); v += swz_xor<0x081F>(v); v += swz_xor<0x101F>(v); v += swz_xor<0x201F>(v); v += swz_xor<0x401F>(v);
    const float lo = __builtin_bit_cast(float, __builtin_amdgcn_readlane(__builtin_bit_cast(int, v), 0)), hi = __builtin_bit_cast(float, __builtin_amdgcn_readlane(__builtin_bit_cast(int, v), 32));
    return lo + hi;
}

#define XB_TMO      128
#define XB_XCNT(j)  (256  + 64 * (j))
#define XB_XSUB(j)  (1280 + 64 * (j))
#define XB_XGEN(j)  (2304 + 64 * (j))
#define XB_TOP      3328
#define XB_TOPGEN   3392
#define XCD_BAR_WORDS 3456
#define XB_SPIN_CAP (1u << 18)

__device__ __forceinline__ unsigned xb_ld(unsigned* p)              { return __hip_atomic_load(p, __ATOMIC_RELAXED, __HIP_MEMORY_SCOPE_AGENT); }
__device__ __forceinline__ unsigned xb_add(unsigned* p, unsigned v) { return __hip_atomic_fetch_add(p, v, __ATOMIC_RELAXED, __HIP_MEMORY_SCOPE_AGENT); }
__device__ __forceinline__ unsigned xb_xcc_id() { return (unsigned)__builtin_amdgcn_s_getreg((3 << 11) | 20) & 0xFu; }
#define XB_SPIN(cond, bar) do { unsigned _sp = 0; while (cond) { __builtin_amdgcn_s_sleep(1); \
    if ((++_sp & 255u) == 0u) { if (xb_ld(&(bar)[XB_TMO])) break; if (_sp > XB_SPIN_CAP) { atomicAdd(&(bar)[XB_TMO], 1u); break; } } } } while (0)

struct XcdBarrier {
    unsigned* bar; unsigned x;
    volatile LAS unsigned* st;
};

__device__ __forceinline__ XcdBarrier xcd_barrier_post(unsigned* bar, volatile LAS unsigned* st) {
    XcdBarrier b; b.bar = bar; b.x = xb_xcc_id(); b.st = st;
    if (threadIdx.x == 0) (void)xb_add(&bar[XB_XCNT(b.x)], 1u);
    return b;
}
__device__ __forceinline__ void xcd_barrier_complete(unsigned* bar, unsigned x, unsigned& nloc, unsigned& nx) {
    const unsigned G = gridDim.x * gridDim.y * gridDim.z;
    unsigned sum, cnt, mine, sp = 0u;
    for (;;) {
        sum = 0u; cnt = 0u; mine = 0u;
#pragma unroll
        for (unsigned j = 0; j < 16; ++j) { const unsigned c = xb_ld(&bar[XB_XCNT(j)]); sum += c; cnt += (c > 0u) ? 1u : 0u; mine = (j == x) ? c : mine; }
        if (sum == G) break;
        __builtin_amdgcn_s_sleep(1);
        if ((++sp & 255u) == 0u) { if (xb_ld(&bar[XB_TMO])) break; if (sp > XB_SPIN_CAP) { atomicAdd(&bar[XB_TMO], 1u); break; } }
    }
    nloc = mine > 0u ? mine : 1u; nx = cnt > 0u ? cnt : 1u;
}

__device__ __forceinline__ void xcd_barrier(const XcdBarrier& b) {
    asm volatile("s_waitcnt vmcnt(0)" ::: "memory");
    __syncthreads();
    if (threadIdx.x == 0) {
        unsigned* bar = b.bar;
        __builtin_amdgcn_s_waitcnt(0);
        unsigned nloc = b.st[0], nx = b.st[1];
        if (nloc == 0u) { xcd_barrier_complete(bar, b.x, nloc, nx); b.st[0] = nloc; b.st[1] = nx; }
        const unsigned old = xb_add(&bar[XB_XSUB(b.x)], 1u);
        const unsigned gen = old / nloc;
        if (old + 1u == (gen + 1u) * nloc) {
            __builtin_amdgcn_fence(__ATOMIC_RELEASE, "agent");
            asm volatile("s_waitcnt vmcnt(0)" ::: "memory");
            const unsigned og = xb_add(&bar[XB_TOP], 1u);
            const unsigned tg = og / nx;
            if (og + 1u == (tg + 1u) * nx) xb_add(&bar[XB_TOPGEN], 1u);
            else XB_SPIN(xb_ld(&bar[XB_TOPGEN]) == tg, bar);
            __builtin_amdgcn_fence(__ATOMIC_ACQUIRE, "agent");
            xb_add(&bar[XB_XGEN(b.x)], 1u);
            asm volatile("s_waitcnt vmcnt(0)" ::: "memory");
        } else {
            XB_SPIN(xb_ld(&bar[XB_XGEN(b.x)]) == gen, bar);
            __builtin_amdgcn_fence(__ATOMIC_ACQUIRE, "agent");
            asm volatile("s_waitcnt vmcnt(0)" ::: "memory");
        }
    }
    __syncthreads();
}

struct Args { const float* in[32]; float* out; unsigned char* ws; int ph_lo, ph_hi; };
typedef __attribute__((address_space(4))) Args KArgs;
enum { I_XP = 0, I_XS, I_CK, I_CV, I_SGLA, I_SDN, I_SHG, I_C, I_CCTX, I_NORMW, I_WMOD, I_BMOD, I_F1IN, I_F1DN, I_F2IN, I_F2DN, I_WIN, I_GW2, I_GB, I_GNORM,
       I_DCONV, I_DALOG, I_DDT, I_DNORM, I_HLB, I_HNORM, I_DLAM, I_DFNORM, I_WBR, I_WMG, I_WOUT, I_FNORM };

__device__ __forceinline__ int srccol_inproj(int np) {
    if (np < 768) return np;
    if (np < 1536) return np - 768 + 800;
    if (np < 1792) return np - 1536 + 1584;
    if (np < 2048) return np - 1792 + 1840;
    if (np < 2304) return np - 2048 + 2608;
    if (np < 2560) return np - 2304 + 2864;
    if (np < 2816) return np - 2560 + 3120;
    if (np < 3072) return np - 2816 + 3376;
    if (np < 3328) return np - 3072 + 3632;
    const int o = np - 3328;
    if (o < 32) return 768 + o;
    if (o < 40) return 1568 + (o - 32);
    if (o < 48) return 1576 + (o - 40);
    if (o < 560) return 2096 + (o - 48);
    return -1;
}
__device__ __forceinline__ void tr_item(const float* W, int ldw, int K, bf16* WT, int kb, int nb, int kind, LAS float* scr, int lane) {
    const int k0 = 64 * kb, n0 = 32 * nb, np = n0 + (lane & 31);
    int sc = np;
    if (kind == 1) sc = ((np >> 7) & 1) * 2816 + (np >> 8) * 128 + (np & 127);
    else if (kind == 2) sc = srccol_inproj(np);
#pragma unroll 8
    for (int i = 0; i < 32; ++i) { const int kk = 2 * i + (lane >> 5); scr[kk * 33 + (lane & 31)] = sc >= 0 ? W[(size_t)(k0 + kk) * ldw + sc] : 0.f; }
    LDS_WAIT(); asm volatile("" ::: "memory");
    const int c = lane & 7;
#pragma unroll
    for (int j = 0; j < 4; ++j) { const int n = (lane >> 3) + 8 * j; const LAS float* s = scr + (8 * c) * 33 + n;
        v4u o; o.x = pk2(s[0 * 33], s[1 * 33]); o.y = pk2(s[2 * 33], s[3 * 33]); o.z = pk2(s[4 * 33], s[5 * 33]); o.w = pk2(s[6 * 33], s[7 * 33]);
        *(GAS v4u*)(WT + (size_t)(n0 + n) * K + k0 + 8 * c) = o; }
    LDS_WAIT(); asm volatile("" ::: "memory");
}
__device__ __forceinline__ void pro_phase(const KArgs& a, int l, LAS unsigned char* lds, int gw, int wave, int lane) {
    LAS float* scr = (LAS float*)(lds + wave * 16384);
    bf16* Wb = (bf16*)(a.ws + WS_W);
    constexpr int NGW = 256 * NWAVES;
    constexpr int I0 = 16 * 176, I1 = I0 + 44 * 32, I2 = I1 + 16 * 128, I3 = I2 + 16 * 128, I4 = I3 + 4 * 4 * 32, I5 = I4 + 16 * 32, I6 = I5 + 16 * 176, I7 = I6 + 44 * 32;
    for (int it = gw; it < I7; it += NGW) {
        if (it < I0) { const int r = it; tr_item(a.in[I_F1IN] + (size_t)l * 1024 * 5632, 5632, 1024, (bf16*)((char*)Wb + W_1A), r / 176, r % 176, 1, scr, lane); }
        else if (it < I1) { const int r = it - I0; tr_item(a.in[I_F1DN] + (size_t)l * 2816 * 1024, 1024, 2816, (bf16*)((char*)Wb + W_1B), r / 32, r % 32, 0, scr, lane); }
        else if (it < I2) { const int r = it - I1; tr_item(a.in[I_WIN] + (size_t)l * 1024 * 3888, 3888, 1024, (bf16*)((char*)Wb + W_IN), r / 128, r % 128, 2, scr, lane); }
        else if (it < I3) { const int r = it - I2; tr_item(a.in[I_WMG] + (size_t)l * 1024 * 4096, 4096, 1024, (bf16*)((char*)Wb + W_IN) + (size_t)4096 * 1024, r / 128, r % 128, 0, scr, lane); }
        else if (it < I4) { const int r = it - I3, n = r / 128, q = r % 128; tr_item(a.in[I_WBR] + (size_t)(l * 4 + n) * 256 * 1024, 1024, 256, (bf16*)((char*)Wb + W_BR) + (size_t)n * 1024 * 256, q / 32, q % 32, 0, scr, lane); }
        else if (it < I5) { const int r = it - I4; tr_item(a.in[I_WOUT] + (size_t)l * 1024 * 1024, 1024, 1024, (bf16*)((char*)Wb + W_WO), r / 32, r % 32, 0, scr, lane); }
        else if (it < I6) { const int r = it - I5; tr_item(a.in[I_F2IN] + (size_t)l * 1024 * 5632, 5632, 1024, (bf16*)((char*)Wb + W_2A), r / 176, r % 176, 1, scr, lane); }
        else { const int r = it - I6; tr_item(a.in[I_F2DN] + (size_t)l * 2816 * 1024, 1024, 2816, (bf16*)((char*)Wb + W_2B), r / 32, r % 32, 0, scr, lane); }
    }
    if (l == 0) {
        float* modp = (float*)(a.ws + WS_MODP);
        for (int it = gw; it < NL * 8 * 36; it += NGW) {
            const int ll = it / 288, r = it % 288, ks = r / 36, jb = r % 36, j = jb * 256 + lane * 4;
            const float* w = a.in[I_WMOD] + (size_t)ll * 1024 * 9216 + (size_t)(ks * 128) * 9216 + j;
            f32x4 a0 = {0.f, 0.f, 0.f, 0.f}, a1 = a0, a2 = a0;
            for (int k = 0; k < 128; ++k) {
                const f32x4 wv = *(const f32x4*)(w + (size_t)k * 9216);
                const int kk = ks * 128 + k;
                const float s0 = siluf_(a.in[I_CCTX][kk]), s1 = siluf_(a.in[I_C][kk]), s2 = siluf_(a.in[I_C][1024 + kk]);
                a0 += wv * s0; a1 += wv * s1; a2 += wv * s2;
            }
            if (ks == 0) { const f32x4 bv = *(const f32x4*)(a.in[I_BMOD] + (size_t)ll * 9216 + j); a0 += bv; a1 += bv; a2 += bv; }
            float* o = modp + (size_t)((ll * 8 + ks) * 3) * 9216 + j;
            *(f32x4*)o = a0; *(f32x4*)(o + 9216) = a1; *(f32x4*)(o + 2 * 9216) = a2;
        }
        float* ct = (float*)(a.ws + WS_ROPE); float* st = ct + 1024 * 32;
        for (int idx = gw * 64 + lane; idx < 1024 * 32; idx += NGW * 64) {
            const int t = idx >> 5, d = idx & 31;
            const float pos = (float)((d < 16) ? (t >> 6) : (t & 63));
            const float inv = powf(10000.0f, -(float)(d & 7) * 0.125f);
            float sn, cs; sincosf(pos * inv, &sn, &cs);
            ct[idx] = cs; st[idx] = sn;
        }
    }
}

__device__ __forceinline__ void norm_phase(const KArgs& a, int l, int which, LAS unsigned char* lds, int gw, int tid, int lane, const float* xP, const float* xS) {
    LAS float* cs = (LAS float*)lds;
    LAS float* sh = cs + 3 * 1024;
    const float* modp = (const float*)(a.ws + WS_MODP) + (size_t)l * 8 * 3 * 9216;
    const float* nw = a.in[I_NORMW] + (size_t)(l * 3 + which) * 1024;
    const int csh = which * 3, csc = which * 3 + 1;
    for (int i = tid; i < 3 * 1024; i += NWAVES * 64) {
        const int g = i >> 10, c = i & 1023; float vs = 0.f, vh = 0.f;
#pragma unroll
        for (int ks = 0; ks < 8; ++ks) { const float* p = modp + (size_t)(ks * 3 + g) * 9216; vs += p[csc * 1024 + c]; vh += p[csh * 1024 + c]; }
        cs[i] = nw[c] * (1.0f + vs); sh[i] = vh;
    }
    __syncthreads();
    bf16* H = (bf16*)(a.ws + WS_H);
    for (int row = gw; row < M; row += 256 * NWAVES) {
        const float* xr = row < MP ? xP + (size_t)row * D : xS + (size_t)(row - MP) * D;
        const int g = row < MP ? 0 : 1 + ((row - MP) >> 10);
        f32x4 v[4]; float s = 0.f;
#pragma unroll
        for (int j = 0; j < 4; ++j) { v[j] = *((const f32x4*)xr + lane + 64 * j); s += (v[j].x * v[j].x + v[j].y * v[j].y) + (v[j].z * v[j].z + v[j].w * v[j].w); }
        const float rstd = 1.0f / sqrtf(wave_sum(s) * (1.0f / D) + 1e-6f);
#pragma unroll
        for (int j = 0; j < 4; ++j) {
            const int c = (lane + 64 * j) * 4;
            const f32x4 c4 = *(const LAS f32x4*)(cs + g * 1024 + c), h4 = *(const LAS f32x4*)(sh + g * 1024 + c);
            const f32x4 o = v[j] * rstd * c4 + h4;
            v2u w; w.x = pk2(o.x, o.y); w.y = pk2(o.z, o.w);
            *(v2u*)(H + (size_t)row * D + c) = w;
        }
    }
    if (l == 0 && which == 0) {
        float* modf = (float*)(a.ws + WS_MODF); const float* mp = (const float*)(a.ws + WS_MODP);
        for (int i = gw * 64 + lane; i < NL * 3 * 9216; i += 256 * NWAVES * 64) {
            const int ll = i / (3 * 9216), r = i % (3 * 9216); float s = 0.f;
#pragma unroll
            for (int ks = 0; ks < 8; ++ks) s += mp[(size_t)((ll * 8 + ks) * 3) * 9216 + r];
            modf[i] = s;
        }
    }
}
__device__ __forceinline__ void final_phase(const KArgs& a, int gw, int lane) {
    float* X = a.out + O_Y; const float* fw = a.in[I_FNORM];
    for (int row = gw; row < M; row += 256 * NWAVES) {
        float* xr = X + (size_t)row * D; f32x4 v[4]; float s = 0.f;
#pragma unroll
        for (int j = 0; j < 4; ++j) { v[j] = *((const f32x4*)xr + lane + 64 * j); s += (v[j].x * v[j].x + v[j].y * v[j].y) + (v[j].z * v[j].z + v[j].w * v[j].w); }
        const float rstd = 1.0f / sqrtf(wave_sum(s) * (1.0f / D) + 1e-6f);
#pragma unroll
        for (int j = 0; j < 4; ++j) { const f32x4 w4 = *((const f32x4*)fw + lane + 64 * j); *((f32x4*)xr + lane + 64 * j) = v[j] * rstd * w4; }
    }
}


struct SeqInfo { bool ctx; int T, row0, b; };
__device__ __forceinline__ SeqInfo seq_info(int s) { SeqInfo q; q.ctx = s < 32; q.T = q.ctx ? 256 : 1024; q.row0 = q.ctx ? s * 256 : MP + (s - 32) * 1024; q.b = q.ctx ? s : s - 32; return q; }

constexpr int CH = 8;
template <int DK, bool HG>
__device__ __forceinline__ void scan_glahg(const KArgs& a, int l, int s, int h, LAS float* sm, int lane) {
    const SeqInfo si = seq_info(s); const int e = lane;
    const bf16* PB = (const bf16*)(a.ws + WS_PB); const float* PF = (const float*)(a.ws + WS_PF);
    float* osc = (float*)(a.ws + WS_OSC) + (size_t)(HG ? 2 : 0) * M * 256;
    bf16* BR = (bf16*)(a.ws + WS_BR) + (size_t)(HG ? 2 : 0) * M * 256;
    LAS float* qs = sm; LAS float* ks = sm + CH * DK; LAS float* dsm = sm + 2 * CH * DK; LAS float* vs = sm + 3 * CH * DK; LAS float* gs = vs + CH * 64; LAS float* os = gs + CH * 64;
    LAS float* w2s = os + CH * 64;
    const int vcol = (HG ? C_HGI : C_GAV) + h * 64 + e, gcol = (HG ? C_HGG : C_GAR) + h * 64 + e;
    const float nrm = (HG ? a.in[I_HNORM] : a.in[I_GNORM])[l * 64 + e];
    constexpr int PER = DK / 8;
    const int stt = lane >> 3, si0 = (lane & 7) * PER;
    for (int dir = 0; dir < 2; ++dir) {
        float S[DK];
        if (si.ctx) {
#pragma unroll
            for (int i = 0; i < DK; ++i) S[i] = 0.f;
        } else {
            const float* st = (HG ? a.in[I_SHG] : a.in[I_SGLA]) + (size_t)((((si.b * NL + l) * 2 + dir) * 4 + h) * DK) * 64 + e;
#pragma unroll
            for (int i = 0; i < DK; ++i) S[i] = st[(size_t)i * 64];
        }
        if (!HG) {
            const float* w2 = a.in[I_GW2] + (size_t)((l * 2 + dir) * 16) * 128 + h * 32;
            for (int i = lane; i < 16 * 32; i += 64) w2s[i] = w2[(i >> 5) * 128 + (i & 31)];
        }
        for (int cc = 0; cc < si.T / CH; ++cc) {
            const int tb = dir == 0 ? cc * CH : si.T - CH - cc * CH;
            LDS_WAIT(); asm volatile("" ::: "memory");
            {
                const int row = si.row0 + tb + stt;
                if (!HG) {
                    const v2u qw = *(const v2u*)(PB + (size_t)row * NPB + C_GAQ + h * 32 + si0);
                    const v2u kw = *(const v2u*)(PB + (size_t)row * NPB + C_GAK + h * 32 + si0);
                    float lr[16];
#pragma unroll
                    for (int r4 = 0; r4 < 4; ++r4) { const f32x4 t4 = *(const f32x4*)(PF + (size_t)row * NPF + F_LR + dir * 16 + r4 * 4); lr[r4 * 4] = t4.x; lr[r4 * 4 + 1] = t4.y; lr[r4 * 4 + 2] = t4.z; lr[r4 * 4 + 3] = t4.w; }
                    const float qv[4] = {bflo(qw.x), bfhi(qw.x), bflo(qw.y), bfhi(qw.y)};
                    const float kv[4] = {bflo(kw.x), bfhi(kw.x), bflo(kw.y), bfhi(kw.y)};
                    const float* gb = a.in[I_GB] + (size_t)(l * 2 + dir) * 128 + h * 32 + si0;
#pragma unroll
                    for (int j = 0; j < 4; ++j) {
                        float z = gb[j];
#pragma unroll
                        for (int r = 0; r < 16; ++r) z += lr[r] * w2s[r * 32 + si0 + j];
                        const float la = -softplusf_(-z) * (1.0f / 16.0f);
                        qs[stt * DK + si0 + j] = qv[j] * 0.17677669529663687f;
                        ks[stt * DK + si0 + j] = kv[j];
                        dsm[stt * DK + si0 + j] = expf(la);
                    }
                } else {
                    const v4u qw = *(const v4u*)(PB + (size_t)row * NPB + C_HGQ + h * 64 + si0);
                    const float qv[8] = {bflo(qw.x), bfhi(qw.x), bflo(qw.y), bfhi(qw.y), bflo(qw.z), bfhi(qw.z), bflo(qw.w), bfhi(qw.w)};
#pragma unroll
                    for (int j = 0; j < 8; ++j) {
                        const int i = si0 + j, c = h * 64 + i;
                        const float x = PF[(size_t)row * NPF + F_HGF + dir * 256 + c];
                        float lb = 0.f;
                        if (l == 1) { const float* lg = a.in[I_HLB]; lb = sigmoidf_(lg[(size_t)(2 + dir) * 256 + c] - lg[(size_t)dir * 256 + c]); }
                        const float f = lb + (1.0f - lb) * sigmoidf_(x);
                        qs[stt * DK + i] = siluf_(qv[j]) * 0.125f;
                        ks[stt * DK + i] = 1.0f - f;
                        dsm[stt * DK + i] = f;
                    }
                }
            }
#pragma unroll
            for (int tt = 0; tt < CH; ++tt) {
                const size_t row = (size_t)(si.row0 + tb + tt);
                vs[tt * 64 + e] = bf2f(PB[row * NPB + vcol]);
                if (dir == 1) { gs[tt * 64 + e] = bf2f(PB[row * NPB + gcol]); os[tt * 64 + e] = osc[row * 256 + h * 64 + e]; }
            }
            LDS_WAIT(); asm volatile("" ::: "memory");
#pragma unroll 1
            for (int u = 0; u < CH; ++u) {
                const int tt = dir == 0 ? u : CH - 1 - u;
                const float v = vs[tt * 64 + e];
                float o = 0.f;
#pragma unroll
                for (int i = 0; i < DK; i += 4) {
                    const f32x4 d4 = *(const LAS f32x4*)(dsm + tt * DK + i), k4 = *(const LAS f32x4*)(ks + tt * DK + i), q4 = *(const LAS f32x4*)(qs + tt * DK + i);
                    S[i] = d4.x * S[i] + k4.x * v; S[i + 1] = d4.y * S[i + 1] + k4.y * v; S[i + 2] = d4.z * S[i + 2] + k4.z * v; S[i + 3] = d4.w * S[i + 3] + k4.w * v;
                    o += q4.x * S[i] + q4.y * S[i + 1] + q4.z * S[i + 2] + q4.w * S[i + 3];
                }
                const size_t row = (size_t)(si.row0 + tb + tt);
                if (dir == 0) osc[row * 256 + h * 64 + e] = o;
                else {
                    const float tot = os[tt * 64 + e] + o;
                    const float ms = wave_sum(tot * tot) * (1.0f / 64.0f);
                    const float out = tot * (1.0f / sqrtf(ms + 1e-6f)) * nrm * siluf_(gs[tt * 64 + e]);
                    BR[row * 256 + h * 64 + e] = (bf16)f2bf(out);
                }
            }
        }
        if (si.ctx) {
            float* o = a.out + (HG ? O_SH : O_SG) + (size_t)((((si.b * NL + l) * 2 + dir) * 4 + h) * DK) * 64 + e;
#pragma unroll
            for (int i = 0; i < DK; ++i) o[(size_t)i * 64] = S[i];
        }
    }
}

__device__ __forceinline__ void scan_dn(const KArgs& a, int l, int s, int h, LAS float* sm, int lane) {
    const SeqInfo si = seq_info(s); const int e = lane;
    const bf16* PB = (const bf16*)(a.ws + WS_PB); const float* PF = (const float*)(a.ws + WS_PF);
    float* osc = (float*)(a.ws + WS_OSC) + (size_t)1 * M * 256;
    bf16* BR = (bf16*)(a.ws + WS_BR) + (size_t)1 * M * 256;
    LAS float* qs = sm; LAS float* ks = sm + CH * 64; LAS float* vs = sm + 2 * CH * 64; LAS float* gs = sm + 3 * CH * 64; LAS float* os = sm + 4 * CH * 64; LAS float* ba = sm + 5 * CH * 64;
    const float* cw = a.in[I_DCONV] + (size_t)l * 3 * 768;
    const float nrm = a.in[I_DNORM][l * 64 + e];
    const int gcol = C_DNG + h * 64 + e;
    const int cch = h * 64 + lane;
    const float wq0 = cw[cch], wq1 = cw[768 + cch], wq2 = cw[1536 + cch], wk0 = cw[256 + cch], wk1 = cw[768 + 256 + cch], wk2 = cw[1536 + 256 + cch],
                wv0 = cw[512 + cch], wv1 = cw[768 + 512 + cch], wv2 = cw[1536 + 512 + cch];
    const bf16* xb = PB + (size_t)si.row0 * NPB + C_DNX + cch;
    const int T_ = si.T;
    auto ld3 = [&](int t, float& xq, float& xk, float& xv) {
        if (t < 0 || t >= T_) { xq = 0.f; xk = 0.f; xv = 0.f; }
        else { const bf16* p = xb + (size_t)t * NPB; xq = bf2f(p[0]); xk = bf2f(p[256]); xv = bf2f(p[512]); }
    };
    for (int dir = 0; dir < 2; ++dir) {
        float S[64];
        if (si.ctx) {
#pragma unroll
            for (int i = 0; i < 64; ++i) S[i] = 0.f;
        } else {
            const float* st = a.in[I_SDN] + (size_t)((((si.b * NL + l) * 2 + dir) * 4 + h) * 64) * 64 + e;
#pragma unroll
            for (int i = 0; i < 64; ++i) S[i] = st[(size_t)i * 64];
        }
        const float dtb = a.in[I_DDT][(l * 2 + dir) * 4 + h], aexp = expf(a.in[I_DALOG][(l * 2 + dir) * 4 + h]);
        for (int cc = 0; cc < si.T / CH; ++cc) {
            const int tb = dir == 0 ? cc * CH : si.T - CH - cc * CH;
            LDS_WAIT(); asm volatile("" ::: "memory");
            {
                float pq, pk, pv, cq_, ck_, cv_;
                ld3(tb - 1, pq, pk, pv); ld3(tb, cq_, ck_, cv_);
#pragma unroll 1
                for (int tt = 0; tt < CH; ++tt) {
                    const int t = tb + tt;
                    float nq_, nk_, nv_; ld3(t + 1, nq_, nk_, nv_);
                    const float cq = siluf_(pq * wq0 + cq_ * wq1 + nq_ * wq2), ck = siluf_(pk * wk0 + ck_ * wk1 + nk_ * wk2);
                    vs[tt * 64 + lane] = siluf_(pv * wv0 + cv_ * wv1 + nv_ * wv2);
                    pq = cq_; pk = ck_; pv = cv_; cq_ = nq_; ck_ = nk_; cv_ = nv_;
                    const float nq = wave_sum(cq * cq), nk = wave_sum(ck * ck);
                    qs[tt * 64 + lane] = cq * (1.0f / sqrtf(nq + 1e-6f)) * 0.125f;
                    ks[tt * 64 + lane] = ck * (1.0f / sqrtf(nk + 1e-6f));
                    if (dir == 1) { const size_t row = (size_t)(si.row0 + t); gs[tt * 64 + e] = bf2f(PB[row * NPB + gcol]); os[tt * 64 + e] = osc[row * 256 + h * 64 + e]; }
                }
            }
            if (lane < CH) {
                const size_t row = (size_t)(si.row0 + tb + lane);
                const float bt = sigmoidf_(PF[row * NPF + F_DNB + dir * 4 + h]);
                const float ain = PF[row * NPF + F_DNA + dir * 4 + h] + dtb;
                ba[lane * 2] = bt; ba[lane * 2 + 1] = expf(-aexp * softplusf_(ain));
            }
            LDS_WAIT(); asm volatile("" ::: "memory");
#pragma unroll 1
            for (int u = 0; u < CH; ++u) {
                const int tt = dir == 0 ? u : CH - 1 - u;
                const float v = vs[tt * 64 + e];
                const float bt = ba[tt * 2], av = ba[tt * 2 + 1];
                float kts = 0.f;
#pragma unroll
                for (int i = 0; i < 64; i += 4) { const f32x4 k4 = *(const LAS f32x4*)(ks + tt * 64 + i); kts += k4.x * S[i] + k4.y * S[i + 1] + k4.z * S[i + 2] + k4.w * S[i + 3]; }
                const float uu = bt * (v - av * kts);
                float o = 0.f;
#pragma unroll
                for (int i = 0; i < 64; i += 4) {
                    const f32x4 k4 = *(const LAS f32x4*)(ks + tt * 64 + i), q4 = *(const LAS f32x4*)(qs + tt * 64 + i);
                    S[i] = av * S[i] + k4.x * uu; S[i + 1] = av * S[i + 1] + k4.y * uu; S[i + 2] = av * S[i + 2] + k4.z * uu; S[i + 3] = av * S[i + 3] + k4.w * uu;
                    o += q4.x * S[i] + q4.y * S[i + 1] + q4.z * S[i + 2] + q4.w * S[i + 3];
                }
                const size_t row = (size_t)(si.row0 + tb + tt);
                if (dir == 0) osc[row * 256 + h * 64 + e] = o;
                else {
                    const float tot = os[tt * 64 + e] + o;
                    const float ms = wave_sum(tot * tot) * (1.0f / 64.0f);
                    const float out = tot * (1.0f / sqrtf(ms + 1e-6f)) * nrm * siluf_(gs[tt * 64 + e]);
                    BR[row * 256 + h * 64 + e] = (bf16)f2bf(out);
                }
            }
        }
        if (si.ctx) {
            float* o = a.out + O_SD + (size_t)((((si.b * NL + l) * 2 + dir) * 4 + h) * 64) * 64 + e;
#pragma unroll
            for (int i = 0; i < 64; ++i) o[(size_t)i * 64] = S[i];
        }
    }
}

__device__ __forceinline__ void attn_item(const KArgs& a, int l, int s, int h, int qb, LAS float* sm, int lane) {
    const SeqInfo si = seq_info(s);
    const bf16* PB = (const bf16*)(a.ws + WS_PB);
    const float* ct = (const float*)(a.ws + WS_ROPE); const float* st = ct + 1024 * 32;
    LAS float* kts = sm; LAS float* vts = sm + 16 * 64;
    const int t = qb * 64 + lane; const size_t row = (size_t)(si.row0 + t);
    float q[64];
#pragma unroll
    for (int c8 = 0; c8 < 8; ++c8) {
        const v4u w = *(const v4u*)(PB + row * NPB + C_DFQ + h * 64 + c8 * 8);
        q[c8 * 8] = bflo(w.x); q[c8 * 8 + 1] = bfhi(w.x); q[c8 * 8 + 2] = bflo(w.y); q[c8 * 8 + 3] = bfhi(w.y);
        q[c8 * 8 + 4] = bflo(w.z); q[c8 * 8 + 5] = bfhi(w.z); q[c8 * 8 + 6] = bflo(w.w); q[c8 * 8 + 7] = bfhi(w.w);
    }
    if (!si.ctx) {
#pragma unroll
        for (int mp = 0; mp < 2; ++mp)
#pragma unroll
            for (int blk = 0; blk < 2; ++blk)
#pragma unroll
                for (int i = 0; i < 8; ++i) {
                    const int d0 = blk * 16 + i, d1 = d0 + 8;
                    const float c0 = ct[t * 32 + d0], s0 = st[t * 32 + d0], c1 = ct[t * 32 + d1], s1 = st[t * 32 + d1];
                    const float x0 = q[mp * 32 + d0], x1 = q[mp * 32 + d1];
                    q[mp * 32 + d0] = x0 * c0 - x1 * s0; q[mp * 32 + d1] = x1 * c1 + x0 * s1;
                }
    }
#pragma unroll
    for (int d = 0; d < 64; ++d) q[d] *= 0.17677669529663687f;
    const float lam_init = 0.8f - 0.6f * expf(-0.3f * (float)l);
    float lam;
    { const float* lv = a.in[I_DLAM] + (size_t)l * 128; float s01 = 0.f, s23 = 0.f;
      for (int i = 0; i < 32; ++i) { s01 += lv[i] * lv[32 + i]; s23 += lv[64 + i] * lv[96 + i]; }
      lam = expf(s01) - expf(s23) + lam_init; }
    const int nkeys = si.ctx ? 256 : 1536;
    float m1 = -INFINITY, m2 = -INFINITY, l1 = 0.f, l2 = 0.f, c1 = 0.f, c2 = 0.f;
    float o[64];
#pragma unroll
    for (int d = 0; d < 64; ++d) o[d] = 0.f;
    for (int pass = 0; pass < 2; ++pass) {
        if (pass == 1) { c1 = 1.0f / l1; c2 = lam / l2; }
        for (int k0 = 0; k0 < nkeys; k0 += 16) {
            LDS_WAIT(); asm volatile("" ::: "memory");
#pragma unroll 4
            for (int j = 0; j < 16; ++j) {
                const int kk = k0 + j; float kv, vv;
                if (si.ctx) { const size_t r = (size_t)(si.row0 + kk); kv = bf2f(PB[r * NPB + C_DFK + h * 64 + lane]); vv = bf2f(PB[r * NPB + C_DFV + h * 64 + lane]); }
                else if (kk < 512) { const size_t off = (size_t)((((si.b * NL + l) * 4 + h) * 512 + kk)) * 64 + lane; kv = a.in[I_CK][off]; vv = a.in[I_CV][off]; }
                else {
                    const int tk = kk - 512; const size_t r = (size_t)(si.row0 + tk);
                    const float x = bf2f(PB[r * NPB + C_DFK + h * 64 + lane]); vv = bf2f(PB[r * NPB + C_DFV + h * 64 + lane]);
                    const float xp = swz_xor<0x201F>(x); const int dd = lane & 31;
                    const float cs = ct[tk * 32 + dd], sn = st[tk * 32 + dd];
                    kv = x * cs + ((dd & 8) ? xp : -xp) * sn;
                }
                kts[j * 64 + lane] = kv; vts[j * 64 + lane] = vv;
            }
            LDS_WAIT(); asm volatile("" ::: "memory");
#pragma unroll 1
            for (int j = 0; j < 16; ++j) {
                float s1 = 0.f, s2 = 0.f;
#pragma unroll
                for (int d = 0; d < 32; d += 4) {
                    const f32x4 ka = *(const LAS f32x4*)(kts + j * 64 + d), kb = *(const LAS f32x4*)(kts + j * 64 + 32 + d);
                    s1 += q[d] * ka.x + q[d + 1] * ka.y + q[d + 2] * ka.z + q[d + 3] * ka.w;
                    s2 += q[32 + d] * kb.x + q[32 + d + 1] * kb.y + q[32 + d + 2] * kb.z + q[32 + d + 3] * kb.w;
                }
                if (pass == 0) {
                    const float n1 = fmaxf(m1, s1), n2 = fmaxf(m2, s2);
                    l1 = l1 * expf(m1 - n1) + expf(s1 - n1); l2 = l2 * expf(m2 - n2) + expf(s2 - n2); m1 = n1; m2 = n2;
                } else {
                    const float w = expf(s1 - m1) * c1 - expf(s2 - m2) * c2;
#pragma unroll
                    for (int d = 0; d < 64; d += 4) { const f32x4 v4 = *(const LAS f32x4*)(vts + j * 64 + d); o[d] += w * v4.x; o[d + 1] += w * v4.y; o[d + 2] += w * v4.z; o[d + 3] += w * v4.w; }
                }
            }
        }
    }
    float ms = 0.f;
#pragma unroll
    for (int d = 0; d < 64; ++d) ms += o[d] * o[d];
    const float rs = (1.0f / sqrtf(ms * (1.0f / 64.0f) + 1e-6f)) * (1.0f - lam_init);
    const float* dnw = a.in[I_DFNORM] + (size_t)l * 64;
    bf16* BR = (bf16*)(a.ws + WS_BR) + (size_t)3 * M * 256 + row * 256 + h * 64;
#pragma unroll
    for (int c8 = 0; c8 < 8; ++c8) {
        v4u w;
        w.x = pk2(o[c8 * 8] * rs * dnw[c8 * 8], o[c8 * 8 + 1] * rs * dnw[c8 * 8 + 1]); w.y = pk2(o[c8 * 8 + 2] * rs * dnw[c8 * 8 + 2], o[c8 * 8 + 3] * rs * dnw[c8 * 8 + 3]);
        w.z = pk2(o[c8 * 8 + 4] * rs * dnw[c8 * 8 + 4], o[c8 * 8 + 5] * rs * dnw[c8 * 8 + 5]); w.w = pk2(o[c8 * 8 + 6] * rs * dnw[c8 * 8 + 6], o[c8 * 8 + 7] * rs * dnw[c8 * 8 + 7]);
        *(v4u*)(BR + c8 * 8) = w;
    }
}

#ifdef NO_GLA
#define CALL_GLA
#else
#define CALL_GLA scan_glahg<32, false>(a, l, s, h, sm, lane);
#endif
#ifdef NO_DN
#define CALL_DN
#else
#define CALL_DN scan_dn(a, l, s, h, sm, lane);
#endif
#ifdef NO_HG
#define CALL_HG
#else
#define CALL_HG scan_glahg<64, true>(a, l, s, h, sm, lane);
#endif
#ifdef NO_ATT
#define CALL_ATT
#else
#define CALL_ATT attn_item(a, l, s, h, qb, sm, lane);
#endif
#define SCAN_DISPATCH if (mx == 0) { CALL_GLA } else if (mx == 1) { CALL_DN } else { CALL_HG }
__device__ __forceinline__ void mix_phase(const KArgs& a, int l, LAS unsigned char* lds, int wave, int lane_) {
    LAS float* sm = (LAS float*)(lds + wave * 16384);
    for (int it = wave * 256 + (int)blockIdx.x; it < 1048; it += 256 * NWAVES) {
        int lane = lane_; asm volatile("" : "+v"(lane));
        if (it < 24) { const int mx = it / 8, r = it % 8, s = 32 + r / 4, h = r % 4;
            SCAN_DISPATCH }
        else if (it < 152) { const int r = it - 24, s = 32 + r / 64, h = (r % 64) / 16, qb = r % 16; CALL_ATT }
        else if (it < 536) { const int r = it - 152, mx = r / 128, q = r % 128, s = q / 4, h = q % 4;
            SCAN_DISPATCH }
        else { const int r = it - 536, s = r / 16, h = (r % 16) / 4, qb = r % 4; CALL_ATT }
    }
}

__global__ void diag_scale(float* out, unsigned mask) {
    const size_t offs[8] = {0, 8388608, O_DK, O_DV, O_SG, O_SD, O_SH, O_END};
    for (int k = 0; k < 7; ++k) if (mask & (1u << k)) {
        for (size_t i = offs[k] + blockIdx.x * (size_t)blockDim.x + threadIdx.x; i < offs[k + 1]; i += (size_t)gridDim.x * blockDim.x) out[i] *= 1.3f;
    }
}


__global__ void __launch_bounds__(NWAVES * 64, 2) hyb_fwd(Args args) {
    extern __shared__ __attribute__((aligned(16))) unsigned char lds_raw[];
    LAS unsigned char* lds = (LAS unsigned char*)lds_raw;
    volatile LAS unsigned* MISC = (volatile LAS unsigned*)(lds + MISC_OFF);
    gu32* ctl = (gu32*)(args.ws + WS_CTL);
    for (int u = threadIdx.x; u < (LDS_BYTES - LDSCTL_OFF) / 4; u += NWAVES * 64) ((LAS unsigned*)(lds + LDSCTL_OFF))[u] = 0u;
    __syncthreads();
    XcdBarrier bar; bar.bar = (unsigned*)(ctl + CW_BAR); bar.x = 0; bar.st = nullptr;
#if MK_ONE_LAUNCH
    bar = xcd_barrier_post((unsigned*)(ctl + CW_BAR), MISC + 8);
#endif
    const int lo = args.ph_lo, hi = args.ph_hi;
    for (int ph = lo; ph < hi; ++ph) {
        int tid_ = threadIdx.x; asm volatile("" : "+v"(tid_));
        const int tid = tid_, lane = tid & 63, wave = __builtin_amdgcn_readfirstlane(tid >> 6);
        int bx_ = blockIdx.x; asm volatile("" : "+s"(bx_));
        const int G = gridDim.x, bx = bx_;
        const int vcu = (G % 8 == 0) ? (bx % 8) * (G / 8) + bx / 8 : bx;
        const int gw = vcu * NWAVES + wave;
        const KArgs* ap_ = (const KArgs*)__builtin_amdgcn_kernarg_segment_ptr(); asm volatile("" : "+s"(ap_));
        const KArgs& a = *ap_;
        bf16* Wb = (bf16*)(a.ws + WS_W);
        float* X = a.out + O_Y;
        const float* modf = (const float*)(a.ws + WS_MODF);
        if (ph == 0 || ph == 12) {
#ifndef NO_PRO
 pro_phase(a, ph == 0 ? 0 : 1, lds, gw, wave, lane);
#endif
 }
        else if (ph == 24) { final_phase(a, gw, lane); }
        else {
            const int l = ph < 12 ? 0 : 1, p = ph < 12 ? ph - 1 : ph - 13;
            const bool first = (l == 0);
            if (p == 0) { norm_phase(a, l, 0, lds, gw, tid, lane, first ? a.in[I_XP] : X, first ? a.in[I_XS] : X + (size_t)MP * D); }
            else if (p == 1 || p == 9) {
                pg8::Gemm g{(const pg8::bf16_t*)(a.ws + WS_H), (const pg8::bf16_t*)((char*)Wb + (p == 1 ? W_1A : W_2A)), M, 2 * FF, D};
                pg8::StaticOrder S; S.init(M, 2 * FF, G, bx);
                pg8::EpiSwiglu E{(pg8::bf16_t*)(a.ws + WS_ACT), FF};

#ifndef NO_G1
pg8::gemm_phase<pg8::EpiSwiglu, pg8::StaticOrder, PG8_ALIGN, PG8_SP2, 1024>(lds + RING_OFF, g, S, E);
#endif

            }
            else if (p == 2 || p == 10) {
                pg8::Gemm g{(const pg8::bf16_t*)(a.ws + WS_ACT), (const pg8::bf16_t*)((char*)Wb + (p == 2 ? W_1B : W_2B)), M, D, FF};
                pg8::StaticOrder S; S.init(M, D, G, bx);
                const bool fromin = first && p == 2;
                pg8::EpiResid E{fromin ? a.in[I_XP] : X, fromin ? a.in[I_XS] : X + (size_t)MP * D, X, modf + (size_t)l * 3 * 9216 + (p == 2 ? 2 : 8) * 1024, 0.5f};

#ifndef NO_G2
pg8::gemm_phase<pg8::EpiResid, pg8::StaticOrder, PG8_ALIGN, PG8_SP2>(lds + RING_OFF, g, S, E);
#endif

            }
            else if (p == 3) { norm_phase(a, l, 1, lds, gw, tid, lane, X, X + (size_t)MP * D); }
            else if (p == 4) {
                pg8::Gemm g{(const pg8::bf16_t*)(a.ws + WS_H), (const pg8::bf16_t*)((char*)Wb + W_IN), M, 8192, D};
                pg8::StaticOrder S; S.init(M, 8192, G, bx);
                pg8::EpiInproj E{(pg8::bf16_t*)(a.ws + WS_PB), (float*)(a.ws + WS_PF), (pg8::bf16_t*)(a.ws + WS_GATE), a.out + O_DK, a.out + O_DV, l};

#ifndef NO_G3
pg8::gemm_phase<pg8::EpiInproj, pg8::StaticOrder, PG8_ALIGN, PG8_SP2, 1024>(lds + RING_OFF, g, S, E);
#endif

            }
            else if (p == 5) { mix_phase(a, l, lds, wave, lane); }
            else if (p == 6) {
                pg8::Gemm g{(const pg8::bf16_t*)(a.ws + WS_BR), (const pg8::bf16_t*)((char*)Wb + W_BR), 4 * M, 4096, 256};
                pg8::MergeOrder S{vcu};
                pg8::EpiMerge E{(const pg8::bf16_t*)(a.ws + WS_GATE), (float*)(a.ws + WS_PART), (pg8::bf16_t*)(a.ws + WS_H)};

#ifndef NO_G4
pg8::gemm_phase<pg8::EpiMerge, pg8::MergeOrder, PG8_ALIGN, PG8_SP2, 256>(lds + RING_OFF, g, S, E);
#endif

            }
            else if (p == 7) {
                pg8::Gemm g{(const pg8::bf16_t*)(a.ws + WS_H), (const pg8::bf16_t*)((char*)Wb + W_WO), M, D, D};
                pg8::StaticOrder S; S.init(M, D, G, bx);
                pg8::EpiResid E{X, X + (size_t)MP * D, X, modf + (size_t)l * 3 * 9216 + 5 * 1024, 1.0f};

#ifndef NO_G2
pg8::gemm_phase<pg8::EpiResid, pg8::StaticOrder, PG8_ALIGN, PG8_SP2>(lds + RING_OFF, g, S, E);
#endif

            }
            else if (p == 8) { norm_phase(a, l, 2, lds, gw, tid, lane, X, X + (size_t)MP * D); }
        }
        if (ph + 1 < hi) {
#if MK_ONE_LAUNCH
            xcd_barrier(bar);
#endif
        }
    }
}

extern "C" void kernel_launch(void* const* d_in, const int* in_sizes, int n_in, void* d_out, int out_size, void* d_ws, size_t ws_size, hipStream_t stream) {
    static int grid = 0;
    if (grid == 0) {
        if (n_in != 32 || (size_t)out_size != O_END || ws_size < WS_END) { fprintf(stderr, "kernel_launch: unexpected problem (n_in %d, out %d, ws %zu); nothing launched\n", n_in, out_size, ws_size); grid = -1; return; }
        int dev = 0, cus = 0, per_cu = 0;
        if (hipGetDevice(&dev) != hipSuccess || hipDeviceGetAttribute(&cus, hipDeviceAttributeMultiprocessorCount, dev) != hipSuccess) { grid = -1; return; }
        if (hipFuncSetAttribute((const void*)hyb_fwd, hipFuncAttributeMaxDynamicSharedMemorySize, LDS_BYTES) != hipSuccess) { fprintf(stderr, "kernel_launch: hipFuncSetAttribute failed\n"); grid = -1; return; }
        if (hipOccupancyMaxActiveBlocksPerMultiprocessor(&per_cu, (const void*)hyb_fwd, NWAVES * 64, LDS_BYTES) != hipSuccess || per_cu < 1)
            fprintf(stderr, "kernel_launch: note: occupancy query reports %d workgroups per CU\n", per_cu);
        (void)hipGetLastError();
        grid = cus;
        if (grid != 256) { fprintf(stderr, "kernel_launch: built for a 256-CU device, found %d CUs; nothing launched\n", grid); grid = -1; return; }
    }
    if (grid < 0) return;
    if (hipMemsetAsync((char*)d_ws + WS_CTL, 0, CTL_ZERO_BYTES, stream) != hipSuccess) return;
    Args a{};
    for (int i = 0; i < 32; ++i) a.in[i] = (const float*)d_in[i];
    a.out = (float*)d_out; a.ws = (unsigned char*)d_ws;
#if MK_ONE_LAUNCH
    a.ph_lo = 0; a.ph_hi = NPHASE;
    hipLaunchKernelGGL(hyb_fwd, dim3(grid), dim3(NWAVES * 64), LDS_BYTES, stream, a);
#else
    for (int p = 0; p < NPHASE; ++p) { a.ph_lo = p; a.ph_hi = p + 1; hipLaunchKernelGGL(hyb_fwd, dim3(grid), dim3(NWAVES * 64), LDS_BYTES, stream, a); }
#endif
#ifdef DIAG_MASK
    diag_scale<<<1024, 256, 0, stream>>>((float*)d_out, DIAG_MASK);
#endif
}
```

```cpp
#include <hip/hip_runtime.h>
#include <cstdio>
#include <cstdint>
#include <cmath>
namespace pg8 {
#define PG8_LAS __attribute__((address_space(3)))
typedef unsigned short bf16_t;
typedef short bf16x8 __attribute__((ext_vector_type(8)));
typedef float f32x4 __attribute__((ext_vector_type(4)));
typedef unsigned u32x4 __attribute__((ext_vector_type(4)));
constexpr int BM = 256, BK = 64, HALF = 128, HTB = HALF * BK * 2  , STAGE_BYTES = 8 * HTB, NXCD = 8, WGM = 8;

__host__ __device__ __forceinline__ int lds_byte(int r, int c) { const int st = (r >> 4) * 2 + (c >> 5), rr = r & 15, cc = c & 31, ob = rr * 64 + cc * 2; return st * 1024 + (ob ^ (((ob >> 9) & 1) << 5)); }
__host__ __device__ __forceinline__ void stage_rc(int b, int& R, int& C) { const int st = b / 1024, sb = b % 1024, swz = sb ^ (((sb >> 9) & 1) << 5); R = (st >> 1) * 16 + swz / 64; C = (st & 1) * 32 + (swz % 64) / 2; }
__host__ __device__ __forceinline__ int perm32(int rho) { const int n = rho >> 4, i = rho & 15; return 8 * (i >> 2) + 4 * n + (i & 3); }

__device__ __forceinline__ int pg8_hw_lane() { int r; asm volatile("v_mbcnt_lo_u32_b32 %0, -1, 0\n\tv_mbcnt_hi_u32_b32 %0, -1, %0" : "=v"(r)); return r; }
struct Unit { int pm, pn; };
struct Gemm { const bf16_t* A; const bf16_t* Bt; int M, N, K; };

struct StaticOrder {
    int nM, nN, nwg, G, c, wgm;
    __host__ __device__ void init(int M, int N, int G_, int c_, int wgm_ = WGM) { nM = M / BM; nN = N / BM; nwg = nM * nN; G = G_; c = c_; wgm = wgm_; }
    __host__ __device__ bool next(int i, Unit& u) const {
        const long L = (long)i * G + c; if (L >= nwg) return false;
        int wgid = (int)L; { const int q = nwg / NXCD, r = nwg % NXCD, xcd = wgid % NXCD, off = wgid / NXCD; wgid = (xcd < r ? xcd * (q + 1) : r * (q + 1) + (xcd - r) * q) + off; }
        const int nig = wgm * nN, gid = wgid / nig, fm = gid * wgm, gsz = (nM - fm) < wgm ? (nM - fm) : wgm;
        u.pm = fm + ((wgid % nig) % gsz); u.pn = (wgid % nig) / gsz; return true;
    }
    __device__ __forceinline__ void a_ready(const Unit&) const {}
    __device__ __forceinline__ void done(const Unit&) const {}
};


typedef unsigned u32x2 __attribute__((ext_vector_type(2)));
typedef float f32x2e_t __attribute__((ext_vector_type(2))); typedef __bf16 bf16x2e_t __attribute__((ext_vector_type(2)));
__device__ __forceinline__ unsigned pk_bf16(float lo, float hi) { f32x2e_t v = {lo, hi}; bf16x2e_t b = __builtin_convertvector(v, bf16x2e_t); return __builtin_bit_cast(unsigned, b); }
__device__ __forceinline__ float bf_lo(unsigned w) { return __builtin_bit_cast(float, w << 16); }
__device__ __forceinline__ float bf_hi(unsigned w) { return __builtin_bit_cast(float, w & 0xffff0000u); }
__device__ __forceinline__ float swz16(float x) { return __builtin_bit_cast(float, __builtin_amdgcn_ds_swizzle(__builtin_bit_cast(int, x), 0x401F)); }
__device__ __forceinline__ float fast_sigmoid(float x) { return __builtin_amdgcn_rcpf(1.0f + __expf(-x)); }

template <bool FOLD>
struct EpiSwigluT {
    static constexpr bool PERM = true, AFTER_DRAIN = false;
    bf16_t* O; int ldo; const float* ss; const float* bias;
    __device__ __forceinline__ void operator()(const f32x4 (&acc)[2][2][4][2], const Unit& u, int wr, int wc, int fr, int fq) const {
        const int row0 = u.pm * BM + wr * 64 + fr, col0 = u.pn * HALF + wc * 32 + 8 * fq;
        float rs[2][4] = {{1.f, 1.f, 1.f, 1.f}, {1.f, 1.f, 1.f, 1.f}};
        f32x4 bg[2] = {{0.f, 0.f, 0.f, 0.f}, {0.f, 0.f, 0.f, 0.f}}, bu[2] = {{0.f, 0.f, 0.f, 0.f}, {0.f, 0.f, 0.f, 0.f}};
        if constexpr (FOLD) {
            const int grp = u.pm < 32 ? 0 : 1 + ((u.pm - 32) >> 2);
            const float* bp = bias + grp * 8192 + u.pn * BM + wc * 32 + 8 * fq;
            bg[0] = *(const f32x4*)bp; bg[1] = *(const f32x4*)(bp + 4); bu[0] = *(const f32x4*)(bp + HALF); bu[1] = *(const f32x4*)(bp + HALF + 4);
#pragma unroll
            for (int ai = 0; ai < 2; ++ai)
#pragma unroll
                for (int m = 0; m < 4; ++m) { const f32x4 q = *(const f32x4*)(ss + (size_t)(row0 + ai * HALF + m * 16) * 4); rs[ai][m] = (q.x + q.y) + (q.z + q.w); }
#pragma unroll
            for (int ai = 0; ai < 2; ++ai)
#pragma unroll
                for (int m = 0; m < 4; ++m) rs[ai][m] = __builtin_amdgcn_rsqf(rs[ai][m] * (1.0f / 1024.0f) + 1e-6f);
        }
#pragma unroll
        for (int ai = 0; ai < 2; ++ai)
#pragma unroll
            for (int m = 0; m < 4; ++m) {
                int row = row0 + ai * HALF + m * 16; asm volatile("" : "+v"(row));
                bf16_t* rowp = O + (size_t)row * ldo + col0;
                float v[8];
#pragma unroll
                for (int n = 0; n < 2; ++n)
#pragma unroll
                    for (int j = 0; j < 4; ++j) { const float g = acc[ai][0][m][n][j] * rs[ai][m] + bg[n][j], up = acc[ai][1][m][n][j] * rs[ai][m] + bu[n][j]; v[n * 4 + j] = g * fast_sigmoid(g) * up; }
                u32x4 w; w.x = pk_bf16(v[0], v[1]); w.y = pk_bf16(v[2], v[3]); w.z = pk_bf16(v[4], v[5]); w.w = pk_bf16(v[6], v[7]);
                *(u32x4*)rowp = w;
            }
    }
};

template <bool NEXT, bool HALFMUL, bool FROMIN, bool NOX>
struct EpiResidT {
    static constexpr bool PERM = true, AFTER_DRAIN = false;
    const float* baseP; const float* baseS; bf16_t* xb; float* outf; const float* scale;
    const float* csn; bf16_t* Hn; PG8_LAS float* lred;
    __device__ __forceinline__ void operator()(const f32x4 (&acc)[2][2][4][2], const Unit& u, int wr, int wc, int fr, int fq) const {
        const int grp = u.pm < 32 ? 0 : 1 + ((u.pm - 32) >> 2);
        const float* sc = scale + grp * 9216;
        const float* base = u.pm < 32 ? baseP : baseS - (size_t)8192 * 1024;
        const int row0 = u.pm * BM + wr * 64 + fr, col0 = u.pn * BM + wc * 32 + 8 * fq;
        float rsq[2][4] = {{0.f, 0.f, 0.f, 0.f}, {0.f, 0.f, 0.f, 0.f}};
#pragma unroll
        for (int bj = 0; bj < 2; ++bj) {
            const int col = col0 + bj * HALF;
            u32x4 bh[2][4];
            if constexpr (!FROMIN) {
#pragma unroll
                for (int ai = 0; ai < 2; ++ai)
#pragma unroll
                    for (int m = 0; m < 4; ++m) { int row = row0 + ai * HALF + m * 16; asm volatile("" : "+v"(row)); bh[ai][m] = *(const u32x4*)(xb + (size_t)row * 1024 + col); }
            }
            const f32x4 s0 = *(const f32x4*)(sc + col) * (HALFMUL ? 0.5f : 1.0f), s1 = *(const f32x4*)(sc + col + 4) * (HALFMUL ? 0.5f : 1.0f);
            f32x4 c0 = {0.f, 0.f, 0.f, 0.f}, c1 = c0;
            if constexpr (NEXT) { c0 = *(const f32x4*)(csn + grp * 1024 + col); c1 = *(const f32x4*)(csn + grp * 1024 + col + 4); }
#pragma unroll
            for (int ai = 0; ai < 2; ++ai) {
                f32x4 b0[4], b1[4];
                if constexpr (FROMIN) {
#pragma unroll
                    for (int m = 0; m < 4; ++m) { int row = row0 + ai * HALF + m * 16; asm volatile("" : "+v"(row)); const float* p = base + (size_t)row * 1024 + col; b0[m] = *(const f32x4*)p; b1[m] = *(const f32x4*)(p + 4); }
                }
#pragma unroll
                for (int m = 0; m < 4; ++m) {
                    int row = row0 + ai * HALF + m * 16; asm volatile("" : "+v"(row));
                    const size_t off = (size_t)row * 1024 + col;
                    if constexpr (!FROMIN) {
                        const u32x4 w = bh[ai][m];
                        b0[m].x = bf_lo(w.x); b0[m].y = bf_hi(w.x); b0[m].z = bf_lo(w.y); b0[m].w = bf_hi(w.y); b1[m].x = bf_lo(w.z); b1[m].y = bf_hi(w.z); b1[m].z = bf_lo(w.w); b1[m].w = bf_hi(w.w);
                    }
                    const f32x4 o0 = b0[m] + s0 * acc[ai][bj][m][0], o1 = b1[m] + s1 * acc[ai][bj][m][1];
                    if constexpr (!NOX) { u32x4 xw; xw.x = pk_bf16(o0.x, o0.y); xw.y = pk_bf16(o0.z, o0.w); xw.z = pk_bf16(o1.x, o1.y); xw.w = pk_bf16(o1.z, o1.w); *(u32x4*)(xb + off) = xw; }
                    if constexpr (NEXT) {
                        rsq[ai][m] += ((o0.x * o0.x + o0.y * o0.y) + (o0.z * o0.z + o0.w * o0.w)) + ((o1.x * o1.x + o1.y * o1.y) + (o1.z * o1.z + o1.w * o1.w));
                        const f32x4 t0 = o0 * c0, t1 = o1 * c1; u32x4 w; w.x = pk_bf16(t0.x, t0.y); w.y = pk_bf16(t0.z, t0.w); w.z = pk_bf16(t1.x, t1.y); w.w = pk_bf16(t1.z, t1.w);
                        *(u32x4*)(Hn + off) = w;
                    }
                }
                if constexpr (FROMIN) asm volatile("" ::: "memory");
            }
            asm volatile("" ::: "memory");
        }
        if constexpr (NEXT) {
#pragma unroll
            for (int ai = 0; ai < 2; ++ai)
#pragma unroll
                for (int m = 0; m < 4; ++m) {
                    const float s = rsq[ai][m] + swz16(rsq[ai][m]);
                    if (!(fq & 1)) lred[(wc * 2 + (fq >> 1)) * 256 + wr * 64 + ai * HALF + m * 16 + fr] = s;
                }
        }
    }
};

struct EpiInproj {
    static constexpr bool PERM = true, AFTER_DRAIN = false;
    bf16_t* PB; float* PF; bf16_t* G; float* dk; float* dv; int layer; const float* rope; const float* ss; const float* bias;
    __device__ __forceinline__ void operator()(const f32x4 (&acc)[2][2][4][2], const Unit& u, int wr, int wc, int fr, int fq) const {
        const int row0 = u.pm * BM + wr * 64 + fr;
        const int grp = u.pm < 32 ? 0 : 1 + ((u.pm - 32) >> 2);
        const float* bp = bias + grp * 8192 + u.pn * BM + wc * 32 + 8 * fq;
        const f32x4 bb[2][2] = {{*(const f32x4*)bp, *(const f32x4*)(bp + 4)}, {*(const f32x4*)(bp + HALF), *(const f32x4*)(bp + HALF + 4)}};
        float rsv[2][4];
#pragma unroll
        for (int ai = 0; ai < 2; ++ai)
#pragma unroll
            for (int m = 0; m < 4; ++m) { const f32x4 q = *(const f32x4*)(ss + (size_t)(row0 + ai * HALF + m * 16) * 4); rsv[ai][m] = (q.x + q.y) + (q.z + q.w); }
#pragma unroll
        for (int ai = 0; ai < 2; ++ai)
#pragma unroll
            for (int m = 0; m < 4; ++m) rsv[ai][m] = __builtin_amdgcn_rsqf(rsv[ai][m] * (1.0f / 1024.0f) + 1e-6f);
        if (u.pn < 13) {
            const int col0 = u.pn * BM + wc * 32 + 8 * fq;
#pragma unroll
            for (int ai = 0; ai < 2; ++ai)
#pragma unroll
                for (int m = 0; m < 4; ++m) {
                    int row = row0 + ai * HALF + m * 16; asm volatile("" : "+v"(row));
                    const float rs = rsv[ai][m];
#pragma unroll
                    for (int bj = 0; bj < 2; ++bj) {
                        f32x4 v0 = acc[ai][bj][m][0] * rs + bb[bj][0], v1 = acc[ai][bj][m][1] * rs + bb[bj][1];
#ifndef PROBE_NO_EPI_ROPE
                        if ((u.pn == 10 || u.pn == 11) && u.pm >= 32) {
                            const int t = row & 1023;
                            const float* cp = rope + t * 32 + 8 * fq; const float* sp = cp + 1024 * 32;
                            const f32x4 c0 = *(const f32x4*)cp, c1 = *(const f32x4*)(cp + 4), s0 = *(const f32x4*)sp, s1 = *(const f32x4*)(sp + 4);
                            f32x4 p0, p1;
#pragma unroll
                            for (int j = 0; j < 4; ++j) { const float a_ = v0[j], b_ = v1[j]; p0[j] = swz16(a_); p1[j] = swz16(b_); }
                            const float sg = (fq & 1) ? 1.0f : -1.0f;
                            v0 = v0 * c0 + p0 * s0 * sg; v1 = v1 * c1 + p1 * s1 * sg;
                        }
#endif
                        u32x4 w; w.x = pk_bf16(v0[0], v0[1]); w.y = pk_bf16(v0[2], v0[3]); w.z = pk_bf16(v1[0], v1[1]); w.w = pk_bf16(v1[2], v1[3]);
                        *(u32x4*)(PB + (size_t)row * 3328 + col0 + bj * HALF) = w;
                        if (u.pn >= 11 && u.pm < 32) {
                            float* o = (u.pn == 11) ? dk : dv;
                            const int hd = bj * 2 + (wc >> 1), d = (wc & 1) * 32 + 8 * fq, b = row >> 8, t = row & 255;
                            float* p = o + ((size_t)(((b * 2 + layer) * 4 + hd) * 256 + t)) * 64 + d;
                            *(f32x4*)p = v0; *(f32x4*)(p + 4) = v1;
                        }
                    }
                }
        } else if (u.pn < 16) {
            const int col0 = (u.pn - 13) * BM + wc * 32 + 8 * fq;
#pragma unroll
            for (int ai = 0; ai < 2; ++ai)
#pragma unroll
                for (int m = 0; m < 4; ++m) {
                    int row = row0 + ai * HALF + m * 16; asm volatile("" : "+v"(row));
                    const float rs = rsv[ai][m];
#pragma unroll
                    for (int bj = 0; bj < 2; ++bj) {
                        const int col = col0 + bj * HALF;
                        if (col < 576) { float* p = PF + (size_t)row * 576 + col; *(f32x4*)p = acc[ai][bj][m][0] * rs + bb[bj][0]; *(f32x4*)(p + 4) = acc[ai][bj][m][1] * rs + bb[bj][1]; }
                    }
                }
        } else {
            const int col0 = (u.pn - 16) * BM + wc * 32 + 8 * fq;
#pragma unroll
            for (int ai = 0; ai < 2; ++ai)
#pragma unroll
                for (int m = 0; m < 4; ++m) {
                    int row = row0 + ai * HALF + m * 16; asm volatile("" : "+v"(row));
                    const float rs = rsv[ai][m];
#pragma unroll
                    for (int bj = 0; bj < 2; ++bj) {
                        float v[8];
                        const f32x4 b0 = bb[bj][0], b1 = bb[bj][1];
#pragma unroll
                        for (int j = 0; j < 4; ++j) { v[j] = fast_sigmoid(acc[ai][bj][m][0][j] * rs + b0[j]); v[4 + j] = fast_sigmoid(acc[ai][bj][m][1][j] * rs + b1[j]); }
                        u32x4 w; w.x = pk_bf16(v[0], v[1]); w.y = pk_bf16(v[2], v[3]); w.z = pk_bf16(v[4], v[5]); w.w = pk_bf16(v[6], v[7]);
                        *(u32x4*)(G + (size_t)row * 4096 + col0 + bj * HALF) = w;
                    }
                }
        }
    }
};

struct EpiMerge {
    static constexpr bool PERM = true, AFTER_DRAIN = false;
    const bf16_t* G; bf16_t* P; bf16_t* MG;
    __device__ __forceinline__ void operator()(const f32x4 (&acc)[2][2][4][2], const Unit& u, int wr, int wc, int fr, int fq) const {
        const int n = u.pm / 40, pm = u.pm - n * 40, pn = u.pn & 3;
        const int row0 = pm * BM + wr * 64 + fr, col0 = pn * BM + wc * 32 + 8 * fq;
        bf16_t* dst = (n < 3) ? P : MG;
#pragma unroll
        for (int ai = 0; ai < 2; ++ai)
#pragma unroll
          for (int mh = 0; mh < 2; ++mh) {
            u32x4 gw[2][2], pw[2][2];
#pragma unroll
            for (int ml = 0; ml < 2; ++ml) {
                int row = row0 + ai * HALF + (mh * 2 + ml) * 16; asm volatile("" : "+v"(row));
#pragma unroll
                for (int bj = 0; bj < 2; ++bj) {
                    const int col = col0 + bj * HALF;
                    gw[ml][bj] = *(const u32x4*)(G + (size_t)row * 4096 + n * 1024 + col);
                    if (n > 0) pw[ml][bj] = *(const u32x4*)(P + (size_t)row * 1024 + col);
                }
            }
#pragma unroll
            for (int ml = 0; ml < 2; ++ml) {
                const int m = mh * 2 + ml;
                int row = row0 + ai * HALF + m * 16; asm volatile("" : "+v"(row));
#pragma unroll
                for (int bj = 0; bj < 2; ++bj) {
                    const int col = col0 + bj * HALF;
                    const u32x4 g4 = gw[ml][bj];
                    f32x4 v0 = acc[ai][bj][m][0], v1 = acc[ai][bj][m][1];
                    v0[0] *= bf_lo(g4.x); v0[1] *= bf_hi(g4.x); v0[2] *= bf_lo(g4.y); v0[3] *= bf_hi(g4.y);
                    v1[0] *= bf_lo(g4.z); v1[1] *= bf_hi(g4.z); v1[2] *= bf_lo(g4.w); v1[3] *= bf_hi(g4.w);
                    if (n > 0) { const u32x4 p4 = pw[ml][bj];
                        v0[0] += bf_lo(p4.x); v0[1] += bf_hi(p4.x); v0[2] += bf_lo(p4.y); v0[3] += bf_hi(p4.y); v1[0] += bf_lo(p4.z); v1[1] += bf_hi(p4.z); v1[2] += bf_lo(p4.w); v1[3] += bf_hi(p4.w); }
                    u32x4 w; w.x = pk_bf16(v0[0], v0[1]); w.y = pk_bf16(v0[2], v0[3]); w.z = pk_bf16(v1[0], v1[1]); w.w = pk_bf16(v1[2], v1[3]);
                    *(u32x4*)(dst + (size_t)row * 1024 + col) = w;
                }
            }
            asm volatile("" ::: "memory");
        }
    }
};
struct MergeOrder {
    int c;
    __device__ __forceinline__ bool next(int i, Unit& u) const { if (c >= 160 || i >= 4) return false; u.pm = i * 40 + (c >> 2); u.pn = i * 4 + (c & 3); return true; }
    __device__ __forceinline__ void a_ready(const Unit&) const {}
    __device__ __forceinline__ void done(const Unit&) const {}
};

template <class Epi, class Sched, bool ALIGN_EPI = false, bool SP2 = false, int KC = 0>
__device__ __forceinline__ void gemm_phase(PG8_LAS unsigned char* lds, const Gemm g, const Sched& S, const Epi& E, int wv  ) {
    int tid_ = wv * 64 + pg8_hw_lane(); asm volatile("" : "+v"(tid_));
    const int tid = tid_, wid = __builtin_amdgcn_readfirstlane(tid >> 6), lane = tid & 63, wr = wid >> 2, wc = wid & 3, fr = lane & 15, fq = lane >> 4;
    const int K = KC > 0 ? KC : g.K, nt = K / BK;
    unsigned voffA[2], voffB[2];
#pragma unroll
    for (int i = 0; i < 2; ++i) { int R, C; stage_rc(tid * 16 + i * 8192, R, C); const int Rb = Epi::PERM ? ((R & ~31) + perm32(R & 31)) : R;
        voffA[i] = (unsigned)(R * K + C) * 2u; voffB[i] = (unsigned)(Rb * K + C) * 2u; }
    const size_t kstep = (size_t)(BK * 2);
    const size_t hstep = (size_t)HALF * K * 2;
    const size_t tstep = 2 * hstep;
    const unsigned ldsw = (unsigned)wid * 1024u;
    const int aoff = lds_byte(wr * 64 + fr, fq * 8), boff = lds_byte(wc * 32 + fr, fq * 8);
#define PG8_SA(b, h) (((b) * 2 + (h)) * HTB)
#define PG8_SB(b, h) ((4 + (b) * 2 + (h)) * HTB)
#define PG8_STAGE(bufoff, gbase, voff) do { _Pragma("unroll") for (int _i = 0; _i < 2; ++_i) { unsigned _vo = (voff)[_i]; asm volatile("" : "+v"(_vo));     \
        __builtin_amdgcn_global_load_lds((const unsigned*)((const char*)(gbase) + _vo), (PG8_LAS unsigned*)(lds + (bufoff) + ldsw + _i * 8192), 16, 0, 0); } } while (0)
#define PG8_LDA(dst, b, h) do { _Pragma("unroll") for (int m = 0; m < 4; ++m) _Pragma("unroll") for (int k = 0; k < 2; ++k) dst[m][k] = *(const PG8_LAS bf16x8*)(lds + PG8_SA(b, h) + aoff + m * 2048 + k * 1024); } while (0)
#define PG8_LDB(dst, b, h) do { _Pragma("unroll") for (int n = 0; n < 2; ++n) _Pragma("unroll") for (int k = 0; k < 2; ++k) dst[n][k] = *(const PG8_LAS bf16x8*)(lds + PG8_SB(b, h) + boff + n * 2048 + k * 1024); } while (0)
#define PG8_MMA(ai, bj, At, Bt) do { __builtin_amdgcn_s_setprio(1); _Pragma("unroll") for (int m = 0; m < 4; ++m) _Pragma("unroll") for (int n = 0; n < 2; ++n) _Pragma("unroll") for (int k = 0; k < 2; ++k) \
        acc[ai][bj][m][n] = __builtin_amdgcn_mfma_f32_16x16x32_bf16(Bt[n][k], At[m][k], acc[ai][bj][m][n], 0, 0, 0); __builtin_amdgcn_s_setprio(0); } while (0)
#define PG8_WAIT_V(n) asm volatile("s_waitcnt vmcnt(" #n ")" ::: "memory")
#define PG8_WAIT_L(n) asm volatile("s_waitcnt lgkmcnt(" #n ")" ::: "memory")
#define PG8_BAR __builtin_amdgcn_s_barrier()
#define PG8_SCHED __builtin_amdgcn_sched_barrier(0)
    Unit cur, nxt; int ui = 0;
    if (!S.next(0, cur)) return;
    f32x4 acc[2][2][4][2];
#pragma unroll
    for (int a = 0; a < 2; ++a)
#pragma unroll
        for (int b = 0; b < 2; ++b)
#pragma unroll
            for (int m = 0; m < 4; ++m)
#pragma unroll
                for (int n = 0; n < 2; ++n) acc[a][b][m][n] = (f32x4){0.f, 0.f, 0.f, 0.f};
    bf16x8 At[4][2], B0[2][2], B1[2][2];
    const char* cA = (const char*)g.A + (size_t)cur.pm * tstep; const char* cB = (const char*)g.Bt + (size_t)cur.pn * tstep;
    S.a_ready(cur);
    if constexpr (SP2) {
        PG8_STAGE(PG8_SB(0, 0), cB, voffB); PG8_STAGE(PG8_SB(0, 1), cB + hstep, voffB); PG8_STAGE(PG8_SA(0, 0), cA, voffA); PG8_STAGE(PG8_SA(0, 1), cA + hstep, voffA);
        if (wr == 1) PG8_BAR;
        PG8_WAIT_V(2); PG8_BAR;
        PG8_STAGE(PG8_SB(1, 0), cB + kstep, voffB); PG8_STAGE(PG8_SA(1, 0), cA + kstep, voffA); PG8_STAGE(PG8_SB(1, 1), cB + hstep + kstep, voffB);
        PG8_WAIT_V(6); PG8_BAR;
    } else {
        PG8_STAGE(PG8_SB(0, 0), cB, voffB); PG8_STAGE(PG8_SA(0, 0), cA, voffA); PG8_STAGE(PG8_SB(0, 1), cB + hstep, voffB); PG8_STAGE(PG8_SA(0, 1), cA + hstep, voffA);
        if (wr == 1) PG8_BAR;
        PG8_WAIT_V(4); PG8_BAR;
        PG8_STAGE(PG8_SB(1, 0), cB + kstep, voffB); PG8_STAGE(PG8_SA(1, 0), cA + kstep, voffA); PG8_STAGE(PG8_SB(1, 1), cB + hstep + kstep, voffB);
        PG8_WAIT_V(6); PG8_BAR;
    }
    for (;;) {
        const bool has_next = S.next(ui + 1, nxt);
        const char* nA = has_next ? (const char*)g.A + (size_t)nxt.pm * tstep : cA; const char* nB = has_next ? (const char*)g.Bt + (size_t)nxt.pn * tstep : cB;
        for (int t = 0; t < nt; t += 2) {
            const bool last = (t == nt - 2);
            const char* a1 = cA + (size_t)(t + 1) * kstep;
            const char* a2 = last ? nA : cA + (size_t)(t + 2) * kstep; const char* b2 = last ? nB : cB + (size_t)(t + 2) * kstep;
            const char* a3 = a2 + kstep; const char* b3 = b2 + kstep;
            if (last && has_next) S.a_ready(nxt);
            if constexpr (SP2) {
            PG8_LDB(B0, 0, 0); PG8_LDB(B1, 0, 1); PG8_SCHED; PG8_LDA(At, 0, 0); PG8_STAGE(PG8_SA(1, 1), a1 + hstep, voffA);
            PG8_WAIT_V(8); PG8_WAIT_L(0); PG8_BAR; PG8_MMA(0, 0, At, B0); PG8_MMA(0, 1, At, B1); PG8_BAR; PG8_SCHED;
            PG8_LDA(At, 0, 1); PG8_STAGE(PG8_SB(0, 0), b2, voffB); PG8_STAGE(PG8_SB(0, 1), b2 + hstep, voffB); PG8_STAGE(PG8_SA(0, 0), a2, voffA);
            PG8_WAIT_V(8); PG8_WAIT_L(0); PG8_BAR; PG8_MMA(1, 0, At, B0); PG8_MMA(1, 1, At, B1); PG8_BAR; PG8_SCHED;
            PG8_LDB(B0, 1, 0); PG8_LDB(B1, 1, 1); PG8_SCHED; PG8_LDA(At, 1, 0); PG8_STAGE(PG8_SA(0, 1), a2 + hstep, voffA);
            PG8_WAIT_V(8); PG8_WAIT_L(0); PG8_BAR; PG8_MMA(0, 0, At, B0); PG8_MMA(0, 1, At, B1); PG8_BAR; PG8_SCHED;
            PG8_LDA(At, 1, 1); PG8_STAGE(PG8_SB(1, 0), b3, voffB); PG8_STAGE(PG8_SB(1, 1), b3 + hstep, voffB); PG8_STAGE(PG8_SA(1, 0), a3, voffA);
            PG8_WAIT_V(8); PG8_WAIT_L(0); PG8_BAR; PG8_MMA(1, 0, At, B0); PG8_MMA(1, 1, At, B1); PG8_BAR; PG8_SCHED;
            } else {
            PG8_LDB(B0, 0, 0); PG8_SCHED; PG8_LDA(At, 0, 0); PG8_STAGE(PG8_SA(1, 1), a1 + hstep, voffA);
            PG8_WAIT_L(8); PG8_BAR; PG8_WAIT_L(0); PG8_MMA(0, 0, At, B0); PG8_BAR; PG8_SCHED;
            PG8_LDB(B1, 0, 1); PG8_STAGE(PG8_SB(0, 0), b2, voffB);
            PG8_BAR; PG8_WAIT_L(0); PG8_MMA(0, 1, At, B1); PG8_BAR;
            PG8_LDA(At, 0, 1); PG8_STAGE(PG8_SA(0, 0), a2, voffA);
            PG8_BAR; PG8_WAIT_L(0); PG8_MMA(1, 0, At, B0); PG8_BAR; PG8_SCHED;
            PG8_STAGE(PG8_SB(0, 1), b2 + hstep, voffB);
            PG8_WAIT_V(6); PG8_BAR; PG8_MMA(1, 1, At, B1); PG8_BAR;
            PG8_LDB(B0, 1, 0); PG8_SCHED; PG8_LDA(At, 1, 0); PG8_STAGE(PG8_SA(0, 1), a2 + hstep, voffA);
            PG8_WAIT_L(8); PG8_BAR; PG8_WAIT_L(0); PG8_MMA(0, 0, At, B0); PG8_BAR; PG8_SCHED;
            PG8_LDB(B1, 1, 1); PG8_STAGE(PG8_SB(1, 0), b3, voffB);
            PG8_BAR; PG8_WAIT_L(0); PG8_MMA(0, 1, At, B1); PG8_BAR;
            PG8_LDA(At, 1, 1); PG8_STAGE(PG8_SA(1, 0), a3, voffA);
            PG8_BAR; PG8_WAIT_L(0); PG8_MMA(1, 0, At, B0); PG8_BAR; PG8_SCHED;
            PG8_STAGE(PG8_SB(1, 1), b3 + hstep, voffB);
            PG8_WAIT_V(6); PG8_BAR; PG8_MMA(1, 1, At, B1); PG8_BAR;
            }
        }
        if constexpr (ALIGN_EPI) { if (wr == 0) PG8_BAR; }
        if constexpr (!Epi::AFTER_DRAIN) { int t3_ = wv * 64 + pg8_hw_lane(); asm volatile("" : "+v"(t3_)); const int l3_ = t3_ & 63, w3_ = __builtin_amdgcn_readfirstlane(t3_ >> 6);
            E(acc, cur, w3_ >> 2, w3_ & 3, l3_ & 15, l3_ >> 4); S.done(cur); }
        if (!has_next) break;
#pragma unroll
        for (int a = 0; a < 2; ++a)
#pragma unroll
            for (int b = 0; b < 2; ++b)
#pragma unroll
                for (int m = 0; m < 4; ++m)
#pragma unroll
                    for (int n = 0; n < 2; ++n) acc[a][b][m][n] = (f32x4){0.f, 0.f, 0.f, 0.f};
        cur = nxt; cA = nA; cB = nB; ++ui;
        if constexpr (ALIGN_EPI) { if (wr == 1) PG8_BAR; }
    }
    PG8_WAIT_V(0);
    if constexpr (!ALIGN_EPI) { if (wr == 0) PG8_BAR; }
    PG8_BAR;
    if constexpr (Epi::AFTER_DRAIN) { E.fused(acc, cur, wr, wc, fr, fq, lds, wid, lane); S.done(cur); }
#undef PG8_SA
#undef PG8_SB
#undef PG8_STAGE
#undef PG8_LDA
#undef PG8_LDB
#undef PG8_MMA
#undef PG8_WAIT_V
#undef PG8_WAIT_L
#undef PG8_BAR
#undef PG8_SCHED
}
}

#ifndef PG8_SP2
#define PG8_SP2 true
#endif
#ifndef PG8_ALIGN
#define PG8_ALIGN true
#endif
constexpr int NWAVES = 8;
#ifndef MK_ONE_LAUNCH
#define MK_ONE_LAUNCH 1
#endif

constexpr int NL = 2;
constexpr int M = 10240, MP = 8192;
constexpr int D = 1024, FF = 2816;
constexpr int NPB = 3328, NPF = 576, NGT = 4096;
constexpr int NSEQ = 34;
constexpr int NPHASE = 23;
constexpr int C_GAQ = 0, C_GAK = 128, C_GAV = 256, C_GAR = 512, C_DNX = 768, C_DNG = 1536, C_HGQ = 1792, C_HGI = 2048, C_HGG = 2304, C_DFQ = 2560, C_DFK = 2816, C_DFV = 3072;
constexpr int F_LR = 0, F_DNB = 32, F_DNA = 40, F_HGF = 48;
constexpr size_t O_Y = 0, O_DK = 10485760, O_DV = 14680064, O_SG = 18874368, O_SD = 19922944, O_SH = 22020096, O_END = 24117248;

constexpr size_t MiB = 1u << 20;
constexpr size_t WS_CTL = 0, CTL_ZERO_BYTES = 64 * 1024;
constexpr size_t WS_MODP = 1 * MiB;
constexpr size_t WS_MODF = 3 * MiB;
constexpr size_t WS_ROPE = 3 * MiB + 512 * 1024;
constexpr size_t WS_W = 4 * MiB;
constexpr size_t W_1A = 0, W_1B = W_1A + (size_t)5632 * 1024 * 2, W_IN = W_1B + (size_t)1024 * 2816 * 2, W_BR = W_IN + (size_t)8192 * 1024 * 2,
                 W_WO = W_BR + (size_t)4096 * 256 * 2, W_2A = W_WO + (size_t)1024 * 1024 * 2, W_2B = W_2A + (size_t)5632 * 1024 * 2, W_END = W_2B + (size_t)1024 * 2816 * 2;
static_assert(W_END <= 56 * MiB, "weights fit");
constexpr size_t WS_H = 60 * MiB;
constexpr size_t WS_BR = 80 * MiB;
constexpr size_t WS_GATE = 100 * MiB;
constexpr size_t WS_PB = 180 * MiB;
constexpr size_t WS_PF = 245 * MiB;
constexpr size_t WS_OSC = 268 * MiB;
constexpr size_t WS_KVC = 298 * MiB;
constexpr size_t WS_HIMG = 300 * MiB;
constexpr size_t WS_DNI1 = 321 * MiB;
constexpr size_t WS_END = 327 * MiB;
constexpr size_t WS_DNI0 = 71 * MiB;
constexpr size_t WS_GIMG = 60 * MiB;
constexpr size_t WS_DNT = 80 * MiB;
constexpr size_t WS_ACT = WS_PB, WS_PART = WS_PB;
constexpr size_t WS_XF = WS_GATE;
constexpr int CW_TMO = 0, CW_CODE = 1, CW_BAR = 4096;
constexpr size_t WS_SSP = 299 * MiB;
constexpr size_t WS_BIAS = WS_CTL + 272 * 1024;
constexpr size_t WS_CSV = WS_MODF + 256 * 1024;
constexpr int LRED_OFF = 131072;
static_assert(6 * 10240 * 16 <= 1024 * 1024 && 272 * 1024 + 5 * 3 * 8192 * 4 <= 1024 * 1024, "ssp / bias regions");

constexpr int RING_OFF = 0, RING_BYTES = 131072;
constexpr int LDSCTL_OFF = 155648, MISC_OFF = LDSCTL_OFF + 320;
constexpr int LDS_BYTES = 163840;

#define GAS __attribute__((address_space(1)))
#define LAS __attribute__((address_space(3)))
typedef unsigned short bf16;
typedef unsigned v4u __attribute__((ext_vector_type(4)));
typedef unsigned v2u __attribute__((ext_vector_type(2)));
typedef float f32x4 __attribute__((ext_vector_type(4)));
typedef GAS unsigned gu32;
#define RLX_AGENT __ATOMIC_RELAXED, __HIP_MEMORY_SCOPE_AGENT
#define LDS_WAIT() asm volatile("s_waitcnt lgkmcnt(0)" ::: "memory")
#define VM_WAIT() asm volatile("s_waitcnt vmcnt(0)" ::: "memory")
typedef float f32x2_t __attribute__((ext_vector_type(2))); typedef __bf16 bf16x2_t __attribute__((ext_vector_type(2)));
__device__ __forceinline__ unsigned pk2(float lo, float hi) { f32x2_t v = {lo, hi}; bf16x2_t b = __builtin_convertvector(v, bf16x2_t); return __builtin_bit_cast(unsigned, b); }
__device__ __forceinline__ unsigned f2bf(float f) { return pk2(f, 0.f) & 0xffffu; }
__device__ __forceinline__ float bf2f(unsigned short u) { return __builtin_bit_cast(float, (unsigned)u << 16); }
__device__ __forceinline__ float bflo(unsigned w) { return __builtin_bit_cast(float, w << 16); }
__device__ __forceinline__ float bfhi(unsigned w) { return __builtin_bit_cast(float, w & 0xffff0000u); }
__device__ __forceinline__ float sigmoidf_(float x) { return 1.0f / (1.0f + expf(-x)); }
__device__ __forceinline__ float fast_sig(float x) { return __builtin_amdgcn_rcpf(1.0f + __expf(-x)); }
__device__ __forceinline__ float siluf_(float x) { return x / (1.0f + expf(-x)); }
__device__ __forceinline__ float softplusf_(float x) { return fmaxf(x, 0.f) + log1pf(expf(-fabsf(x))); }
__device__ __forceinline__ int hw_lane() { int r; asm volatile("v_mbcnt_lo_u32_b32 %0, -1, 0\n\tv_mbcnt_hi_u32_b32 %0, -1, %0" : "=v"(r)); return r; }
template <int PAT> __device__ __forceinline__ float swz_xor(float v) { return __builtin_bit_cast(float, __builtin_amdgcn_ds_swizzle(__builtin_bit_cast(int, v), PAT)); }
__device__ __forceinline__ float wave_sum(float v) {
    v += swz_xor<0x041F>(v); v += swz_xor<0x081F>(v); v += swz_xor<0x101F>(v); v += swz_xor<0x201F>(v); v += swz_xor<0x401F>(v);
    const float lo = __builtin_bit_cast(float, __builtin_amdgcn_readlane(__builtin_bit_cast(int, v), 0)), hi = __builtin_bit_cast(float, __builtin_amdgcn_readlane(__builtin_bit_cast(int, v), 32));
    return lo + hi;
}

#define XB_TMO      128
#define XB_XCNT(j)  (256  + 64 * (j))
#define XB_XSUB(j)  (1280 + 64 * (j))
#define XB_XGEN(j)  (2304 + 64 * (j))
#define XB_TOP      3328
#define XB_TOPGEN   3392
#define XCD_BAR_WORDS 3456
#define XB_SPIN_CAP (1u << 18)

__device__ __forceinline__ unsigned xb_ld(unsigned* p)              { return __hip_atomic_load(p, __ATOMIC_RELAXED, __HIP_MEMORY_SCOPE_AGENT); }
__device__ __forceinline__ unsigned xb_add(unsigned* p, unsigned v) { return __hip_atomic_fetch_add(p, v, __ATOMIC_RELAXED, __HIP_MEMORY_SCOPE_AGENT); }
__device__ __forceinline__ unsigned xb_xcc_id() { return (unsigned)__builtin_amdgcn_s_getreg((3 << 11) | 20) & 0xFu; }
#define XB_SPIN(cond, bar) do { unsigned _sp = 0; while (cond) { __builtin_amdgcn_s_sleep(1); \
    if ((++_sp & 255u) == 0u) { if (xb_ld(&(bar)[XB_TMO])) break; if (_sp > XB_SPIN_CAP) { atomicAdd(&(bar)[XB_TMO], 1u); break; } } } } while (0)

struct XcdBarrier {
    unsigned* bar; unsigned x;
    volatile LAS unsigned* st;
};

__device__ __forceinline__ XcdBarrier xcd_barrier_post(unsigned* bar, volatile LAS unsigned* st) {
    XcdBarrier b; b.bar = bar; b.x = xb_xcc_id(); b.st = st;
    if (threadIdx.x == 0) (void)xb_add(&bar[XB_XCNT(b.x)], 1u);
    return b;
}
__device__ __forceinline__ void xcd_barrier_complete(unsigned* bar, unsigned x, unsigned& nloc, unsigned& nx) {
    const unsigned G = gridDim.x * gridDim.y * gridDim.z;
    unsigned sum, cnt, mine, sp = 0u;
    for (;;) {
        sum = 0u; cnt = 0u; mine = 0u;
#pragma unroll
        for (unsigned j = 0; j < 16; ++j) { const unsigned c = xb_ld(&bar[XB_XCNT(j)]); sum += c; cnt += (c > 0u) ? 1u : 0u; mine = (j == x) ? c : mine; }
        if (sum == G) break;
        __builtin_amdgcn_s_sleep(1);
        if ((++sp & 255u) == 0u) { if (xb_ld(&bar[XB_TMO])) break; if (sp > XB_SPIN_CAP) { atomicAdd(&bar[XB_TMO], 1u); break; } }
    }
    nloc = mine > 0u ? mine : 1u; nx = cnt > 0u ? cnt : 1u;
}

__device__ __forceinline__ void xcd_barrier(const XcdBarrier& b, bool leader  ) {
    asm volatile("s_waitcnt vmcnt(0)" ::: "memory");
    __syncthreads();
    if (leader) {
        unsigned* bar = b.bar;
        __builtin_amdgcn_s_waitcnt(0);
        unsigned nloc = b.st[0], nx = b.st[1];
        if (nloc == 0u) { xcd_barrier_complete(bar, b.x, nloc, nx); b.st[0] = nloc; b.st[1] = nx; }
        const unsigned old = xb_add(&bar[XB_XSUB(b.x)], 1u);
        const unsigned gen = old / nloc;
        if (old + 1u == (gen + 1u) * nloc) {
            __builtin_amdgcn_fence(__ATOMIC_RELEASE, "agent");
            asm volatile("s_waitcnt vmcnt(0)" ::: "memory");
            const unsigned og = xb_add(&bar[XB_TOP], 1u);
            const unsigned tg = og / nx;
            if (og + 1u == (tg + 1u) * nx) xb_add(&bar[XB_TOPGEN], 1u);
            else XB_SPIN(xb_ld(&bar[XB_TOPGEN]) == tg, bar);
            __builtin_amdgcn_fence(__ATOMIC_ACQUIRE, "agent");
            xb_add(&bar[XB_XGEN(b.x)], 1u);
            asm volatile("s_waitcnt vmcnt(0)" ::: "memory");
        } else {
            XB_SPIN(xb_ld(&bar[XB_XGEN(b.x)]) == gen, bar);
            __builtin_amdgcn_fence(__ATOMIC_ACQUIRE, "agent");
            asm volatile("s_waitcnt vmcnt(0)" ::: "memory");
        }
    }
    __syncthreads();
}

struct Args { const float* in[32]; float* out; unsigned char* ws; int ph_lo, ph_hi; };
typedef __attribute__((address_space(4))) Args KArgs;
enum { I_XP = 0, I_XS, I_CK, I_CV, I_SGLA, I_SDN, I_SHG, I_C, I_CCTX, I_NORMW, I_WMOD, I_BMOD, I_F1IN, I_F1DN, I_F2IN, I_F2DN, I_WIN, I_GW2, I_GB, I_GNORM,
       I_DCONV, I_DALOG, I_DDT, I_DNORM, I_HLB, I_HNORM, I_DLAM, I_DFNORM, I_WBR, I_WMG, I_WOUT, I_FNORM };

__device__ __forceinline__ int srccol_inproj(int np) {
    if (np < 768) return np;
    if (np < 1536) return np - 768 + 800;
    if (np < 1792) return np - 1536 + 1584;
    if (np < 2048) return np - 1792 + 1840;
    if (np < 2304) return np - 2048 + 2608;
    if (np < 2560) return np - 2304 + 2864;
    if (np < 2816) return np - 2560 + 3120;
    if (np < 3072) return np - 2816 + 3376;
    if (np < 3328) return np - 3072 + 3632;
    const int o = np - 3328;
    if (o < 32) return 768 + o;
    if (o < 40) return 1568 + (o - 32);
    if (o < 48) return 1576 + (o - 40);
    if (o < 560) return 2096 + (o - 48);
    return -1;
}
__device__ __forceinline__ void tr_item(const float* W, int ldw, int K, bf16* WT, int kb, int nb, int kind, LAS float* scr, int lane) {
    const int k0 = 64 * kb, n0 = 32 * nb, np = n0 + (lane & 31);
    int sc = np;
    if (kind == 1) sc = ((np >> 7) & 1) * 2816 + (np >> 8) * 128 + (np & 127);
    else if (kind == 2) sc = srccol_inproj(np);
    float tv[32];
    const float* wp = W + (size_t)(k0 + (lane >> 5)) * ldw + (sc >= 0 ? sc : 0);
#pragma unroll
    for (int i = 0; i < 32; ++i) tv[i] = __builtin_nontemporal_load(wp + (size_t)(2 * i) * ldw);
#pragma unroll
    for (int i = 0; i < 32; ++i) scr[(2 * i + (lane >> 5)) * 33 + (lane & 31)] = sc >= 0 ? tv[i] : 0.f;
    LDS_WAIT(); asm volatile("" ::: "memory");
    const int c = lane & 7;
#pragma unroll
    for (int j = 0; j < 4; ++j) { const int n = (lane >> 3) + 8 * j; const LAS float* s = scr + (8 * c) * 33 + n;
        v4u o; o.x = pk2(s[0 * 33], s[1 * 33]); o.y = pk2(s[2 * 33], s[3 * 33]); o.z = pk2(s[4 * 33], s[5 * 33]); o.w = pk2(s[6 * 33], s[7 * 33]);
        *(GAS v4u*)(WT + (size_t)(n0 + n) * K + k0 + 8 * c) = o; }
    LDS_WAIT(); asm volatile("" ::: "memory");
}
constexpr int CI0 = 16 * 176, CI1 = CI0 + 44 * 32, CI2 = CI1 + 16 * 128, CI3 = CI2 + 16 * 128, CI4 = CI3 + 4 * 4 * 32, CI5 = CI4 + 16 * 32, CI6 = CI5 + 16 * 176, CI7 = CI6 + 44 * 32;
__device__ __forceinline__ void conv_items(const KArgs& a, int l, int i0, int i1, int w, int nw, LAS unsigned char* lds, int wave, int lane) {
    LAS float* scr = (LAS float*)(lds + wave * 16384);
    bf16* Wb = (bf16*)(a.ws + WS_W);
    for (int it = i0 + w; it < i1; it += nw) {
        if (it < CI0) { const int r = it; tr_item(a.in[I_F1IN] + (size_t)l * 1024 * 5632, 5632, 1024, (bf16*)((char*)Wb + W_1A), r / 176, r % 176, 1, scr, lane); }
        else if (it < CI1) { const int r = it - CI0; tr_item(a.in[I_F1DN] + (size_t)l * 2816 * 1024, 1024, 2816, (bf16*)((char*)Wb + W_1B), r / 32, r % 32, 0, scr, lane); }
        else if (it < CI2) { const int r = it - CI1; tr_item(a.in[I_WIN] + (size_t)l * 1024 * 3888, 3888, 1024, (bf16*)((char*)Wb + W_IN), r / 128, r % 128, 2, scr, lane); }
        else if (it < CI3) { const int r = it - CI2; tr_item(a.in[I_WMG] + (size_t)l * 1024 * 4096, 4096, 1024, (bf16*)((char*)Wb + W_IN) + (size_t)4096 * 1024, r / 128, r % 128, 0, scr, lane); }
        else if (it < CI4) { const int r = it - CI3, n = r / 128, q = r % 128; tr_item(a.in[I_WBR] + (size_t)(l * 4 + n) * 256 * 1024, 1024, 256, (bf16*)((char*)Wb + W_BR) + (size_t)n * 1024 * 256, q / 32, q % 32, 0, scr, lane); }
        else if (it < CI5) { const int r = it - CI4; tr_item(a.in[I_WOUT] + (size_t)l * 1024 * 1024, 1024, 1024, (bf16*)((char*)Wb + W_WO), r / 32, r % 32, 0, scr, lane); }
        else if (it < CI6) { const int r = it - CI5; tr_item(a.in[I_F2IN] + (size_t)l * 1024 * 5632, 5632, 1024, (bf16*)((char*)Wb + W_2A), r / 176, r % 176, 1, scr, lane); }
        else { const int r = it - CI6; tr_item(a.in[I_F2DN] + (size_t)l * 2816 * 1024, 1024, 2816, (bf16*)((char*)Wb + W_2B), r / 32, r % 32, 0, scr, lane); }
    }
}
__device__ __forceinline__ void conv_cache(const KArgs& a, int l, int w, int nw, int lane) {
    bf16* kvc = (bf16*)(a.ws + WS_KVC);
    for (int i = (w * 64 + lane) * 4; i < 2 * 2 * 4 * 512 * 64; i += nw * 64 * 4) {
        const int kv = i / (2 * 4 * 512 * 64), r = i % (2 * 4 * 512 * 64), b = r / (4 * 512 * 64), q = r % (4 * 512 * 64);
        const f32x4 v = __builtin_nontemporal_load((const f32x4*)((kv ? a.in[I_CV] : a.in[I_CK]) + (size_t)(b * NL + l) * 4 * 512 * 64 + q));
        v2u wv; wv.x = pk2(v.x, v.y); wv.y = pk2(v.z, v.w); *(v2u*)(kvc + i) = wv;
    }
}
constexpr int BI1 = 128, BI2 = BI1 + 88, BI3 = BI2 + 88, BI4 = BI3 + 128, BI5 = BI4 + 88;
__device__ __forceinline__ void bias_items(const KArgs& a, int i0, int i1, int w, int nw, LAS unsigned char* lds, int wave, int lane, size_t dummy = 0) {
    LAS float* shl = (LAS float*)(lds + wave * 2048);
    LAS float* red = (LAS float*)(lds + 16384);
    const float* modf = (const float*)(a.ws + WS_MODF);
    float* bias = (float*)(a.ws + WS_BIAS + dummy);
    for (int it = i0 + w; it < i1; it += nw) {
        int cb, r;
        if (it < BI1) { cb = 0; r = it; } else if (it < BI2) { cb = 1; r = it - BI1; } else if (it < BI3) { cb = 2; r = it - BI2; } else if (it < BI4) { cb = 3; r = it - BI3; } else { cb = 4; r = it - BI4; }
        const int ll = (cb + 1) / 3, which = (cb + 1) % 3, kc = wave, n = r * 64 + lane;
#pragma unroll
        for (int q = 0; q < 6; ++q) { const int idx = lane + 64 * q, g = idx >> 7, kk = idx & 127; shl[idx] = modf[(size_t)(ll * 3 + g) * 9216 + which * 3 * 1024 + kc * 128 + kk]; }
        LDS_WAIT(); asm volatile("" ::: "memory");
        const float* W; int ldw, sc;
        if (which == 1) { if (n < 4096) { W = a.in[I_WIN] + (size_t)ll * 1024 * 3888; ldw = 3888; sc = srccol_inproj(n); } else { W = a.in[I_WMG] + (size_t)ll * 1024 * 4096; ldw = 4096; sc = n - 4096; } }
        else { W = (which == 0 ? a.in[I_F1IN] : a.in[I_F2IN]) + (size_t)ll * 1024 * 5632; ldw = 5632; sc = ((n >> 7) & 1) * 2816 + (n >> 8) * 128 + (n & 127); }
        const float* wp = W + (size_t)(kc * 128) * ldw + (sc >= 0 ? sc : 0);
        float s0 = 0.f, s1 = 0.f, s2 = 0.f;
        for (int k0 = 0; k0 < 128; k0 += 32) {
            float wv[32];
#pragma unroll
            for (int i = 0; i < 32; ++i) wv[i] = __builtin_nontemporal_load(wp + (size_t)(k0 + i) * ldw);
#pragma unroll
            for (int i = 0; i < 32; i += 4) {
                const f32x4 h0 = *(const LAS f32x4*)(shl + k0 + i), h1 = *(const LAS f32x4*)(shl + 128 + k0 + i), h2 = *(const LAS f32x4*)(shl + 256 + k0 + i);
                s0 += (h0.x * wv[i] + h0.y * wv[i + 1]) + (h0.z * wv[i + 2] + h0.w * wv[i + 3]);
                s1 += (h1.x * wv[i] + h1.y * wv[i + 1]) + (h1.z * wv[i + 2] + h1.w * wv[i + 3]);
                s2 += (h2.x * wv[i] + h2.y * wv[i + 1]) + (h2.z * wv[i + 2] + h2.w * wv[i + 3]);
            }
        }
        if (sc < 0) { s0 = 0.f; s1 = 0.f; s2 = 0.f; }
        red[(wave * 3 + 0) * 64 + lane] = s0; red[(wave * 3 + 1) * 64 + lane] = s1; red[(wave * 3 + 2) * 64 + lane] = s2;
        __syncthreads();
        if (wave < 3) { float s = 0.f;
#pragma unroll
            for (int q = 0; q < 8; ++q) s += red[(q * 3 + wave) * 64 + lane];
            bias[(size_t)(cb * 3 + wave) * 8192 + n] = s; }
        __syncthreads();
    }
}
__device__ __forceinline__ void mod_items(const KArgs& a, int i0, int i1, int w, int nw, LAS unsigned char* lds, int wave, int lane) {
    float* modp = (float*)(a.ws + WS_MODP);
    LAS float* sl = (LAS float*)(lds + wave * 16384 + 12288);
        for (int it = i0 + w; it < i1; it += nw) {
            const int ll = it / 288, r = it % 288, ks = r / 36, jb = r % 36, j = jb * 256 + lane * 4;
            const float* w = a.in[I_WMOD] + (size_t)ll * 1024 * 9216 + (size_t)(ks * 128) * 9216 + j;
#pragma unroll
            for (int q = 0; q < 2; ++q) { const int kk = ks * 128 + lane + 64 * q; sl[lane + 64 * q] = siluf_(a.in[I_CCTX][kk]); sl[128 + lane + 64 * q] = siluf_(a.in[I_C][kk]); sl[256 + lane + 64 * q] = siluf_(a.in[I_C][1024 + kk]); }
            LDS_WAIT(); asm volatile("" ::: "memory");
            f32x4 a0 = {0.f, 0.f, 0.f, 0.f}, a1 = a0, a2 = a0;
            for (int k0 = 0; k0 < 128; k0 += 32) {
                f32x4 wv[32];
#pragma unroll
                for (int i = 0; i < 32; ++i) wv[i] = __builtin_nontemporal_load((const f32x4*)(w + (size_t)(k0 + i) * 9216));
#pragma unroll
                for (int i = 0; i < 32; i += 4) {
                    const f32x4 s0 = *(const LAS f32x4*)(sl + k0 + i), s1 = *(const LAS f32x4*)(sl + 128 + k0 + i), s2 = *(const LAS f32x4*)(sl + 256 + k0 + i);
#pragma unroll
                    for (int q = 0; q < 4; ++q) { a0 += wv[i + q] * s0[q]; a1 += wv[i + q] * s1[q]; a2 += wv[i + q] * s2[q]; }
                }
            }
            if (ks == 0) { const f32x4 bv = *(const f32x4*)(a.in[I_BMOD] + (size_t)ll * 9216 + j); a0 += bv; a1 += bv; a2 += bv; }
            float* o = modp + (size_t)((ll * 8 + ks) * 3) * 9216 + j;
            *(f32x4*)o = a0; *(f32x4*)(o + 9216) = a1; *(f32x4*)(o + 2 * 9216) = a2;
            LDS_WAIT(); asm volatile("" ::: "memory");
        }
}
__device__ __forceinline__ void mod_consolidate(const KArgs& a, int ll, int w, int nw, int lane) {
    float* modf = (float*)(a.ws + WS_MODF); const float* mp = (const float*)(a.ws + WS_MODP); float* csv = (float*)(a.ws + WS_CSV);
    for (int i = w * 64 + lane; i < 3 * 9216; i += nw * 64) {
        float s = 0.f;
#pragma unroll
        for (int ks = 0; ks < 8; ++ks) s += mp[(size_t)((ll * 8 + ks) * 3) * 9216 + i];
        modf[(size_t)ll * 3 * 9216 + i] = s;
    }
    for (int i = w * 64 + lane; i < 3 * 3 * 1024; i += nw * 64) {
        const int c = i & 1023, g = (i >> 10) % 3, wh = i / 3072; float s = 0.f;
#pragma unroll
        for (int ks = 0; ks < 8; ++ks) s += mp[(size_t)((ll * 8 + ks) * 3 + g) * 9216 + (wh * 3 + 1) * 1024 + c];
        csv[(size_t)ll * 9216 + i] = a.in[I_NORMW][(size_t)(ll * 3 + wh) * 1024 + c] * (1.0f + s);
    }
}
__device__ __forceinline__ void pro_phase(const KArgs& a, int l, LAS unsigned char* lds, int gw, int wave, int lane) {
    constexpr int NGW = 256 * NWAVES;
    conv_items(a, 0, 0, CI1, gw, NGW, lds, wave, lane);
    conv_cache(a, 0, gw, NGW, lane);
    if (l == 0) {
        mod_items(a, 0, 288, NGW - 1 - gw, NGW, lds, wave, lane);
        float* ct = (float*)(a.ws + WS_ROPE); float* st = ct + 1024 * 32;
        for (int idx = gw * 64 + lane; idx < 1024 * 32; idx += NGW * 64) {
            const int t = idx >> 5, d = idx & 31;
            const float pos = (float)((d < 16) ? (t >> 6) : (t & 63));
            const float inv = powf(10000.0f, -(float)(d & 7) * 0.125f);
            float sn, cs; sincosf(pos * inv, &sn, &cs);
            ct[idx] = cs; st[idx] = sn;
        }
    }
}

__device__ __forceinline__ void norm_phase(const KArgs& a, int l, int which, LAS unsigned char* lds, int gw, int tid, int lane, const float* xP, const float* xS) {
    LAS float* cs = (LAS float*)lds;
    LAS float* sh = cs + 3 * 1024;
    const float* modp = (const float*)(a.ws + WS_MODP) + (size_t)l * 8 * 3 * 9216;
    const float* nw = a.in[I_NORMW] + (size_t)(l * 3 + which) * 1024;
    const int csh = which * 3, csc = which * 3 + 1;
    bf16* H = (bf16*)(a.ws + WS_H);
    f32x4 v[5][4];
#pragma unroll
    for (int q = 0; q < 5; ++q) {
        const int row = gw + q * 256 * NWAVES;
        const float* xr = row < MP ? xP + (size_t)row * D : xS + (size_t)(row - MP) * D;
#pragma unroll
        for (int j = 0; j < 4; ++j) v[q][j] = *((const f32x4*)xr + lane + 64 * j);
    }
    for (int i = tid; i < 3 * 1024; i += NWAVES * 64) {
        const int g = i >> 10, c = i & 1023; float vs = 0.f, vh = 0.f;
#pragma unroll
        for (int ks = 0; ks < 8; ++ks) { const float* p = modp + (size_t)(ks * 3 + g) * 9216; vs += p[csc * 1024 + c]; vh += p[csh * 1024 + c]; }
        cs[i] = nw[c] * (1.0f + vs); sh[i] = vh;
    }
    __syncthreads();
#pragma unroll
    for (int q = 0; q < 5; ++q) {
        const int row = gw + q * 256 * NWAVES;
        const int g = row < MP ? 0 : 1 + ((row - MP) >> 10);
        float s = 0.f;
#pragma unroll
        for (int j = 0; j < 4; ++j) s += (v[q][j].x * v[q][j].x + v[q][j].y * v[q][j].y) + (v[q][j].z * v[q][j].z + v[q][j].w * v[q][j].w);
        const float rstd = 1.0f / sqrtf(wave_sum(s) * (1.0f / D) + 1e-6f);
#pragma unroll
        for (int j = 0; j < 4; ++j) {
            const int c = (lane + 64 * j) * 4;
            const f32x4 c4 = *(const LAS f32x4*)(cs + g * 1024 + c), h4 = *(const LAS f32x4*)(sh + g * 1024 + c);
            const f32x4 o = v[q][j] * rstd * c4 + h4;
            v2u w; w.x = pk2(o.x, o.y); w.y = pk2(o.z, o.w);
            *(v2u*)(H + (size_t)row * D + c) = w;
        }
    }
    if (l == 0 && which == 0) {
        mod_consolidate(a, 0, gw, 256 * NWAVES, lane);
        float* csv = (float*)(a.ws + WS_CSV);
        for (int i = gw * 64 + lane; i < 3 * 1024; i += 256 * NWAVES * 64) csv[NL * 3 * 3 * 1024 + i] = a.in[I_FNORM][i & 1023];
    }
}
__device__ __forceinline__ void final_phase(const KArgs& a, int gw, int lane) {
    float* X = a.out + O_Y; const bf16* H = (const bf16*)(a.ws + WS_H); const float* ss = (const float*)(a.ws + WS_SSP) + (size_t)5 * M * 4;
    v4u v[5][2]; f32x4 q[5];
#pragma unroll
    for (int r = 0; r < 5; ++r) {
        const int row = gw + r * 256 * NWAVES;
        q[r] = *(const f32x4*)(ss + (size_t)row * 4);
#pragma unroll
        for (int j = 0; j < 2; ++j) v[r][j] = *((const v4u*)(H + (size_t)row * D) + lane + 64 * j);
    }
#pragma unroll
    for (int r = 0; r < 5; ++r) {
        float* xr = X + (size_t)(gw + r * 256 * NWAVES) * D;
        const float rstd = 1.0f / sqrtf(((q[r].x + q[r].y) + (q[r].z + q[r].w)) * (1.0f / D) + 1e-6f);
#pragma unroll
        for (int j = 0; j < 2; ++j) {
            const v4u w = v[r][j]; f32x4 o0, o1;
            o0.x = bflo(w.x) * rstd; o0.y = bfhi(w.x) * rstd; o0.z = bflo(w.y) * rstd; o0.w = bfhi(w.y) * rstd; o1.x = bflo(w.z) * rstd; o1.y = bfhi(w.z) * rstd; o1.z = bflo(w.w) * rstd; o1.w = bfhi(w.w) * rstd;
            float* p = xr + (lane + 64 * j) * 8; *(f32x4*)p = o0; *(f32x4*)(p + 4) = o1;
        }
    }
}


struct SeqInfo { bool ctx; int T, row0, b; };
__device__ __forceinline__ SeqInfo seq_info(int s) { SeqInfo q; q.ctx = s < 32; q.T = q.ctx ? 256 : 1024; q.row0 = q.ctx ? s * 256 : MP + (s - 32) * 1024; q.b = q.ctx ? s : s - 32; return q; }

typedef short s16x8 __attribute__((ext_vector_type(8)));
typedef float f32x16 __attribute__((ext_vector_type(16)));
typedef short v4i16_t __attribute__((ext_vector_type(4)));
__device__ __forceinline__ s16x8 pack_acc8(const f32x16& x, int s, float f0, float f1, float f2, float f3, float f4, float f5, float f6, float f7) {
    v4u w; w.x = pk2(x[8 * s + 0] * f0, x[8 * s + 1] * f1); w.y = pk2(x[8 * s + 2] * f2, x[8 * s + 3] * f3); w.z = pk2(x[8 * s + 4] * f4, x[8 * s + 5] * f5); w.w = pk2(x[8 * s + 6] * f6, x[8 * s + 7] * f7);
    return __builtin_bit_cast(s16x8, w);
}
__device__ __forceinline__ int img_sw(int row, int ld) { return ld == 64 ? (row & 7) : ((row >> 1) & 3); }
__device__ __forceinline__ s16x8 frag_a(const LAS bf16* img, int ld, int row, int ks, int hh) {
    int sw = img_sw(row, ld); asm volatile("" : "+v"(sw));
    const LAS unsigned char* rb = (const LAS unsigned char*)img + row * ld * 2 + 8 * hh;
    const v2u lo = *(const LAS v2u*)(rb + (((2 * ks) ^ sw) << 4)), hi = *(const LAS v2u*)(rb + (((2 * ks + 1) ^ sw) << 4));
    v4u w; w.x = lo.x; w.y = lo.y; w.z = hi.x; w.w = hi.y; return __builtin_bit_cast(s16x8, w);
}
__device__ __forceinline__ s16x8 frag_tr_sw(const LAS bf16* img, int ld, int rowbase, int colbase, int lane) {
    const int hh = lane >> 5, g16 = (lane >> 4) & 1, l16 = lane & 15;
    const int row = rowbase + 4 * hh + (l16 >> 2), col = colbase + 16 * g16 + 4 * (l16 & 3);
    int swt = img_sw(row, ld); asm volatile("" : "+v"(swt));
    const LAS unsigned char* bp = (const LAS unsigned char*)img + row * ld * 2 + (((col >> 3) ^ swt) << 4) + (col & 7) * 2;
    const v4i16_t lo = __builtin_amdgcn_ds_read_tr16_b64_v4i16((LAS v4i16_t*)bp), hi = __builtin_amdgcn_ds_read_tr16_b64_v4i16((LAS v4i16_t*)(bp + 16 * ld));
    return (s16x8){lo[0], lo[1], lo[2], lo[3], hi[0], hi[1], hi[2], hi[3]};
}
__device__ __forceinline__ s16x8 frag_tr(const LAS bf16* img, int ldb, int rowbase, int colbase, int lane) {
    const int hh = lane >> 5, g16 = (lane >> 4) & 1, l16 = lane & 15;
    const LAS unsigned char* bp = (const LAS unsigned char*)img + (rowbase + 4 * hh + (l16 >> 2)) * ldb + (colbase + 16 * g16 + 4 * (l16 & 3)) * 2;
    const v4i16_t lo = __builtin_amdgcn_ds_read_tr16_b64_v4i16((LAS v4i16_t*)bp), hi = __builtin_amdgcn_ds_read_tr16_b64_v4i16((LAS v4i16_t*)(bp + 8 * ldb));
    return (s16x8){lo[0], lo[1], lo[2], lo[3], hi[0], hi[1], hi[2], hi[3]};
}
constexpr int SCAN_LDS = 19456;
template <int DK> struct ScanImg { static constexpr int QB = 0, KB = 64 * DK * 2, FB = 2 * 64 * DK * 2, BYTES = 2 * 64 * DK * 2 + 3 * DK * 4; };
__device__ __forceinline__ int blk_of(const SeqInfo& si, int tb) { return si.row0 / 64 + tb; }

template <int DK, bool HG>
__device__ __forceinline__ void prep_glahg(const KArgs& a, int l, int blk, int h, int dir, LAS unsigned char* sm, int lane_in) {
    int lane = lane_in; asm volatile("" : "+v"(lane));
    const bf16* PB = (const bf16*)(a.ws + WS_PB); const float* PF = (const float*)(a.ws + WS_PF);
    unsigned char* img = a.ws + (HG ? WS_HIMG : WS_GIMG) + (size_t)((blk * 4 + h) * 2 + dir) * ScanImg<DK>::BYTES;
    bf16* QI = (bf16*)(img + ScanImg<DK>::QB); bf16* KI = (bf16*)(img + ScanImg<DK>::KB); float* FI = (float*)(img + ScanImg<DK>::FB);
    LAS float* XCH = (LAS float*)sm;
    const int r32 = lane & 31, hh = lane >> 5;
    const int tstp = dir == 0 ? 1 : -1;
    const size_t rowb = (size_t)(blk * 64 + (dir == 0 ? 0 : 63));
    if (HG) {
        const int d = lane; float lbv = 0.f;
        if (l == 1) { const float* lg = a.in[I_HLB]; const int c = h * 64 + d; lbv = sigmoidf_(lg[(size_t)(2 + dir) * 256 + c] - lg[(size_t)dir * 256 + c]); }
        const long sx = (long)tstp * NPF, sq = (long)tstp * NPB;
        const float* px0 = PF + rowb * NPF + F_HGF + dir * 256 + h * 64 + d;
        const bf16* pq0 = PB + rowb * NPB + C_HGQ + h * 64 + d;
        float xv[64]; unsigned qp[32];
#pragma unroll
        for (int t = 0; t < 64; ++t) xv[t] = px0[(long)t * sx];
#pragma unroll
        for (int t = 0; t < 64; t += 2) { const unsigned lo = pq0[(long)t * sq], hi = pq0[(long)(t + 1) * sq]; qp[t >> 1] = lo | (hi << 16); }
        float bcur = 0.f, bb[32];
#pragma unroll
        for (int tau = 0; tau < 32; ++tau) { const float f = lbv + (1.0f - lbv) * fast_sig(xv[tau]); xv[tau] = f; bcur += __logf(f); bb[tau] = bcur; }
        const float rr = bcur;
#pragma unroll
        for (int tau = 0; tau < 64; ++tau) {
            const float qr = (tau & 1) ? bfhi(qp[tau >> 1]) : bflo(qp[tau >> 1]);
            const float f = tau < 32 ? xv[tau] : lbv + (1.0f - lbv) * fast_sig(xv[tau]);
            float bt;
            if (tau < 32) bt = bb[tau]; else { bcur += __logf(f); bt = bcur; }
            const float e1 = __expf(fminf(fmaxf(bt - rr, -80.f), 80.f)), e2 = __builtin_amdgcn_rcpf(e1);
            QI[tau * DK + d] = (bf16)f2bf(qr * fast_sig(qr) * 0.125f * e1); KI[tau * DK + d] = (bf16)f2bf((1.0f - f) * e2);
        }
        FI[d] = __expf(rr); FI[DK + d] = __expf(bcur - rr); FI[2 * DK + d] = __expf(bcur);
    } else {
        const int d = r32;
        const float gbv = a.in[I_GB][(size_t)(l * 2 + dir) * 128 + h * 32 + d];
        float w2r[16];
#pragma unroll
        for (int r = 0; r < 16; ++r) w2r[r] = a.in[I_GW2][(size_t)((l * 2 + dir) * 16 + r) * 128 + h * 32 + d];
        const long sq = (long)tstp * NPB;
        const bf16* pq0 = PB + (rowb + (long)tstp * (32 * hh)) * NPB + h * 32 + d;
        LAS float* XL = XCH + 256;
        f32x4 lr4[4];
        { const float* pl = PF + (rowb + (long)tstp * lane) * NPF + F_LR + dir * 16;
#pragma unroll
          for (int r4 = 0; r4 < 4; ++r4) lr4[r4] = *(const f32x4*)(pl + r4 * 4); }
        unsigned qk[32];
#pragma unroll
        for (int tq = 0; tq < 32; ++tq) { const bf16* pq = pq0 + (long)tq * sq; const unsigned lo = pq[C_GAQ], hi = pq[C_GAK]; qk[tq] = lo | (hi << 16); }
#pragma unroll
        for (int r4 = 0; r4 < 4; ++r4) *(LAS f32x4*)(XL + lane * 16 + r4 * 4) = lr4[r4];
        LDS_WAIT(); asm volatile("" ::: "memory");
        float bcur = 0.f, bb[32];
#pragma unroll
        for (int tq = 0; tq < 32; ++tq) {
            const LAS float* pl = XL + (32 * hh + tq) * 16; float z = gbv;
#pragma unroll
            for (int r4 = 0; r4 < 4; ++r4) { const f32x4 t4 = *(const LAS f32x4*)(pl + r4 * 4); z += t4.x * w2r[r4 * 4] + t4.y * w2r[r4 * 4 + 1] + t4.z * w2r[r4 * 4 + 2] + t4.w * w2r[r4 * 4 + 3]; }
            bcur -= (fmaxf(-z, 0.f) + __logf(1.0f + __expf(-fabsf(z)))) * 0.0625f; bb[tq] = bcur;
        }
        if (hh == 0) XCH[d] = bcur; else XCH[32 + d] = bcur;
        LDS_WAIT(); asm volatile("" ::: "memory");
        const float rr = XCH[d], blast = rr + XCH[32 + d];
#pragma unroll
        for (int tq = 0; tq < 32; ++tq) {
            const int tau = 32 * hh + tq;
            const float qv = bflo(qk[tq]) * 0.17677669529663687f, kv = bfhi(qk[tq]);
            const float ex = hh == 0 ? fminf(bb[tq] - rr, 80.f) : fmaxf(bb[tq], -80.f);
            const float e1 = __expf(ex), e2 = __builtin_amdgcn_rcpf(e1);
            QI[tau * DK + d] = (bf16)f2bf(qv * e1); KI[tau * DK + d] = (bf16)f2bf(kv * e2);
        }
        if (hh == 0) { FI[d] = __expf(rr); FI[DK + d] = __expf(blast - rr); FI[2 * DK + d] = __expf(blast); }
        LDS_WAIT(); asm volatile("" ::: "memory");
    }
}

template <int DK, bool HG, bool SPLIT>
__device__ __forceinline__ void chain_glahg(const KArgs& a, int l, int s, int h, int dir, int te0, LAS unsigned char* sm, int lane_in) {
    constexpr int NTE = SPLIT ? 1 : 2; const int co = SPLIT ? 32 * te0 : 0;
    int lane_o = lane_in; asm volatile("" : "+v"(lane_o));
    constexpr int NTD = DK / 32, KS = DK / 16;
    const SeqInfo si = seq_info(s);
    const bf16* PB = (const bf16*)(a.ws + WS_PB);
    bf16* OSC = (bf16*)(a.ws + WS_OSC) + (size_t)(dir * 3 + (HG ? 2 : 0)) * M * 256;
    LAS bf16* B0 = (LAS bf16*)sm; LAS bf16* B1 = (LAS bf16*)(sm + 8192); LAS bf16* VR0 = (LAS bf16*)(sm + 16384);
    LAS float* ER = (LAS float*)(sm + 32768); LAS float* EL = ER + DK; LAS float* EBL = ER + 2 * DK;
    f32x16 S[NTD][NTE];
    { const int lane = lane_o, r32 = lane & 31, hh = lane >> 5;
#pragma unroll
    for (int td = 0; td < NTD; ++td)
#pragma unroll
        for (int te = 0; te < NTE; ++te) {
            if (si.ctx) { S[td][te] = f32x16{}; }
            else {
                const float* st = (HG ? a.in[I_SHG] : a.in[I_SGLA]) + (size_t)((((si.b * NL + l) * 2 + dir) * 4 + h) * DK) * 64 + 32 * te + co + r32;
#pragma unroll
                for (int rg = 0; rg < 16; ++rg) S[td][te][rg] = st[(size_t)(32 * td + (rg & 3) + 8 * (rg >> 2) + 4 * hh) * 64];
            }
        }
    }
    const int NC = si.T / 64;
    constexpr int NQ = 64 * DK * 2 / 1024;
    v4u nq[NQ], nk[NQ]; float nf0, nf1, nf2;
#define GH_LOAD(cs_) do { const int tb_ = dir == 0 ? (cs_) : NC - 1 - (cs_); \
        const unsigned char* img_ = a.ws + (HG ? WS_HIMG : WS_GIMG) + (size_t)((blk_of(si, tb_) * 4 + h) * 2 + dir) * ScanImg<DK>::BYTES; \
        _Pragma("unroll") for (int i_ = 0; i_ < NQ; ++i_) { nq[i_] = *(const v4u*)(img_ + ScanImg<DK>::QB + (lane + 64 * i_) * 16); nk[i_] = *(const v4u*)(img_ + ScanImg<DK>::KB + (lane + 64 * i_) * 16); } \
        const int fl_ = lane < DK ? lane : 0; nf0 = *(const float*)(img_ + ScanImg<DK>::FB + fl_ * 4); nf1 = *(const float*)(img_ + ScanImg<DK>::FB + (DK + fl_) * 4); nf2 = *(const float*)(img_ + ScanImg<DK>::FB + (2 * DK + fl_) * 4); } while (0)
#define GH_VDMA(cs_) do { const int tb_ = dir == 0 ? (cs_) : NC - 1 - (cs_), t0_ = dir == 0 ? tb_ * 64 : tb_ * 64 + 63, ts_ = dir == 0 ? 1 : -1; \
        LAS unsigned char* vd_ = sm + 16384 + (((cs_) & 1) ? 8192 : 0); \
        _Pragma("unroll") for (int i_ = 0; i_ < 8; ++i_) { const int p_ = lane + 64 * i_; \
            __builtin_amdgcn_global_load_lds((const unsigned*)(PB + (size_t)(si.row0 + t0_ + ts_ * (p_ >> 3)) * NPB + (HG ? C_HGI : C_GAV) + h * 64 + 8 * ((p_ & 7) ^ ((p_ >> 3) & 7))), (LAS unsigned*)(vd_ + i_ * 1024), 16, 0, 0); } } while (0)
    { const int lane = lane_o; GH_LOAD(0); GH_VDMA(0); }
#pragma unroll 1
    for (int cs = 0; cs < NC; ++cs) {
        int lane_c = hw_lane(); asm volatile("" : "+v"(lane_c));
        const int lane = lane_c, r32 = lane & 31, hh = lane >> 5;
        const int tb = dir == 0 ? cs : NC - 1 - cs;
        const int t0 = dir == 0 ? tb * 64 : tb * 64 + 63, tstp = dir == 0 ? 1 : -1;
        {
#pragma unroll
            for (int i = 0; i < NQ; ++i) { const int p = lane + 64 * i, row = p / (DK / 8), c = p % (DK / 8); const int off = row * DK * 2 + ((c ^ img_sw(row, DK)) << 4);
                *(LAS v4u*)((LAS unsigned char*)B0 + off) = nq[i]; *(LAS v4u*)((LAS unsigned char*)B1 + off) = nk[i]; }
            if (lane < DK) { ER[lane] = nf0; EL[lane] = nf1; EBL[lane] = nf2; }
            asm volatile("s_waitcnt vmcnt(0)" ::: "memory");
            const int csn = cs + 1 < NC ? cs + 1 : cs; GH_LOAD(csn); if (cs + 1 < NC) GH_VDMA(cs + 1);
#ifdef PROBE_GH_NOPF
            asm volatile("s_waitcnt vmcnt(0)" ::: "memory");
#endif
        }
        LAS bf16* VR = (LAS bf16*)(sm + 16384 + ((cs & 1) ? 8192 : 0));
        LDS_WAIT(); asm volatile("" ::: "memory");
        if constexpr (SPLIT) {
        s16x8 pa00[2], pa01[2], pa11[2];
        s16x8 q0[KS], q1[KS];
        {
            s16x8 k0[KS], k1[KS];
#pragma unroll
            for (int ks = 0; ks < KS; ++ks) { q0[ks] = frag_a(B0, DK, r32, ks, hh); q1[ks] = frag_a(B0, DK, 32 + r32, ks, hh); k0[ks] = frag_a(B1, DK, r32, ks, hh); k1[ks] = frag_a(B1, DK, 32 + r32, ks, hh); }
#pragma unroll
            for (int ks = 0; ks < KS; ++ks) asm volatile("" : "+v"(q0[ks]), "+v"(q1[ks]), "+v"(k0[ks]), "+v"(k1[ks]));
            f32x16 x00 = f32x16{}, x01 = f32x16{}, x11 = f32x16{};
#pragma unroll
            for (int ks = 0; ks < KS; ++ks) {
                x00 = __builtin_amdgcn_mfma_f32_32x32x16_bf16(k0[ks], q0[ks], x00, 0, 0, 0);
                x01 = __builtin_amdgcn_mfma_f32_32x32x16_bf16(k0[ks], q1[ks], x01, 0, 0, 0);
                x11 = __builtin_amdgcn_mfma_f32_32x32x16_bf16(k1[ks], q1[ks], x11, 0, 0, 0);
            }
#pragma unroll
            for (int rg = 0; rg < 16; ++rg) { const int jr = (rg & 3) + 8 * (rg >> 2) + 4 * hh; if (jr > r32) { x00[rg] = 0.f; x11[rg] = 0.f; } }
#pragma unroll
            for (int s2 = 0; s2 < 2; ++s2) { pa00[s2] = pack_acc8(x00, s2, 1, 1, 1, 1, 1, 1, 1, 1); pa01[s2] = pack_acc8(x01, s2, 1, 1, 1, 1, 1, 1, 1, 1); pa11[s2] = pack_acc8(x11, s2, 1, 1, 1, 1, 1, 1, 1, 1); }
        }
        s16x8 sbp[NTD][2], vbf[4];
#pragma unroll
        for (int tk = 0; tk < 4; ++tk) vbf[tk] = frag_tr_sw(VR, 64, 16 * tk, co, lane);
#pragma unroll
        for (int td = 0; td < NTD; ++td)
#pragma unroll
            for (int s2 = 0; s2 < 2; ++s2) {
                const f32x4 e0 = *(const LAS f32x4*)(ER + 32 * td + 16 * s2 + 4 * hh), e1 = *(const LAS f32x4*)(ER + 32 * td + 16 * s2 + 8 + 4 * hh);
                sbp[td][s2] = pack_acc8(S[td][0], s2, e0.x, e0.y, e0.z, e0.w, e1.x, e1.y, e1.z, e1.w);
            }
#pragma unroll
        for (int tk = 0; tk < 4; ++tk) asm volatile("" : "+v"(vbf[tk]));
        {
            f32x16 Z0 = f32x16{}, Z1 = f32x16{};
#pragma unroll
            for (int td = 0; td < NTD; ++td)
#pragma unroll
                for (int s2 = 0; s2 < 2; ++s2) {
                    Z0 = __builtin_amdgcn_mfma_f32_32x32x16_bf16(sbp[td][s2], q0[2 * td + s2], Z0, 0, 0, 0);
                    Z1 = __builtin_amdgcn_mfma_f32_32x32x16_bf16(sbp[td][s2], q1[2 * td + s2], Z1, 0, 0, 0);
                }
#pragma unroll
            for (int s2 = 0; s2 < 2; ++s2) {
                Z0 = __builtin_amdgcn_mfma_f32_32x32x16_bf16(vbf[s2], pa00[s2], Z0, 0, 0, 0);
                Z1 = __builtin_amdgcn_mfma_f32_32x32x16_bf16(vbf[s2], pa01[s2], Z1, 0, 0, 0);
            }
#pragma unroll
            for (int s2 = 0; s2 < 2; ++s2) Z1 = __builtin_amdgcn_mfma_f32_32x32x16_bf16(vbf[2 + s2], pa11[s2], Z1, 0, 0, 0);
            bf16* orow0 = OSC + (size_t)(si.row0 + t0 + tstp * r32) * 256 + h * 64 + co + 4 * hh;
            bf16* orow1 = OSC + (size_t)(si.row0 + t0 + tstp * (32 + r32)) * 256 + h * 64 + co + 4 * hh;
#pragma unroll
            for (int g4 = 0; g4 < 4; ++g4) {
                v2u w; w.x = pk2(Z0[4 * g4], Z0[4 * g4 + 1]); w.y = pk2(Z0[4 * g4 + 2], Z0[4 * g4 + 3]); *(v2u*)(orow0 + 8 * g4) = w;
                v2u w1; w1.x = pk2(Z1[4 * g4], Z1[4 * g4 + 1]); w1.y = pk2(Z1[4 * g4 + 2], Z1[4 * g4 + 3]); *(v2u*)(orow1 + 8 * g4) = w1;
            }
        }
        {
            s16x8 kaf[NTD][4];
#pragma unroll
            for (int td = 0; td < NTD; ++td)
#pragma unroll
                for (int tk = 0; tk < 4; ++tk) kaf[td][tk] = frag_tr_sw(B1, DK, 16 * tk, 32 * td, lane);
#pragma unroll
            for (int td = 0; td < NTD; ++td)
#pragma unroll
                for (int tk = 0; tk < 4; ++tk) asm volatile("" : "+v"(kaf[td][tk]));
            f32x16 U[NTD];
#pragma unroll
            for (int td = 0; td < NTD; ++td) U[td] = f32x16{};
#pragma unroll
            for (int tk = 0; tk < 4; ++tk)
#pragma unroll
                for (int td = 0; td < NTD; ++td) U[td] = __builtin_amdgcn_mfma_f32_32x32x16_bf16(kaf[td][tk], vbf[tk], U[td], 0, 0, 0);
#pragma unroll
            for (int td = 0; td < NTD; ++td)
#pragma unroll
                for (int g4 = 0; g4 < 4; ++g4) {
                    const f32x4 fb = *(const LAS f32x4*)(EBL + 32 * td + 8 * g4 + 4 * hh), fl = *(const LAS f32x4*)(EL + 32 * td + 8 * g4 + 4 * hh);
#pragma unroll
                    for (int j = 0; j < 4; ++j) S[td][0][4 * g4 + j] = fb[j] * S[td][0][4 * g4 + j] + fl[j] * U[td][4 * g4 + j];
                }
        }
        } else {
        s16x8 pa00[2], pa01[2], pa11[2];
        {
            s16x8 qf[KS];
#pragma unroll
            for (int ks = 0; ks < KS; ++ks) qf[ks] = frag_a(B0, DK, r32, ks, hh);
            f32x16 x = f32x16{};
#pragma unroll
            for (int ks = 0; ks < KS; ++ks) { const s16x8 k0 = frag_a(B1, DK, r32, ks, hh); x = __builtin_amdgcn_mfma_f32_32x32x16_bf16(k0, qf[ks], x, 0, 0, 0); }
#pragma unroll
            for (int rg = 0; rg < 16; ++rg) { const int jr = (rg & 3) + 8 * (rg >> 2) + 4 * hh; if (jr > r32) x[rg] = 0.f; }
            pa00[0] = pack_acc8(x, 0, 1, 1, 1, 1, 1, 1, 1, 1); pa00[1] = pack_acc8(x, 1, 1, 1, 1, 1, 1, 1, 1, 1);
            asm volatile("" : "+v"(pa00[0]), "+v"(pa00[1]));
#pragma unroll
            for (int ks = 0; ks < KS; ++ks) qf[ks] = frag_a(B0, DK, 32 + r32, ks, hh);
            x = f32x16{};
#pragma unroll
            for (int ks = 0; ks < KS; ++ks) { const s16x8 k0 = frag_a(B1, DK, r32, ks, hh); x = __builtin_amdgcn_mfma_f32_32x32x16_bf16(k0, qf[ks], x, 0, 0, 0); }
            pa01[0] = pack_acc8(x, 0, 1, 1, 1, 1, 1, 1, 1, 1); pa01[1] = pack_acc8(x, 1, 1, 1, 1, 1, 1, 1, 1, 1);
            asm volatile("" : "+v"(pa01[0]), "+v"(pa01[1]));
            x = f32x16{};
#pragma unroll
            for (int ks = 0; ks < KS; ++ks) { const s16x8 k1 = frag_a(B1, DK, 32 + r32, ks, hh); x = __builtin_amdgcn_mfma_f32_32x32x16_bf16(k1, qf[ks], x, 0, 0, 0); }
#pragma unroll
            for (int rg = 0; rg < 16; ++rg) { const int jr = (rg & 3) + 8 * (rg >> 2) + 4 * hh; if (jr > r32) x[rg] = 0.f; }
            pa11[0] = pack_acc8(x, 0, 1, 1, 1, 1, 1, 1, 1, 1); pa11[1] = pack_acc8(x, 1, 1, 1, 1, 1, 1, 1, 1, 1);
            asm volatile("" : "+v"(pa11[0]), "+v"(pa11[1]));
        }
#pragma unroll
        for (int ti = 0; ti < 2; ++ti) {
            f32x16 Z[NTE];
#pragma unroll
            for (int te = 0; te < NTE; ++te) Z[te] = f32x16{};
#pragma unroll
            for (int td = 0; td < NTD; ++td)
#pragma unroll
                for (int s2 = 0; s2 < 2; ++s2) {
                    const f32x4 e0 = *(const LAS f32x4*)(ER + 32 * td + 16 * s2 + 4 * hh), e1 = *(const LAS f32x4*)(ER + 32 * td + 16 * s2 + 8 + 4 * hh);
                    const s16x8 qa = frag_a(B0, DK, 32 * ti + r32, 2 * td + s2, hh);
#pragma unroll
                    for (int te = 0; te < NTE; ++te) {
                        const s16x8 sb = pack_acc8(S[td][te], s2, e0.x, e0.y, e0.z, e0.w, e1.x, e1.y, e1.z, e1.w);
                        Z[te] = __builtin_amdgcn_mfma_f32_32x32x16_bf16(sb, qa, Z[te], 0, 0, 0);
                    }
                }
#pragma unroll
            for (int tj = 0; tj <= ti; ++tj)
#pragma unroll
                for (int s2 = 0; s2 < 2; ++s2) {
                    const s16x8 pa = (ti == 0) ? pa00[s2] : (tj == 0 ? pa01[s2] : pa11[s2]);
#pragma unroll
                    for (int te = 0; te < NTE; ++te) {
                        const s16x8 vb = frag_tr_sw(VR, 64, 32 * tj + 16 * s2, 32 * te + co, lane);
                        Z[te] = __builtin_amdgcn_mfma_f32_32x32x16_bf16(vb, pa, Z[te], 0, 0, 0);
                    }
                }
            {
                bf16* orow = OSC + (size_t)(si.row0 + t0 + tstp * (32 * ti + r32)) * 256 + h * 64 + co + 4 * hh;
#pragma unroll
                for (int te = 0; te < NTE; ++te)
#pragma unroll
                    for (int g4 = 0; g4 < 4; ++g4) { v2u w; w.x = pk2(Z[te][4 * g4], Z[te][4 * g4 + 1]); w.y = pk2(Z[te][4 * g4 + 2], Z[te][4 * g4 + 3]); *(v2u*)(orow + 32 * te + 8 * g4) = w; }
            }
        }
#pragma unroll
        for (int td = 0; td < NTD; ++td) {
            f32x16 U[NTE];
#pragma unroll
            for (int te = 0; te < NTE; ++te) U[te] = f32x16{};
#pragma unroll
            for (int tk = 0; tk < 4; ++tk) {
                const s16x8 ka = frag_tr_sw(B1, DK, 16 * tk, 32 * td, lane);
#pragma unroll
                for (int te = 0; te < NTE; ++te) {
                    const s16x8 vb = frag_tr_sw(VR, 64, 16 * tk, 32 * te + co, lane);
                    U[te] = __builtin_amdgcn_mfma_f32_32x32x16_bf16(ka, vb, U[te], 0, 0, 0);
                }
            }
#pragma unroll
            for (int rg = 0; rg < 16; ++rg) {
                const int dd = 32 * td + (rg & 3) + 8 * (rg >> 2) + 4 * hh;
                const float fb = EBL[dd], fl = EL[dd];
#pragma unroll
                for (int te = 0; te < NTE; ++te) S[td][te][rg] = fb * S[td][te][rg] + fl * U[te][rg];
            }
        }
        }
        LDS_WAIT(); asm volatile("" ::: "memory");
    }
#undef GH_LOAD
#undef GH_VDMA
    if (si.ctx) {
        int lf_ = hw_lane(); asm volatile("" : "+v"(lf_));
        const int lane = lf_, r32 = lane & 31, hh = lane >> 5;
        float* o = a.out + (HG ? O_SH : O_SG) + (size_t)((((si.b * NL + l) * 2 + dir) * 4 + h) * DK) * 64;
#pragma unroll
        for (int td = 0; td < NTD; ++td)
#pragma unroll
            for (int te = 0; te < NTE; ++te)
#pragma unroll
                for (int rg = 0; rg < 16; ++rg) o[(size_t)(32 * td + (rg & 3) + 8 * (rg >> 2) + 4 * hh) * 64 + 32 * te + co + r32] = S[td][te][rg];
    }
}

constexpr int DNI_TT = 0, DNI_PA = 2048, DNI_TB = 4096, DNI_BYTES = 4608;
__device__ __forceinline__ unsigned char* dn_img(const KArgs& a, int c32, int h, int dir) { return a.ws + (dir == 0 ? WS_DNI0 : WS_DNI1) + (size_t)(c32 * 4 + h) * DNI_BYTES; }
__device__ __forceinline__ void prep_dn(const KArgs& a, int l, int c32, int h, int dir, LAS unsigned char* sm, int lane_in) {
    int lane = lane_in; asm volatile("" : "+v"(lane));
    const int r32 = lane & 31, hh = lane >> 5;
    const bf16* PB = (const bf16*)(a.ws + WS_PB); const float* PF = (const float*)(a.ws + WS_PF);
    bf16* DQ = (bf16*)(a.ws + WS_DNT); bf16* DK_ = DQ + (size_t)M * 256; bf16* DV = DK_ + (size_t)M * 256;
    LAS bf16* QR = (LAS bf16*)sm; LAS bf16* KR = (LAS bf16*)(sm + 4096);
    LAS float* AD = (LAS float*)(sm + 8192);
    LAS float* DC = (LAS float*)(sm + 12288); LAS float* RQ = DC + 32; LAS float* RK = DC + 64; LAS float* BRK = DC + 96;
    unsigned char* img = dn_img(a, c32, h, dir);
    const int sb = c32 < 256 ? (c32 & ~7) : 256 + ((c32 - 256) & ~31), first = sb * 32, last = (c32 < 256 ? sb + 8 : sb + 32) * 32 - 1;
    const int tstp = dir == 0 ? 1 : -1, rowb = c32 * 32 + (dir == 0 ? 0 : 31);
    {
        const float* cw = a.in[I_DCONV] + (size_t)l * 3 * 768; const int cch = h * 64 + lane;
        const float q0 = cw[cch], q2 = cw[1536 + cch], k0 = cw[256 + cch], k2 = cw[1536 + 256 + cch], v0 = cw[512 + cch], v2 = cw[1536 + 512 + cch];
        const float wq1 = cw[768 + cch], wk1 = cw[768 + 256 + cch], wv1 = cw[768 + 512 + cch];
        const float wqa = dir == 0 ? q0 : q2, wqb = dir == 0 ? q2 : q0, wka = dir == 0 ? k0 : k2, wkb = dir == 0 ? k2 : k0, wva = dir == 0 ? v0 : v2, wvb = dir == 0 ? v2 : v0;
        const bf16* xb = PB + C_DNX + cch;
        unsigned xqk[34], xvv[34];
#pragma unroll
        for (int i = 0; i < 34; ++i) {
            const int row = rowb + tstp * (i - 1);
            if ((i > 0 && i < 33) || (row >= first && row <= last)) { const bf16* p = xb + (size_t)row * NPB; const unsigned lo = p[0], hi = p[256]; xqk[i] = lo | (hi << 16); xvv[i] = p[512]; }
            else { xqk[i] = 0u; xvv[i] = 0u; }
        }
#pragma unroll
        for (int tau = 0; tau < 32; ++tau) {
            const int row = rowb + tstp * tau;
            const float pq = bflo(xqk[tau]), pk = bfhi(xqk[tau]), pv = bflo(xvv[tau]), cq = bflo(xqk[tau + 1]), ck = bfhi(xqk[tau + 1]), cv = bflo(xvv[tau + 1]), nq = bflo(xqk[tau + 2]), nk = bfhi(xqk[tau + 2]), nv = bflo(xvv[tau + 2]);
            const float yq = pq * wqa + cq * wq1 + nq * wqb, yk = pk * wka + ck * wk1 + nk * wkb, yv = pv * wva + cv * wv1 + nv * wvb;
            const unsigned qb_ = f2bf(yq * fast_sig(yq)), kb_ = f2bf(yk * fast_sig(yk));
            { const int off = tau * 64 + (((lane >> 3) ^ (tau & 7)) << 3) + (lane & 7); QR[off] = (bf16)qb_; KR[off] = (bf16)kb_; }
            if (dir == 0) { const size_t o = (size_t)row * 256 + cch; DQ[o] = (bf16)qb_; DK_[o] = (bf16)kb_; DV[o] = (bf16)f2bf(yv * fast_sig(yv)); }
        }
    }
    LDS_WAIT(); asm volatile("" ::: "memory");
    float bt, dl;
    {
        const LAS bf16* rp = (hh == 0 ? QR : KR) + r32 * 64; float ss = 0.f;
#pragma unroll
        for (int c8 = 0; c8 < 8; ++c8) { const v4u w = *(const LAS v4u*)(rp + 8 * (c8 ^ (r32 & 7)));
            ss += bflo(w.x) * bflo(w.x) + bfhi(w.x) * bfhi(w.x) + bflo(w.y) * bflo(w.y) + bfhi(w.y) * bfhi(w.y) + bflo(w.z) * bflo(w.z) + bfhi(w.z) * bfhi(w.z) + bflo(w.w) * bflo(w.w) + bfhi(w.w) * bfhi(w.w); }
        const float rs = 1.0f / sqrtf(ss + 1e-6f);
        if (hh == 0) RQ[r32] = rs * 0.125f; else RK[r32] = rs;
        const size_t row = (size_t)(rowb + tstp * r32);
        bt = fast_sig(PF[row * NPF + F_DNB + dir * 4 + h]);
        const float dtb = a.in[I_DDT][(l * 2 + dir) * 4 + h], aexp = expf(a.in[I_DALOG][(l * 2 + dir) * 4 + h]);
        float d = -aexp * softplusf_(PF[row * NPF + F_DNA + dir * 4 + h] + dtb);
#pragma unroll
        for (int k = 1; k < 32; k <<= 1) { const float o = __builtin_bit_cast(float, __builtin_amdgcn_ds_bpermute((lane - k) << 2, __builtin_bit_cast(int, d))); if (r32 >= k) d += o; }
        dl = __builtin_bit_cast(float, __builtin_amdgcn_readlane(__builtin_bit_cast(int, d), 31));
        LDS_WAIT(); asm volatile("" ::: "memory");
        const float rq = RQ[r32], rk = RK[r32], ed = __expf(d);
        if (hh == 0) {
            DC[r32] = d; BRK[r32] = bt * rk;
            float* tb = (float*)(img + DNI_TB);
            tb[r32] = -ed * rk; tb[32 + r32] = rk * __expf(dl - d); tb[64 + r32] = rq * ed; if (r32 == 0) tb[96] = __expf(dl);
        }
    }
    LDS_WAIT(); asm volatile("" ::: "memory");
    {
        f32x16 xk = f32x16{}, xq = f32x16{};
#pragma unroll
        for (int ks = 0; ks < 4; ++ks) { const s16x8 kf = frag_a(KR, 64, r32, ks, hh), qf = frag_a(QR, 64, r32, ks, hh);
            xk = __builtin_amdgcn_mfma_f32_32x32x16_bf16(kf, kf, xk, 0, 0, 0); xq = __builtin_amdgcn_mfma_f32_32x32x16_bf16(kf, qf, xq, 0, 0, 0); }
        const float di = DC[r32], brki = BRK[r32], rqi = RQ[r32];
#pragma unroll
        for (int g4 = 0; g4 < 4; ++g4) {
            const f32x4 dm = *(const LAS f32x4*)(DC + 8 * g4 + 4 * hh), rkm = *(const LAS f32x4*)(RK + 8 * g4 + 4 * hh);
            f32x4 av;
#pragma unroll
            for (int j = 0; j < 4; ++j) {
                const int m = 8 * g4 + 4 * hh + j;
                const float Dv = (m <= r32) ? __expf(di - dm[j]) : 0.f;
                av[j] = (m < r32) ? brki * rkm[j] * xk[4 * g4 + j] * Dv : 0.f;
                xq[4 * g4 + j] = rqi * rkm[j] * xq[4 * g4 + j] * Dv;
            }
            *(LAS f32x4*)(AD + r32 * 32 + 8 * g4 + 4 * hh) = av;
        }
        const s16x8 p0 = pack_acc8(xq, 0, 1, 1, 1, 1, 1, 1, 1, 1), p1 = pack_acc8(xq, 1, 1, 1, 1, 1, 1, 1, 1, 1);
        *(s16x8*)(img + DNI_PA + lane * 16) = p0; *(s16x8*)(img + DNI_PA + 1024 + lane * 16) = p1;
    }
    LDS_WAIT(); asm volatile("" ::: "memory");
    {
        float t[32];
#pragma unroll
        for (int i = 0; i < 32; ++i) {
            float acc = (i == r32) ? 1.0f : 0.0f;
#pragma unroll
            for (int m4 = 0; m4 < (i + 3) / 4; ++m4) {
                const f32x4 a4 = *(const LAS f32x4*)(AD + i * 32 + 4 * m4);
                if (4 * m4 + 0 < i) acc -= a4.x * t[4 * m4 + 0];
                if (4 * m4 + 1 < i) acc -= a4.y * t[4 * m4 + 1];
                if (4 * m4 + 2 < i) acc -= a4.z * t[4 * m4 + 2];
                if (4 * m4 + 3 < i) acc -= a4.w * t[4 * m4 + 3];
            }
            t[i] = acc;
        }
        bf16* TT = (bf16*)(img + DNI_TT);
#pragma unroll
        for (int i = 0; i < 16; ++i) { const float v = (hh == 0 ? t[i] : t[16 + i]) * bt; TT[(16 * hh + i) * 32 + r32] = (bf16)f2bf(v); }
    }
    LDS_WAIT(); asm volatile("" ::: "memory");
}

constexpr int DN_LDS = 16384;
template <bool SPLIT>
__device__ __forceinline__ void chain_dn(const KArgs& a, int l, int s, int h, int dir, int te0, LAS unsigned char* sm, int lane_in) {
    constexpr int NTE = SPLIT ? 1 : 2; const int co = SPLIT ? 32 * te0 : 0;
    int lane_o = lane_in; asm volatile("" : "+v"(lane_o));
    const SeqInfo si = seq_info(s);
    const bf16* DQ = (const bf16*)(a.ws + WS_DNT); const bf16* DK_ = DQ + (size_t)M * 256; const bf16* DV = DK_ + (size_t)M * 256;
    bf16* OSC = (bf16*)(a.ws + WS_OSC) + (size_t)(dir * 3 + 1) * M * 256;
    LAS bf16* QR = (LAS bf16*)sm; LAS bf16* KR = (LAS bf16*)(sm + 4096);
    LAS bf16* TT = (LAS bf16*)(sm + 12288);
    LAS float* NBE = (LAS float*)(sm + 14336); LAS float* RKL = NBE + 32; LAS float* RQE = NBE + 64;
    f32x16 S[2][NTE];
    { const int lane = lane_o, r32 = lane & 31, hh = lane >> 5;
#pragma unroll
      for (int td = 0; td < 2; ++td)
#pragma unroll
        for (int te = 0; te < NTE; ++te) {
            if (si.ctx) { S[td][te] = f32x16{}; }
            else {
                const float* st = a.in[I_SDN] + (size_t)((((si.b * NL + l) * 2 + dir) * 4 + h) * 64) * 64 + 32 * te + co + r32;
#pragma unroll
                for (int rg = 0; rg < 16; ++rg) S[td][te][rg] = st[(size_t)(32 * td + (rg & 3) + 8 * (rg >> 2) + 4 * hh) * 64];
            }
        }
    }
    const int NC = si.T / 32;
    v4u nq[4], nk[4], nt[2]; s16x8 npa[2]; float nf0, nf1, nf2, nedl;
#define DN_LOAD(cs_) do { const int tb_ = dir == 0 ? (cs_) : NC - 1 - (cs_), c32_ = si.row0 / 32 + tb_, t0_ = dir == 0 ? tb_ * 32 : tb_ * 32 + 31, ts_ = dir == 0 ? 1 : -1; \
        const unsigned char* img_ = dn_img(a, c32_, h, dir); \
        _Pragma("unroll") for (int i_ = 0; i_ < 4; ++i_) { const int p_ = lane + 64 * i_; const size_t o_ = (size_t)(si.row0 + t0_ + ts_ * (p_ >> 3)) * 256 + h * 64 + 8 * (p_ & 7); \
            nq[i_] = *(const v4u*)(DQ + o_); nk[i_] = *(const v4u*)(DK_ + o_); } \
        nt[0] = *(const v4u*)(img_ + DNI_TT + lane * 16); nt[1] = *(const v4u*)(img_ + DNI_TT + 1024 + lane * 16); \
        npa[0] = *(const s16x8*)(img_ + DNI_PA + lane * 16); npa[1] = *(const s16x8*)(img_ + DNI_PA + 1024 + lane * 16); \
        const float* tb2_ = (const float*)(img_ + DNI_TB); nf0 = tb2_[lane & 31]; nf1 = tb2_[32 + (lane & 31)]; nf2 = tb2_[64 + (lane & 31)]; nedl = tb2_[96]; } while (0)
#define DN_VDMA(cs_) do { const int tb_ = dir == 0 ? (cs_) : NC - 1 - (cs_), t0_ = dir == 0 ? tb_ * 32 : tb_ * 32 + 31, ts_ = dir == 0 ? 1 : -1; \
        LAS unsigned char* vd_ = sm + (((cs_) & 1) ? 16384 : 8192); \
        _Pragma("unroll") for (int i_ = 0; i_ < 4; ++i_) { const int p_ = lane + 64 * i_; \
            __builtin_amdgcn_global_load_lds((const unsigned*)(DV + (size_t)(si.row0 + t0_ + ts_ * (p_ >> 3)) * 256 + h * 64 + 8 * ((p_ & 7) ^ ((p_ >> 3) & 7))), (LAS unsigned*)(vd_ + i_ * 1024), 16, 0, 0); } } while (0)
    { const int lane = lane_o; DN_LOAD(0); DN_VDMA(0); }
#pragma unroll 1
    for (int cs = 0; cs < NC; ++cs) {
        int lane_c = hw_lane(); asm volatile("" : "+v"(lane_c));
        const int lane = lane_c, r32 = lane & 31, hh = lane >> 5;
        const int tb = dir == 0 ? cs : NC - 1 - cs;
        const int t0 = dir == 0 ? tb * 32 : tb * 32 + 31, tstp = dir == 0 ? 1 : -1;
        s16x8 pa[2]; float edl;
        {
#pragma unroll
            for (int i = 0; i < 4; ++i) { const int p = lane + 64 * i, off = (p >> 3) * 128 + (((p & 7) ^ ((p >> 3) & 7)) << 4); *(LAS v4u*)((LAS unsigned char*)QR + off) = nq[i]; *(LAS v4u*)((LAS unsigned char*)KR + off) = nk[i]; }
            { const int row = lane >> 2, off = row * 64 + (((lane & 3) ^ ((row >> 1) & 3)) << 4); *(LAS v4u*)((LAS unsigned char*)TT + off) = nt[0]; *(LAS v4u*)((LAS unsigned char*)TT + 1024 + off) = nt[1]; }
            if (hh == 0) { NBE[r32] = nf0; RKL[r32] = nf1; RQE[r32] = nf2; }
            pa[0] = npa[0]; pa[1] = npa[1]; edl = nedl;
            asm volatile("s_waitcnt vmcnt(0)" ::: "memory");
            const int csn = cs + 1 < NC ? cs + 1 : cs; DN_LOAD(csn); if (cs + 1 < NC) DN_VDMA(cs + 1);
#ifdef PROBE_DN_NOPF
            asm volatile("s_waitcnt vmcnt(0)" ::: "memory");
#endif
        }
        LAS bf16* VR = (LAS bf16*)(sm + ((cs & 1) ? 16384 : 8192));
        LDS_WAIT(); asm volatile("" ::: "memory");
        if constexpr (SPLIT) {
        s16x8 kf[4], qf[4], tf[2], vfr[2];
#pragma unroll
        for (int ks = 0; ks < 4; ++ks) { kf[ks] = frag_a(KR, 64, r32, ks, hh); qf[ks] = frag_a(QR, 64, r32, ks, hh); }
#pragma unroll
        for (int s2 = 0; s2 < 2; ++s2) { tf[s2] = frag_a(TT, 32, r32, s2, hh); vfr[s2] = frag_tr_sw(VR, 64, 16 * s2, co, lane); }
#pragma unroll
        for (int ks = 0; ks < 4; ++ks) asm volatile("" : "+v"(kf[ks]), "+v"(qf[ks]));
#pragma unroll
        for (int s2 = 0; s2 < 2; ++s2) asm volatile("" : "+v"(tf[s2]), "+v"(vfr[s2]));
        s16x8 sb[4];
#pragma unroll
        for (int ks = 0; ks < 4; ++ks) sb[ks] = pack_acc8(S[ks >> 1][0], ks & 1, 1, 1, 1, 1, 1, 1, 1, 1);
        f32x16 ksa = f32x16{}, Z = f32x16{}, vn = f32x16{};
#pragma unroll
        for (int s2 = 0; s2 < 2; ++s2) vn = __builtin_amdgcn_mfma_f32_32x32x16_bf16(tf[s2], vfr[s2], vn, 0, 0, 0);
#pragma unroll
        for (int ks = 0; ks < 4; ++ks) {
            ksa = __builtin_amdgcn_mfma_f32_32x32x16_bf16(kf[ks], sb[ks], ksa, 0, 0, 0);
            Z = __builtin_amdgcn_mfma_f32_32x32x16_bf16(sb[ks], qf[ks], Z, 0, 0, 0);
        }
        s16x8 ka[2][2]; f32x4 nb[2][2], rkl[2][2];
#pragma unroll
        for (int s2 = 0; s2 < 2; ++s2) {
#pragma unroll
            for (int td = 0; td < 2; ++td) ka[s2][td] = frag_tr_sw(KR, 64, 16 * s2, 32 * td, lane);
            nb[s2][0] = *(const LAS f32x4*)(NBE + 16 * s2 + 4 * hh); nb[s2][1] = *(const LAS f32x4*)(NBE + 16 * s2 + 8 + 4 * hh);
            rkl[s2][0] = *(const LAS f32x4*)(RKL + 16 * s2 + 4 * hh); rkl[s2][1] = *(const LAS f32x4*)(RKL + 16 * s2 + 8 + 4 * hh);
        }
        const float rqe = RQE[r32];
#pragma unroll
        for (int s2 = 0; s2 < 2; ++s2) asm volatile("" : "+v"(ka[s2][0]), "+v"(ka[s2][1]));
#pragma unroll
        for (int s2 = 0; s2 < 2; ++s2) {
            const s16x8 ksf = pack_acc8(ksa, s2, nb[s2][0].x, nb[s2][0].y, nb[s2][0].z, nb[s2][0].w, nb[s2][1].x, nb[s2][1].y, nb[s2][1].z, nb[s2][1].w);
            vn = __builtin_amdgcn_mfma_f32_32x32x16_bf16(tf[s2], ksf, vn, 0, 0, 0);
        }
#pragma unroll
        for (int rg = 0; rg < 16; ++rg) Z[rg] *= rqe;
#pragma unroll
        for (int td = 0; td < 2; ++td)
#pragma unroll
            for (int rg = 0; rg < 16; ++rg) S[td][0][rg] *= edl;
        s16x8 b0[2], b0s[2];
#pragma unroll
        for (int s2 = 0; s2 < 2; ++s2) {
            b0[s2] = pack_acc8(vn, s2, 1, 1, 1, 1, 1, 1, 1, 1);
            b0s[s2] = pack_acc8(vn, s2, rkl[s2][0].x, rkl[s2][0].y, rkl[s2][0].z, rkl[s2][0].w, rkl[s2][1].x, rkl[s2][1].y, rkl[s2][1].z, rkl[s2][1].w);
        }
#pragma unroll
        for (int s2 = 0; s2 < 2; ++s2) {
            Z = __builtin_amdgcn_mfma_f32_32x32x16_bf16(b0[s2], pa[s2], Z, 0, 0, 0);
#pragma unroll
            for (int td = 0; td < 2; ++td) S[td][0] = __builtin_amdgcn_mfma_f32_32x32x16_bf16(ka[s2][td], b0s[s2], S[td][0], 0, 0, 0);
        }
        {
            bf16* orow = OSC + (size_t)(si.row0 + t0 + tstp * r32) * 256 + h * 64 + co + 4 * hh;
#pragma unroll
            for (int g4 = 0; g4 < 4; ++g4) { v2u w; w.x = pk2(Z[4 * g4], Z[4 * g4 + 1]); w.y = pk2(Z[4 * g4 + 2], Z[4 * g4 + 3]); *(v2u*)(orow + 8 * g4) = w; }
        }
        } else {
        s16x8 ksf[2][NTE]; f32x16 Z[NTE];
        {
            f32x16 ksa[NTE];
#pragma unroll
            for (int te = 0; te < NTE; ++te) { ksa[te] = f32x16{}; Z[te] = f32x16{}; }
#pragma unroll
            for (int ks = 0; ks < 4; ++ks) {
                const s16x8 kf = frag_a(KR, 64, r32, ks, hh), qf = frag_a(QR, 64, r32, ks, hh);
#pragma unroll
                for (int te = 0; te < NTE; ++te) {
                    const s16x8 sb = pack_acc8(S[ks >> 1][te], ks & 1, 1, 1, 1, 1, 1, 1, 1, 1);
                    ksa[te] = __builtin_amdgcn_mfma_f32_32x32x16_bf16(kf, sb, ksa[te], 0, 0, 0);
                    Z[te] = __builtin_amdgcn_mfma_f32_32x32x16_bf16(sb, qf, Z[te], 0, 0, 0);
                }
            }
#pragma unroll
            for (int s2 = 0; s2 < 2; ++s2) {
                const f32x4 n0 = *(const LAS f32x4*)(NBE + 16 * s2 + 4 * hh), n1 = *(const LAS f32x4*)(NBE + 16 * s2 + 8 + 4 * hh);
#pragma unroll
                for (int te = 0; te < NTE; ++te) ksf[s2][te] = pack_acc8(ksa[te], s2, n0.x, n0.y, n0.z, n0.w, n1.x, n1.y, n1.z, n1.w);
            }
            { const float f = RQE[r32];
#pragma unroll
              for (int te = 0; te < NTE; ++te)
#pragma unroll
                for (int rg = 0; rg < 16; ++rg) Z[te][rg] *= f; }
        }
        {
            f32x16 vn[NTE];
#pragma unroll
            for (int te = 0; te < NTE; ++te) vn[te] = f32x16{};
#pragma unroll
            for (int s2 = 0; s2 < 2; ++s2) {
                const s16x8 tf = frag_a(TT, 32, r32, s2, hh);
#pragma unroll
                for (int te = 0; te < NTE; ++te) {
                    const s16x8 v0 = frag_tr_sw(VR, 64, 16 * s2, 32 * te + co, lane);
                    vn[te] = __builtin_amdgcn_mfma_f32_32x32x16_bf16(tf, v0, vn[te], 0, 0, 0);
                    vn[te] = __builtin_amdgcn_mfma_f32_32x32x16_bf16(tf, ksf[s2][te], vn[te], 0, 0, 0);
                }
            }
#pragma unroll
            for (int s2 = 0; s2 < 2; ++s2)
#pragma unroll
                for (int te = 0; te < NTE; ++te) {
                    const s16x8 b0 = pack_acc8(vn[te], s2, 1, 1, 1, 1, 1, 1, 1, 1);
                    Z[te] = __builtin_amdgcn_mfma_f32_32x32x16_bf16(b0, pa[s2], Z[te], 0, 0, 0);
                }
            {
                bf16* orow = OSC + (size_t)(si.row0 + t0 + tstp * r32) * 256 + h * 64 + co + 4 * hh;
#pragma unroll
                for (int te = 0; te < NTE; ++te)
#pragma unroll
                    for (int g4 = 0; g4 < 4; ++g4) { v2u w; w.x = pk2(Z[te][4 * g4], Z[te][4 * g4 + 1]); w.y = pk2(Z[te][4 * g4 + 2], Z[te][4 * g4 + 3]); *(v2u*)(orow + 32 * te + 8 * g4) = w; }
            }
#pragma unroll
            for (int td = 0; td < 2; ++td)
#pragma unroll
                for (int te = 0; te < NTE; ++te)
#pragma unroll
                    for (int rg = 0; rg < 16; ++rg) S[td][te][rg] *= edl;
#pragma unroll
            for (int s2 = 0; s2 < 2; ++s2) {
                const f32x4 f0 = *(const LAS f32x4*)(RKL + 16 * s2 + 4 * hh), f1 = *(const LAS f32x4*)(RKL + 16 * s2 + 8 + 4 * hh);
#pragma unroll
                for (int te = 0; te < NTE; ++te) {
                    const s16x8 b0 = pack_acc8(vn[te], s2, f0.x, f0.y, f0.z, f0.w, f1.x, f1.y, f1.z, f1.w);
#pragma unroll
                    for (int td = 0; td < 2; ++td) {
                        const s16x8 ka = frag_tr_sw(KR, 64, 16 * s2, 32 * td, lane);
                        S[td][te] = __builtin_amdgcn_mfma_f32_32x32x16_bf16(ka, b0, S[td][te], 0, 0, 0);
                    }
                }
            }
        }
        }
        LDS_WAIT(); asm volatile("" ::: "memory");
    }
#undef DN_LOAD
#undef DN_VDMA
    if (si.ctx) {
        int lf_ = hw_lane(); asm volatile("" : "+v"(lf_));
        const int lane = lf_, r32 = lane & 31, hh = lane >> 5;
        float* o = a.out + O_SD + (size_t)((((si.b * NL + l) * 2 + dir) * 4 + h) * 64) * 64;
#pragma unroll
        for (int td = 0; td < 2; ++td)
#pragma unroll
            for (int te = 0; te < NTE; ++te)
#pragma unroll
                for (int rg = 0; rg < 16; ++rg) o[(size_t)(32 * td + (rg & 3) + 8 * (rg >> 2) + 4 * hh) * 64 + 32 * te + co + r32] = S[td][te][rg];
    }
}

typedef short v4i16_t __attribute__((ext_vector_type(4)));
__device__ __forceinline__ float bperm_xor32(float v, int lane) { return __builtin_bit_cast(float, __builtin_amdgcn_ds_bpermute(((lane ^ 32) << 2), __builtin_bit_cast(int, v))); }
__device__ __forceinline__ void attn_mfma(const KArgs& a, int l, int s, int h, int qb, LAS unsigned char* sm, int lane_in) {
    int lane = lane_in; asm volatile("" : "+v"(lane));
    const SeqInfo si = seq_info(s);
    const int r32 = lane & 31, hh = lane >> 5;
    const bf16* PB = (const bf16*)(a.ws + WS_PB);
    const bf16* KC = (const bf16*)(a.ws + WS_KVC) + (size_t)((si.b * 4 + h) * 512) * 64;
    const bf16* VC = KC + (size_t)2 * 4 * 512 * 64;
    LAS bf16* Vs = (LAS bf16*)sm;
    const int q0 = qb * 32;
    const float SC = 0.17677669529663687f * 1.4426950408889634f;
    s16x8 qf[2][2];
#pragma unroll
    for (int mp = 0; mp < 2; ++mp)
#pragma unroll
        for (int ks = 0; ks < 2; ++ks) {
            const v4u w = *(const v4u*)(PB + (size_t)(si.row0 + q0 + r32) * NPB + C_DFQ + h * 64 + mp * 32 + 16 * ks + 8 * hh);
            v4u o; o.x = pk2(bflo(w.x) * SC, bfhi(w.x) * SC); o.y = pk2(bflo(w.y) * SC, bfhi(w.y) * SC); o.z = pk2(bflo(w.z) * SC, bfhi(w.z) * SC); o.w = pk2(bflo(w.w) * SC, bfhi(w.w) * SC);
            qf[mp][ks] = __builtin_bit_cast(s16x8, o);
        }
    const float lam_init = 0.8f - 0.6f * expf(-0.3f * (float)l);
    float lam;
    { const float* lv = a.in[I_DLAM] + (size_t)l * 128; float s01 = 0.f, s23 = 0.f;
      for (int i = 0; i < 32; ++i) { s01 += lv[i] * lv[32 + i]; s23 += lv[64 + i] * lv[96 + i]; }
      lam = expf(s01) - expf(s23) + lam_init; }
    const int nt = si.ctx ? 8 : 48;
    auto krow = [&](int kt, int r) -> const bf16* {
        if (si.ctx) return PB + (size_t)(si.row0 + 32 * kt + r) * NPB + C_DFK + h * 64;
        if (kt < 16) return KC + (size_t)(32 * kt + r) * 64;
        return PB + (size_t)(si.row0 + 32 * (kt - 16) + r) * NPB + C_DFK + h * 64;
    };
    auto vrow = [&](int kt, int r) -> const bf16* {
        if (si.ctx) return PB + (size_t)(si.row0 + 32 * kt + r) * NPB + C_DFV + h * 64;
        if (kt < 16) return VC + (size_t)(32 * kt + r) * 64;
        return PB + (size_t)(si.row0 + 32 * (kt - 16) + r) * NPB + C_DFV + h * 64;
    };
#define LOADK(dst, kt) do { const bf16* kp_ = krow(kt, r32) + 8 * hh; dst[0][0] = *(const s16x8*)(kp_); dst[0][1] = *(const s16x8*)(kp_ + 16); dst[1][0] = *(const s16x8*)(kp_ + 32); dst[1][1] = *(const s16x8*)(kp_ + 48); } while (0)
    float m1 = -1e30f, l1 = 0.f, m2 = -1e30f, l2 = 0.f;
    {
        s16x8 kc[2][2], kn[2][2];
        LOADK(kc, 0);
#pragma unroll 1
        for (int kt = 0; kt < nt; ++kt) {
            { const int ktn = kt + 1 < nt ? kt + 1 : kt; LOADK(kn, ktn); }
            f32x16 x1 = f32x16{}, x2 = f32x16{};
            x1 = __builtin_amdgcn_mfma_f32_32x32x16_bf16(kc[0][0], qf[0][0], x1, 0, 0, 0); x1 = __builtin_amdgcn_mfma_f32_32x32x16_bf16(kc[0][1], qf[0][1], x1, 0, 0, 0);
            x2 = __builtin_amdgcn_mfma_f32_32x32x16_bf16(kc[1][0], qf[1][0], x2, 0, 0, 0); x2 = __builtin_amdgcn_mfma_f32_32x32x16_bf16(kc[1][1], qf[1][1], x2, 0, 0, 0);
            float t1 = x1[0], t2 = x2[0];
#pragma unroll
            for (int rg = 1; rg < 16; ++rg) { t1 = fmaxf(t1, x1[rg]); t2 = fmaxf(t2, x2[rg]); }
            const float n1 = fmaxf(m1, t1), n2 = fmaxf(m2, t2);
            float a1 = 0.f, a2 = 0.f;
#pragma unroll
            for (int rg = 0; rg < 16; ++rg) { a1 += __builtin_amdgcn_exp2f(x1[rg] - n1); a2 += __builtin_amdgcn_exp2f(x2[rg] - n2); }
            l1 = l1 * __builtin_amdgcn_exp2f(m1 - n1) + a1; l2 = l2 * __builtin_amdgcn_exp2f(m2 - n2) + a2; m1 = n1; m2 = n2;
#pragma unroll
            for (int i = 0; i < 2; ++i) { kc[i][0] = kn[i][0]; kc[i][1] = kn[i][1]; }
        }
    }
    { const float mo1 = bperm_xor32(m1, lane), lo1 = bperm_xor32(l1, lane), mo2 = bperm_xor32(m2, lane), lo2 = bperm_xor32(l2, lane);
      const float M1 = fmaxf(m1, mo1), M2 = fmaxf(m2, mo2);
      l1 = l1 * __builtin_amdgcn_exp2f(m1 - M1) + lo1 * __builtin_amdgcn_exp2f(mo1 - M1); l2 = l2 * __builtin_amdgcn_exp2f(m2 - M2) + lo2 * __builtin_amdgcn_exp2f(mo2 - M2); m1 = M1; m2 = M2; }
    const float c1 = 1.0f / l1, c2 = lam / l2;
    f32x16 O0 = f32x16{}, O1 = f32x16{};
    {
        s16x8 kc[2][2], kn[2][2]; v4u vc[4], vn[4];
#define LOADV(dst, kt) do { _Pragma("unroll") for (int i_ = 0; i_ < 4; ++i_) { const int p_ = lane + 64 * i_; dst[i_] = *(const v4u*)(vrow(kt, p_ >> 3) + 8 * (p_ & 7)); } } while (0)
        LOADK(kc, 0); LOADV(vc, 0);
        const int g16 = (lane >> 4) & 1, l16 = lane & 15;
        const int traddr = (4 * hh + (l16 >> 2)) * 128 + (16 * g16 + 4 * (l16 & 3)) * 2;
#pragma unroll 1
        for (int kt = 0; kt < nt; ++kt) {
            { const int ktn = kt + 1 < nt ? kt + 1 : kt; LOADK(kn, ktn); LOADV(vn, ktn); }
#pragma unroll
            for (int i = 0; i < 4; ++i) { const int p = lane + 64 * i; *(LAS v4u*)((LAS unsigned char*)Vs + (p >> 3) * 128 + (((p & 7) ^ ((p >> 3) & 7)) << 4)) = vc[i]; }
            f32x16 x1 = f32x16{}, x2 = f32x16{};
            x1 = __builtin_amdgcn_mfma_f32_32x32x16_bf16(kc[0][0], qf[0][0], x1, 0, 0, 0); x1 = __builtin_amdgcn_mfma_f32_32x32x16_bf16(kc[0][1], qf[0][1], x1, 0, 0, 0);
            x2 = __builtin_amdgcn_mfma_f32_32x32x16_bf16(kc[1][0], qf[1][0], x2, 0, 0, 0); x2 = __builtin_amdgcn_mfma_f32_32x32x16_bf16(kc[1][1], qf[1][1], x2, 0, 0, 0);
#pragma unroll
            for (int rg = 0; rg < 16; ++rg) x1[rg] = __builtin_amdgcn_exp2f(x1[rg] - m1) * c1 - __builtin_amdgcn_exp2f(x2[rg] - m2) * c2;
            const s16x8 pa0 = pack_acc8(x1, 0, 1, 1, 1, 1, 1, 1, 1, 1), pa1 = pack_acc8(x1, 1, 1, 1, 1, 1, 1, 1, 1, 1);
            LDS_WAIT(); asm volatile("" ::: "memory");
#pragma unroll
            for (int s2 = 0; s2 < 2; ++s2) {
#pragma unroll
                for (int te = 0; te < 2; ++te) {
                    const s16x8 vb = frag_tr_sw(Vs, 64, 16 * s2, 32 * te, lane);
                    if (te == 0) O0 = __builtin_amdgcn_mfma_f32_32x32x16_bf16(s2 == 0 ? pa0 : pa1, vb, O0, 0, 0, 0);
                    else O1 = __builtin_amdgcn_mfma_f32_32x32x16_bf16(s2 == 0 ? pa0 : pa1, vb, O1, 0, 0, 0);
                }
            }
#pragma unroll
            for (int i = 0; i < 2; ++i) { kc[i][0] = kn[i][0]; kc[i][1] = kn[i][1]; }
#pragma unroll
            for (int i = 0; i < 4; ++i) vc[i] = vn[i];
            LDS_WAIT(); asm volatile("" ::: "memory");
        }
    }
#undef LOADK
#undef LOADV
    const float* dnw = a.in[I_DFNORM] + (size_t)l * 64;
    const float w0 = dnw[r32], w1 = dnw[32 + r32];
    bf16* BR = (bf16*)(a.ws + WS_BR) + (size_t)3 * M * 256;
#pragma unroll
    for (int rg = 0; rg < 16; ++rg) {
        float ss = O0[rg] * O0[rg] + O1[rg] * O1[rg];
        ss += swz_xor<0x041F>(ss); ss += swz_xor<0x081F>(ss); ss += swz_xor<0x101F>(ss); ss += swz_xor<0x201F>(ss); ss += swz_xor<0x401F>(ss);
        const float rs = (1.0f / sqrtf(ss * (1.0f / 64.0f) + 1e-6f)) * (1.0f - lam_init);
        const int qi = (rg & 3) + 8 * (rg >> 2) + 4 * hh;
        bf16* op = BR + (size_t)(si.row0 + q0 + qi) * 256 + h * 64 + r32;
        op[0] = (bf16)f2bf(O0[rg] * rs * w0); op[32] = (bf16)f2bf(O1[rg] * rs * w1);
    }
}

constexpr size_t ATT_PO = 0, ATT_ML = (size_t)2048 * 4 * 2 * 2 * 64 * 4;
__device__ __forceinline__ void attn_split(const KArgs& a, int l, int s, int h, int qb, int kh, LAS unsigned char* sm, int lane_in) {
    int lane = lane_in; asm volatile("" : "+v"(lane));
    const SeqInfo si = seq_info(s);
    const int r32 = lane & 31, hh = lane >> 5;
    const bf16* PB = (const bf16*)(a.ws + WS_PB);
    const bf16* KC = (const bf16*)(a.ws + WS_KVC) + (size_t)((si.b * 4 + h) * 512) * 64;
    const bf16* VC = KC + (size_t)2 * 4 * 512 * 64;
    LAS bf16* Vs = (LAS bf16*)sm; LAS float* AL = (LAS float*)(sm + 4096);
    const int q0 = qb * 32;
    const float SC = 0.17677669529663687f * 1.4426950408889634f;
    s16x8 qf[2][2];
#pragma unroll
    for (int mp = 0; mp < 2; ++mp)
#pragma unroll
        for (int ks = 0; ks < 2; ++ks) {
            const v4u w = *(const v4u*)(PB + (size_t)(si.row0 + q0 + r32) * NPB + C_DFQ + h * 64 + mp * 32 + 16 * ks + 8 * hh);
            v4u o; o.x = pk2(bflo(w.x) * SC, bfhi(w.x) * SC); o.y = pk2(bflo(w.y) * SC, bfhi(w.y) * SC); o.z = pk2(bflo(w.z) * SC, bfhi(w.z) * SC); o.w = pk2(bflo(w.w) * SC, bfhi(w.w) * SC);
            qf[mp][ks] = __builtin_bit_cast(s16x8, o);
        }
    auto krow = [&](int kt, int r) -> const bf16* { if (kt < 16) return KC + (size_t)(32 * kt + r) * 64; return PB + (size_t)(si.row0 + 32 * (kt - 16) + r) * NPB + C_DFK + h * 64; };
    auto vrow = [&](int kt, int r) -> const bf16* { if (kt < 16) return VC + (size_t)(32 * kt + r) * 64; return PB + (size_t)(si.row0 + 32 * (kt - 16) + r) * NPB + C_DFV + h * 64; };
#define LOADK(dst, kt) do { const bf16* kp_ = krow(kt, r32) + 8 * hh; dst[0][0] = *(const s16x8*)(kp_); dst[0][1] = *(const s16x8*)(kp_ + 16); dst[1][0] = *(const s16x8*)(kp_ + 32); dst[1][1] = *(const s16x8*)(kp_ + 48); } while (0)
#define LOADV(dst, kt) do { _Pragma("unroll") for (int i_ = 0; i_ < 4; ++i_) { const int p_ = lane + 64 * i_; dst[i_] = *(const v4u*)(vrow(kt, p_ >> 3) + 8 * (p_ & 7)); } } while (0)
    float m1 = -1e30f, l1 = 0.f, m2 = -1e30f, l2 = 0.f;
    f32x16 O1a = f32x16{}, O1b = f32x16{}, O2a = f32x16{}, O2b = f32x16{};
    const int kt0 = 24 * kh;
    s16x8 kc[2][2], kn[2][2]; v4u vc[4], vn[4];
    LOADK(kc, kt0); LOADV(vc, kt0);
#pragma unroll 1
    for (int kt = kt0; kt < kt0 + 24; ++kt) {
        { const int ktn = kt + 1 < kt0 + 24 ? kt + 1 : kt; LOADK(kn, ktn); LOADV(vn, ktn); }
#pragma unroll
        for (int i = 0; i < 4; ++i) { const int p = lane + 64 * i; *(LAS v4u*)((LAS unsigned char*)Vs + (p >> 3) * 128 + (((p & 7) ^ ((p >> 3) & 7)) << 4)) = vc[i]; }
        f32x16 x1 = f32x16{}, x2 = f32x16{};
        x1 = __builtin_amdgcn_mfma_f32_32x32x16_bf16(kc[0][0], qf[0][0], x1, 0, 0, 0); x1 = __builtin_amdgcn_mfma_f32_32x32x16_bf16(kc[0][1], qf[0][1], x1, 0, 0, 0);
        x2 = __builtin_amdgcn_mfma_f32_32x32x16_bf16(kc[1][0], qf[1][0], x2, 0, 0, 0); x2 = __builtin_amdgcn_mfma_f32_32x32x16_bf16(kc[1][1], qf[1][1], x2, 0, 0, 0);
        float t1 = x1[0], t2 = x2[0];
#pragma unroll
        for (int rg = 1; rg < 16; ++rg) { t1 = fmaxf(t1, x1[rg]); t2 = fmaxf(t2, x2[rg]); }
        t1 = fmaxf(t1, bperm_xor32(t1, lane)); t2 = fmaxf(t2, bperm_xor32(t2, lane));
        const float n1 = fmaxf(m1, t1), n2 = fmaxf(m2, t2);
        if (__any((n1 > m1) || (n2 > m2))) {
            const float a1 = __builtin_amdgcn_exp2f(m1 - n1), a2 = __builtin_amdgcn_exp2f(m2 - n2);
            if (hh == 0) { AL[r32] = a1; AL[32 + r32] = a2; }
            l1 *= a1; l2 *= a2;
            LDS_WAIT(); asm volatile("" ::: "memory");
#pragma unroll
            for (int g4 = 0; g4 < 4; ++g4) {
                const f32x4 f1 = *(const LAS f32x4*)(AL + 8 * g4 + 4 * hh), f2 = *(const LAS f32x4*)(AL + 32 + 8 * g4 + 4 * hh);
#pragma unroll
                for (int j = 0; j < 4; ++j) { O1a[4 * g4 + j] *= f1[j]; O1b[4 * g4 + j] *= f1[j]; O2a[4 * g4 + j] *= f2[j]; O2b[4 * g4 + j] *= f2[j]; }
            }
        }
        m1 = n1; m2 = n2;
        float s1 = 0.f, s2 = 0.f;
#pragma unroll
        for (int rg = 0; rg < 16; ++rg) { x1[rg] = __builtin_amdgcn_exp2f(x1[rg] - n1); x2[rg] = __builtin_amdgcn_exp2f(x2[rg] - n2); s1 += x1[rg]; s2 += x2[rg]; }
        l1 += s1; l2 += s2;
        const s16x8 p10 = pack_acc8(x1, 0, 1, 1, 1, 1, 1, 1, 1, 1), p11 = pack_acc8(x1, 1, 1, 1, 1, 1, 1, 1, 1, 1), p20 = pack_acc8(x2, 0, 1, 1, 1, 1, 1, 1, 1, 1), p21 = pack_acc8(x2, 1, 1, 1, 1, 1, 1, 1, 1, 1);
        LDS_WAIT(); asm volatile("" ::: "memory");
#pragma unroll
        for (int s2_ = 0; s2_ < 2; ++s2_) {
            const s16x8 v0 = frag_tr_sw(Vs, 64, 16 * s2_, 0, lane), v1 = frag_tr_sw(Vs, 64, 16 * s2_, 32, lane);
            O1a = __builtin_amdgcn_mfma_f32_32x32x16_bf16(s2_ == 0 ? p10 : p11, v0, O1a, 0, 0, 0); O1b = __builtin_amdgcn_mfma_f32_32x32x16_bf16(s2_ == 0 ? p10 : p11, v1, O1b, 0, 0, 0);
            O2a = __builtin_amdgcn_mfma_f32_32x32x16_bf16(s2_ == 0 ? p20 : p21, v0, O2a, 0, 0, 0); O2b = __builtin_amdgcn_mfma_f32_32x32x16_bf16(s2_ == 0 ? p20 : p21, v1, O2b, 0, 0, 0);
        }
#pragma unroll
        for (int i = 0; i < 2; ++i) { kc[i][0] = kn[i][0]; kc[i][1] = kn[i][1]; }
#pragma unroll
        for (int i = 0; i < 4; ++i) vc[i] = vn[i];
        LDS_WAIT(); asm volatile("" ::: "memory");
    }
#undef LOADK
#undef LOADV
    l1 += bperm_xor32(l1, lane); l2 += bperm_xor32(l2, lane);
    const int srow0 = si.b * 1024 + q0;
    float* PO = (float*)(a.ws + WS_PF + ATT_PO); float* ML = (float*)(a.ws + WS_PF + ATT_ML);
    if (hh == 0) { float* p = ML + (size_t)(((srow0 + r32) * 4 + h) * 2 + kh) * 4; p[0] = m1; p[1] = l1; p[2] = m2; p[3] = l2; }
#pragma unroll
    for (int rg = 0; rg < 16; ++rg) {
        const int qi = (rg & 3) + 8 * (rg >> 2) + 4 * hh;
        float* p = PO + (size_t)((((srow0 + qi) * 4 + h) * 2 + kh) * 2) * 64 + r32;
        p[0] = O1a[rg]; p[32] = O1b[rg]; p[64] = O2a[rg]; p[96] = O2b[rg];
    }
}
__device__ __forceinline__ float attn_lambda(const KArgs& a, int l) {
    const float lam_init = 0.8f - 0.6f * expf(-0.3f * (float)l);
    const float* lv = a.in[I_DLAM] + (size_t)l * 128; float s01 = 0.f, s23 = 0.f;
    for (int i = 0; i < 32; ++i) { s01 += lv[i] * lv[32 + i]; s23 += lv[64 + i] * lv[96 + i]; }
    return expf(s01) - expf(s23) + lam_init;
}
__device__ __forceinline__ void attn_merge(const KArgs& a, int l, int it, int lane, float lam) {
    const int srow = it >> 2, h = it & 3;
    const float* PO = (const float*)(a.ws + WS_PF + ATT_PO) + (size_t)((srow * 4 + h) * 2) * 2 * 64; const float* ML = (const float*)(a.ws + WS_PF + ATT_ML) + (size_t)((srow * 4 + h) * 2) * 4;
    const float lam_init = 0.8f - 0.6f * expf(-0.3f * (float)l);
    const float m1a = ML[0], l1a = ML[1], m2a = ML[2], l2a = ML[3], m1b = ML[4], l1b = ML[5], m2b = ML[6], l2b = ML[7];
    const float M1 = fmaxf(m1a, m1b), M2 = fmaxf(m2a, m2b);
    const float w1a = __builtin_amdgcn_exp2f(m1a - M1), w1b = __builtin_amdgcn_exp2f(m1b - M1), w2a = __builtin_amdgcn_exp2f(m2a - M2), w2b = __builtin_amdgcn_exp2f(m2b - M2);
    const float L1 = l1a * w1a + l1b * w1b, L2 = l2a * w2a + l2b * w2b;
    const float o1 = (PO[lane] * w1a + PO[128 + lane] * w1b) / L1, o2 = (PO[64 + lane] * w2a + PO[192 + lane] * w2b) / L2;
    const float o = o1 - lam * o2;
    const float ms = wave_sum(o * o) * (1.0f / 64.0f);
    const float out = o * (1.0f / sqrtf(ms + 1e-6f)) * a.in[I_DFNORM][(size_t)l * 64 + lane] * (1.0f - lam_init);
    bf16* BR = (bf16*)(a.ws + WS_BR) + (size_t)3 * M * 256;
    BR[(size_t)(MP + srow) * 256 + h * 64 + lane] = (bf16)f2bf(out);
}

__device__ __forceinline__ void fin_phase(const KArgs& a, int l, int gw, int lane) {
    const bf16* PB = (const bf16*)(a.ws + WS_PB);
    const bf16* OSC = (const bf16*)(a.ws + WS_OSC);
    bf16* BR = (bf16*)(a.ws + WS_BR);
    const float lam = attn_lambda(a, l);
#pragma unroll
    for (int q = 0; q < 4; ++q) attn_merge(a, l, gw + q * 256 * NWAVES, lane, lam);
    for (int it0 = gw; it0 < 3 * M; it0 += 5 * 256 * NWAVES) {
        v2u wf[5], wb[5], wg[5];
#pragma unroll
        for (int q = 0; q < 5; ++q) {
            const int it = it0 + q * 256 * NWAVES, m = it / M, row = it - m * M;
            wf[q] = *(const v2u*)(OSC + ((size_t)m * M + row) * 256 + lane * 4); wb[q] = *(const v2u*)(OSC + ((size_t)(3 + m) * M + row) * 256 + lane * 4);
            const int gcol = (m == 0 ? C_GAR : (m == 1 ? C_DNG : C_HGG)) + lane * 4;
            wg[q] = *(const v2u*)(PB + (size_t)row * NPB + gcol);
        }
#pragma unroll
        for (int q = 0; q < 5; ++q) {
            const int it = it0 + q * 256 * NWAVES, m = it / M, row = it - m * M;
            const float* nw = (m == 0 ? a.in[I_GNORM] : (m == 1 ? a.in[I_DNORM] : a.in[I_HNORM])) + l * 64 + (lane & 15) * 4;
            float o0 = bflo(wf[q].x) + bflo(wb[q].x), o1 = bfhi(wf[q].x) + bfhi(wb[q].x), o2 = bflo(wf[q].y) + bflo(wb[q].y), o3 = bfhi(wf[q].y) + bfhi(wb[q].y);
            float ss = (o0 * o0 + o1 * o1) + (o2 * o2 + o3 * o3);
            ss += swz_xor<0x041F>(ss); ss += swz_xor<0x081F>(ss); ss += swz_xor<0x101F>(ss); ss += swz_xor<0x201F>(ss);
            const float rs = 1.0f / sqrtf(ss * (1.0f / 64.0f) + 1e-6f);
            const float g0 = bflo(wg[q].x), g1 = bfhi(wg[q].x), g2 = bflo(wg[q].y), g3 = bfhi(wg[q].y);
            v2u w; w.x = pk2(o0 * rs * nw[0] * g0 * fast_sig(g0), o1 * rs * nw[1] * g1 * fast_sig(g1)); w.y = pk2(o2 * rs * nw[2] * g2 * fast_sig(g2), o3 * rs * nw[3] * g3 * fast_sig(g3));
            *(v2u*)(BR + ((size_t)m * M + row) * 256 + lane * 4) = w;
        }
    }
}
__device__ __forceinline__ void prep_phase(const KArgs& a, int l, LAS unsigned char* lds, int gw, int wave, int lane_) {
    LAS unsigned char* smb = lds + wave * SCAN_LDS;
    for (int it = gw; it < 5120; it += 256 * NWAVES) {
#ifdef DBL_PHG
#define REP_PHG for (int rep_ = 0; rep_ < 2; ++rep_)
#else
#define REP_PHG
#endif
#ifdef DBL_PDN
#define REP_PDN for (int rep_ = 0; rep_ < 2; ++rep_)
#else
#define REP_PDN
#endif
#ifdef DBL_PGLA
#define REP_PGLA for (int rep_ = 0; rep_ < 2; ++rep_)
#else
#define REP_PGLA
#endif
        if (it < 1280) { const int g = it; REP_PHG { int lane = hw_lane(); asm volatile("" : "+v"(lane)); prep_glahg<64, true>(a, l, g >> 3, (g >> 1) & 3, g & 1, smb, lane); } }
        else if (it < 3840) { const int g = it - 1280; REP_PDN { int lane = hw_lane(); asm volatile("" : "+v"(lane)); prep_dn(a, l, g >> 3, (g >> 1) & 3, g & 1, smb, lane); } }
        else { const int g = it - 3840; REP_PGLA { int lane = hw_lane(); asm volatile("" : "+v"(lane)); prep_glahg<32, false>(a, l, g >> 3, (g >> 1) & 3, g & 1, smb, lane); } }
    }
}
#define LANE_ int lane = hw_lane(); asm volatile("" : "+v"(lane));
#ifdef DBL_DN
#define CALL_DN(SP, te) { LANE_ chain_dn<SP>(a, l, s, h, dir, te, smb, lane); } { LANE_ chain_dn<SP>(a, l, s, h, dir, te, smb, lane); }
#else
#define CALL_DN(SP, te) { LANE_ chain_dn<SP>(a, l, s, h, dir, te, smb, lane); }
#endif
#ifdef DBL_HG
#define CALL_HG(SP, te) { LANE_ chain_glahg<64, true, SP>(a, l, s, h, dir, te, smb, lane); } { LANE_ chain_glahg<64, true, SP>(a, l, s, h, dir, te, smb, lane); }
#else
#define CALL_HG(SP, te) { LANE_ chain_glahg<64, true, SP>(a, l, s, h, dir, te, smb, lane); }
#endif
#ifdef DBL_GLA
#define CALL_GLA(SP, te) { LANE_ chain_glahg<32, false, SP>(a, l, s, h, dir, te, smb, lane); } { LANE_ chain_glahg<32, false, SP>(a, l, s, h, dir, te, smb, lane); }
#else
#define CALL_GLA(SP, te) { LANE_ chain_glahg<32, false, SP>(a, l, s, h, dir, te, smb, lane); }
#endif
#ifdef DBL_ATT
#define CALL_ATT { int lane = hw_lane(); asm volatile("" : "+v"(lane)); attn_mfma(a, l, s, h, qb, smb, lane); } { int lane = hw_lane(); asm volatile("" : "+v"(lane)); attn_mfma(a, l, s, h, qb, smb, lane); }
#else
#define CALL_ATT { int lane = hw_lane(); asm volatile("" : "+v"(lane)); attn_mfma(a, l, s, h, qb, smb, lane); }
#endif
__device__ __forceinline__ void mix_phase(const KArgs& a, int l, LAS unsigned char* lds, int wave, int lane_) {
    const int ew = wave >> 1;
    if ((wave & 1) == 0) {
        LAS unsigned char* smb = lds + ew * 38912;
        const int bxs = (int)blockIdx.x;
        const int it = ew < 2 ? ew * 256 + bxs : (ew == 2 ? (bxs < 96 ? 100000 : 512 + bxs - 96) : 672 + bxs);
#ifdef DBL_LAT
#define REP_LAT for (int rep_ = 0; rep_ < 2; ++rep_)
#else
#define REP_LAT
#endif
#ifdef DBL_CTX
#define REP_CTX for (int rep_ = 0; rep_ < 2; ++rep_)
#else
#define REP_CTX
#endif
#ifdef DBL_LDN
#define REP_LDN for (int rep2_ = 0; rep2_ < 2; ++rep2_)
#else
#define REP_LDN
#endif
#ifdef DBL_LGLA
#define REP_LGLA for (int rep2_ = 0; rep2_ < 2; ++rep2_)
#else
#define REP_LGLA
#endif
#ifdef DBL_LHG
#define REP_LHG for (int rep2_ = 0; rep2_ < 2; ++rep2_)
#else
#define REP_LHG
#endif
        if (it < 32) { const int r = it >> 1, te = it & 1, s = 32 + r / 8, h = (r % 8) / 2, dir = r & 1; REP_LDN REP_LAT CALL_DN(true, te) }
        else if (it < 96) { const int r = (it - 32) >> 1, te = it & 1, mx = r / 16, q = r % 16, s = 32 + q / 8, h = (q % 8) / 2, dir = q & 1; if (mx == 0) { REP_LGLA REP_LAT CALL_GLA(true, te) } else { REP_LHG REP_LAT CALL_HG(true, te) } }
        else if (it < 352) { const int r = it - 96, s = r / 8, h = (r % 8) / 2, dir = r & 1; REP_CTX CALL_DN(false, 0) }
        else if (it < 864) { const int r = it - 352, mx = r / 256, q = r % 256, s = q / 8, h = (q % 8) / 2, dir = q & 1; if (mx == 0) { REP_CTX CALL_GLA(false, 0) } else { REP_CTX CALL_HG(false, 0) } }
    } else {
        LAS unsigned char* smb = lds + ew * 38912 + 34304;
        for (int it = ew * 256 + (int)blockIdx.x; it < 1536; it += 1024) {
            if (it < 512) { const int r = it >> 1, kh = it & 1, s = 32 + r / 128, h = (r % 128) / 32, qb = r % 32; { int lane = hw_lane(); asm volatile("" : "+v"(lane)); attn_split(a, l, s, h, qb, kh, smb, lane); }
#ifdef DBL_ATL
 { int lane = hw_lane(); asm volatile("" : "+v"(lane)); attn_split(a, l, s, h, qb, kh, smb, lane); }
#endif
 }
            else { const int r = it - 512, s = r / 32, h = (r % 32) / 8, qb = r % 8; CALL_ATT }
        }
    }
}

__global__ void diag_scale(float* out, unsigned mask) {
    const size_t offs[8] = {0, 8388608, O_DK, O_DV, O_SG, O_SD, O_SH, O_END};
    for (int k = 0; k < 7; ++k) if (mask & (1u << k)) {
        for (size_t i = offs[k] + blockIdx.x * (size_t)blockDim.x + threadIdx.x; i < offs[k + 1]; i += (size_t)gridDim.x * blockDim.x) out[i] *= 1.3f;
    }
}


template <int ph>
__device__ __forceinline__ void run_phase(LAS unsigned char* lds, int wv) {
        int tid_ = wv * 64 + hw_lane(); asm volatile("" : "+v"(tid_));
        const int tid = tid_, lane = tid & 63, wave = __builtin_amdgcn_readfirstlane(tid >> 6);
        int bx_ = blockIdx.x; asm volatile("" : "+s"(bx_));
        const int G = gridDim.x, bx = bx_;
        const int vcu = (G % 8 == 0) ? (bx % 8) * (G / 8) + bx / 8 : bx;
        const int gw = vcu * NWAVES + wave;
        const KArgs* ap_ = (const KArgs*)__builtin_amdgcn_kernarg_segment_ptr(); asm volatile("" : "+s"(ap_));
        const KArgs& a = *ap_;
        bf16* Wb = (bf16*)(a.ws + WS_W);
        float* X = a.out + O_Y;
        const float* modf = (const float*)(a.ws + WS_MODF);
        if constexpr (ph == 0) {
#ifndef NO_PRO
 pro_phase(a, 0, lds, gw, wave, lane);
#ifdef DBL_PRO
 __syncthreads(); pro_phase(a, 0, lds, gw, wave, lane);
#endif
#endif
 }
        else if constexpr (ph == NPHASE - 1) { final_phase(a, gw, lane); }
        else {
            constexpr int l = ph < 12 ? 0 : 1, q_ = ph < 12 ? ph - 1 : ph - 11, p = q_ < 3 ? q_ : (q_ < 9 ? q_ + 1 : q_ + 2);
            constexpr int cbc = l * 3 + (p == 1 ? 0 : p == 4 ? 1 : 2) - 1;
            constexpr int cbp = l * 3 + (p == 2 ? 0 : p == 9 ? 1 : 2);
            const float* SSb = (const float*)(a.ws + WS_SSP); const float* BIb = (const float*)(a.ws + WS_BIAS); const float* CSb = (const float*)(a.ws + WS_CSV);
            constexpr bool first = (l == 0);
            if constexpr (p == 0) { norm_phase(a, l, 0, lds, gw, tid, lane, first ? a.in[I_XP] : X, first ? a.in[I_XS] : X + (size_t)MP * D);
#ifdef DBL_NORM
 __syncthreads(); norm_phase(a, l, 0, lds, gw, tid, lane, first ? a.in[I_XP] : X, first ? a.in[I_XS] : X + (size_t)MP * D);
#endif
 }
            else if constexpr (p == 1 || p == 11) {
                constexpr bool fold = !(l == 0 && p == 1);
                pg8::Gemm g{(const pg8::bf16_t*)(a.ws + (p == 1 ? WS_H : WS_BR)), (const pg8::bf16_t*)((char*)Wb + (p == 1 ? W_1A : W_2A)), M, 2 * FF, D};
                pg8::StaticOrder S; S.init(M, 2 * FF, G, bx);
                pg8::EpiSwigluT<fold> E{(pg8::bf16_t*)(a.ws + WS_ACT), FF, SSb + (size_t)(fold ? cbc : 0) * M * 4, BIb + (size_t)(fold ? cbc : 0) * 3 * 8192};

#ifndef NO_G1
pg8::gemm_phase<pg8::EpiSwigluT<fold>, pg8::StaticOrder, PG8_ALIGN, PG8_SP2, 1024>(lds + RING_OFF, g, S, E, wv);
#endif
#ifdef DBL_UP
                __syncthreads(); pg8::gemm_phase<pg8::EpiSwigluT<fold>, pg8::StaticOrder, PG8_ALIGN, PG8_SP2, 1024>(lds + RING_OFF, g, S, E, wv);
#endif
                if constexpr (l == 0) if (bx >= 112) {
                    __syncthreads();
                    bias_items(a, p == 1 ? 0 : BI2, p == 1 ? BI2 : BI5, bx - 112, 144, lds, wave, lane);
#ifdef DBL_BIAS
                    bias_items(a, p == 1 ? 0 : BI2, p == 1 ? BI2 : BI5, bx - 112, 144, lds, wave, lane, WS_OSC - WS_BIAS);
#endif
                }

            }
            else if constexpr (p == 2 || p == 12) {
                pg8::Gemm g{(const pg8::bf16_t*)(a.ws + WS_ACT), (const pg8::bf16_t*)((char*)Wb + (p == 2 ? W_1B : W_2B)), M, D, FF};
                pg8::StaticOrder S; S.init(M, D, G, bx, 5);
                constexpr bool nxt = true, lastr = (l == NL - 1 && p == 12);
                constexpr bool FI_ = first && p == 2;
                typedef pg8::EpiResidT<nxt, true, FI_, lastr> EpiR;
                EpiR E{a.in[I_XP], a.in[I_XS], (pg8::bf16_t*)X, (float*)(a.ws + WS_XF), modf + (size_t)l * 3 * 9216 + (p == 2 ? 2 : 8) * 1024,
                                      CSb + (size_t)(nxt ? cbp + 1 : 0) * 3 * 1024, (pg8::bf16_t*)(a.ws + WS_H), (LAS float*)(lds + LRED_OFF)};

#ifndef NO_G2
pg8::gemm_phase<EpiR, pg8::StaticOrder, PG8_ALIGN, PG8_SP2>(lds + RING_OFF, g, S, E, wv);
#endif
#ifdef DBL_DOWN0
                if constexpr (l == 0 && p == 2) { __syncthreads(); pg8::gemm_phase<EpiR, pg8::StaticOrder, PG8_ALIGN, PG8_SP2>(lds + RING_OFF, g, S, E, wv); }
#endif
                if constexpr (nxt) { __syncthreads();
                    pg8::Unit u_; if (S.next(0, u_) && tid < 256) { const LAS float* lr = (const LAS float*)(lds + LRED_OFF) + tid; float s_ = 0.f;
#pragma unroll
                        for (int q = 0; q < 8; ++q) s_ += lr[q * 256];
                        ((float*)SSb)[((size_t)cbp * M + u_.pm * 256 + tid) * 4 + u_.pn] = s_; } }
                if (bx >= 160) {
                    if constexpr (p == 2) conv_items(a, l, CI1, CI5, (bx - 160) * NWAVES + wave, 96 * NWAVES, lds, wave, lane);
                    if constexpr (p == 2 && l == 0) mod_items(a, 288, 576, (bx - 160) * NWAVES + wave, 96 * NWAVES, lds, wave, lane);
#ifdef DBL_SIDE
                    if constexpr (p == 2) conv_items(a, l, CI1, CI5, (bx - 160) * NWAVES + wave, 96 * NWAVES, lds, wave, lane);
#endif
                    else if constexpr (l == 0) { conv_items(a, 1, 0, CI1, (bx - 160) * NWAVES + wave, 96 * NWAVES, lds, wave, lane); conv_cache(a, 1, (bx - 160) * NWAVES + wave, 96 * NWAVES, lane); }
                }

            }
            else if constexpr (p == 4) {
                pg8::Gemm g{(const pg8::bf16_t*)(a.ws + WS_H), (const pg8::bf16_t*)((char*)Wb + W_IN), M, 8192, D};
                pg8::StaticOrder S; S.init(M, 8192, G, bx);
                pg8::EpiInproj E{(pg8::bf16_t*)(a.ws + WS_PB), (float*)(a.ws + WS_PF), (pg8::bf16_t*)(a.ws + WS_GATE), a.out + O_DK, a.out + O_DV, l, (const float*)(a.ws + WS_ROPE), SSb + (size_t)cbc * M * 4, BIb + (size_t)cbc * 3 * 8192};

#ifndef NO_G3
pg8::gemm_phase<pg8::EpiInproj, pg8::StaticOrder, PG8_ALIGN, PG8_SP2, 1024>(lds + RING_OFF, g, S, E, wv);
#endif
#ifdef DBL_INPROJ
                __syncthreads(); pg8::gemm_phase<pg8::EpiInproj, pg8::StaticOrder, PG8_ALIGN, PG8_SP2, 1024>(lds + RING_OFF, g, S, E, wv);
#endif

            }
            else if constexpr (p == 5) { prep_phase(a, l, lds, gw, wave, lane);
#ifdef DBL_PREP
                __syncthreads(); prep_phase(a, l, lds, gw, wave, lane);
#endif
            }
            else if constexpr (p == 6) { mix_phase(a, l, lds, wave, lane);
#ifdef DBL_MIX
                __syncthreads(); mix_phase(a, l, lds, wave, lane);
#endif
            }
            else if constexpr (p == 7) { fin_phase(a, l, gw, lane);
#ifdef DBL_NORM
 fin_phase(a, l, gw, lane);
#endif
 }
            else if constexpr (p == 8) {
                pg8::Gemm g{(const pg8::bf16_t*)(a.ws + WS_BR), (const pg8::bf16_t*)((char*)Wb + W_BR), 4 * M, 4096, 256};
                pg8::MergeOrder S{vcu};
                pg8::EpiMerge E{(const pg8::bf16_t*)(a.ws + WS_GATE), (pg8::bf16_t*)(a.ws + WS_PART), (pg8::bf16_t*)(a.ws + WS_H)};

#ifndef NO_G4
pg8::gemm_phase<pg8::EpiMerge, pg8::MergeOrder, PG8_ALIGN, PG8_SP2, 256>(lds + RING_OFF, g, S, E, wv);
#endif
#ifdef DBL_MERGE
                __syncthreads(); pg8::gemm_phase<pg8::EpiMerge, pg8::MergeOrder, PG8_ALIGN, PG8_SP2, 256>(lds + RING_OFF, g, S, E, wv);
#endif
                if (vcu >= 160) conv_items(a, l, CI5, CI6, (vcu - 160) * NWAVES + wave, 96 * NWAVES, lds, wave, lane);
                if constexpr (l == 0) { if (vcu >= 160) mod_consolidate(a, 1, (vcu - 160) * NWAVES + wave, 96 * NWAVES, lane); }
#ifdef DBL_SIDE2
                if (vcu >= 160) conv_items(a, l, CI5, CI6, (vcu - 160) * NWAVES + wave, 96 * NWAVES, lds, wave, lane);
#endif

            }
            else if constexpr (p == 9) {
                pg8::Gemm g{(const pg8::bf16_t*)(a.ws + WS_H), (const pg8::bf16_t*)((char*)Wb + W_WO), M, D, D};
                pg8::StaticOrder S; S.init(M, D, G, bx, 5);
                pg8::EpiResidT<true, false, false, false> E{a.in[I_XP], a.in[I_XS], (pg8::bf16_t*)X, (float*)(a.ws + WS_XF), modf + (size_t)l * 3 * 9216 + 5 * 1024,
                                       CSb + (size_t)(cbp + 1) * 3 * 1024, (pg8::bf16_t*)(a.ws + WS_BR), (LAS float*)(lds + LRED_OFF)};

#ifndef NO_G2
pg8::gemm_phase<pg8::EpiResidT<true, false, false, false>, pg8::StaticOrder, PG8_ALIGN, PG8_SP2>(lds + RING_OFF, g, S, E, wv);
#endif
                if constexpr (true) { __syncthreads();
                    pg8::Unit u_; if (S.next(0, u_) && tid < 256) { const LAS float* lr = (const LAS float*)(lds + LRED_OFF) + tid; float s_ = 0.f;
#pragma unroll
                        for (int q = 0; q < 8; ++q) s_ += lr[q * 256];
                        ((float*)SSb)[((size_t)cbp * M + u_.pm * 256 + tid) * 4 + u_.pn] = s_; } }
                if (bx >= 160) conv_items(a, l, CI6, CI7, (bx - 160) * NWAVES + wave, 96 * NWAVES, lds, wave, lane);

            }
        }
}
#if MK_ONE_LAUNCH
#define SEAM() do { const KArgs* sp_ = (const KArgs*)__builtin_amdgcn_kernarg_segment_ptr(); asm volatile("" : "+s"(sp_)); \
    XcdBarrier b2; b2.bar = (unsigned*)((gu32*)(sp_->ws + WS_CTL) + CW_BAR); b2.x = xb_xcc_id(); b2.st = (volatile LAS unsigned*)(lds + MISC_OFF) + 8; xcd_barrier(b2, wv == 0 && hw_lane() == 0); } while (0)
#endif
__global__ void __launch_bounds__(NWAVES * 64, 2) hyb_fwd(Args args) {
    extern __shared__ __attribute__((aligned(16))) unsigned char lds_raw[];
    LAS unsigned char* lds = (LAS unsigned char*)lds_raw;
    volatile LAS unsigned* MISC = (volatile LAS unsigned*)(lds + MISC_OFF);
    gu32* ctl = (gu32*)(args.ws + WS_CTL);
    const int wv = __builtin_amdgcn_readfirstlane((int)threadIdx.x >> 6);
    for (int u = threadIdx.x; u < (LDS_BYTES - LDSCTL_OFF) / 4; u += NWAVES * 64) ((LAS unsigned*)(lds + LDSCTL_OFF))[u] = 0u;
    __syncthreads();
#if MK_ONE_LAUNCH
    (void)xcd_barrier_post((unsigned*)(ctl + CW_BAR), MISC + 8);
#endif
#if MK_ONE_LAUNCH
#ifdef DBL_BAR
#define RP(n) run_phase<n>(lds, wv); SEAM(); SEAM();
#else
#define RP(n) run_phase<n>(lds, wv); SEAM();
#endif
    RP(0) RP(1) RP(2) RP(3) RP(4) RP(5) RP(6) RP(7) RP(8) RP(9) RP(10) RP(11) RP(12) RP(13) RP(14) RP(15) RP(16) RP(17) RP(18) RP(19) RP(20) RP(21)
    run_phase<22>(lds, wv);
#undef RP
#else
    switch (args.ph_lo) {
#define RP(n) case n: run_phase<n>(lds, wv); break;
    RP(0) RP(1) RP(2) RP(3) RP(4) RP(5) RP(6) RP(7) RP(8) RP(9) RP(10) RP(11) RP(12) RP(13) RP(14) RP(15) RP(16) RP(17) RP(18) RP(19) RP(20) RP(21) RP(22)
#undef RP
    default: break;
    }
#endif
}

extern "C" void kernel_launch(void* const* d_in, const int* in_sizes, int n_in, void* d_out, int out_size, void* d_ws, size_t ws_size, hipStream_t stream) {
    static int grid = 0;
    if (grid == 0) {
        if (n_in != 32 || (size_t)out_size != O_END || ws_size < WS_END) { fprintf(stderr, "kernel_launch: unexpected problem (n_in %d, out %d, ws %zu); nothing launched\n", n_in, out_size, ws_size); grid = -1; return; }
        int dev = 0, cus = 0, per_cu = 0;
        if (hipGetDevice(&dev) != hipSuccess || hipDeviceGetAttribute(&cus, hipDeviceAttributeMultiprocessorCount, dev) != hipSuccess) { grid = -1; return; }
        if (hipFuncSetAttribute((const void*)hyb_fwd, hipFuncAttributeMaxDynamicSharedMemorySize, LDS_BYTES) != hipSuccess) { fprintf(stderr, "kernel_launch: hipFuncSetAttribute failed\n"); grid = -1; return; }
        if (hipOccupancyMaxActiveBlocksPerMultiprocessor(&per_cu, (const void*)hyb_fwd, NWAVES * 64, LDS_BYTES) != hipSuccess || per_cu < 1)
            fprintf(stderr, "kernel_launch: note: occupancy query reports %d workgroups per CU\n", per_cu);
        (void)hipGetLastError();
        grid = cus;
        if (grid != 256) { fprintf(stderr, "kernel_launch: built for a 256-CU device, found %d CUs; nothing launched\n", grid); grid = -1; return; }
    }
    if (grid < 0) return;
    if (hipMemsetAsync((char*)d_ws + WS_CTL, 0, CTL_ZERO_BYTES, stream) != hipSuccess) return;
    Args a{};
    for (int i = 0; i < 32; ++i) a.in[i] = (const float*)d_in[i];
    a.out = (float*)d_out; a.ws = (unsigned char*)d_ws;
#if MK_ONE_LAUNCH
    a.ph_lo = 0; a.ph_hi = NPHASE;
    hipLaunchKernelGGL(hyb_fwd, dim3(grid), dim3(NWAVES * 64), LDS_BYTES, stream, a);
#else
    for (int p = 0; p < NPHASE; ++p) { a.ph_lo = p; a.ph_hi = p + 1; hipLaunchKernelGGL(hyb_fwd, dim3(grid), dim3(NWAVES * 64), LDS_BYTES, stream, a); }
#endif
#ifdef DIAG_MASK
    diag_scale<<<1024, 256, 0, stream>>>((float*)d_out, DIAG_MASK);
#endif
}
```

```cpp
#include <hip/hip_runtime.h>
#include <cstdio>
#include <cstdint>
#include <cmath>
namespace pg8 {
#define PG8_LAS __attribute__((address_space(3)))
typedef unsigned short bf16_t;
typedef short bf16x8 __attribute__((ext_vector_type(8)));
typedef float f32x4 __attribute__((ext_vector_type(4)));
typedef unsigned u32x4 __attribute__((ext_vector_type(4)));
constexpr int BM = 256, BK = 64, HALF = 128, HTB = HALF * BK * 2  , STAGE_BYTES = 8 * HTB, NXCD = 8, WGM = 8;

__host__ __device__ __forceinline__ int lds_byte(int r, int c) { const int st = (r >> 4) * 2 + (c >> 5), rr = r & 15, cc = c & 31, ob = rr * 64 + cc * 2; return st * 1024 + (ob ^ (((ob >> 9) & 1) << 5)); }
__host__ __device__ __forceinline__ void stage_rc(int b, int& R, int& C) { const int st = b / 1024, sb = b % 1024, swz = sb ^ (((sb >> 9) & 1) << 5); R = (st >> 1) * 16 + swz / 64; C = (st & 1) * 32 + (swz % 64) / 2; }
__host__ __device__ __forceinline__ int perm32(int rho) { const int n = rho >> 4, i = rho & 15; return 8 * (i >> 2) + 4 * n + (i & 3); }

__device__ __forceinline__ int pg8_hw_lane() { int r; asm volatile("v_mbcnt_lo_u32_b32 %0, -1, 0\n\tv_mbcnt_hi_u32_b32 %0, -1, %0" : "=v"(r)); return r; }
struct Unit { int pm, pn; };
struct Gemm { const bf16_t* A; const bf16_t* Bt; int M, N, K; };

struct StaticOrder {
    int nM, nN, nwg, G, c, wgm;
    __host__ __device__ void init(int M, int N, int G_, int c_, int wgm_ = WGM) { nM = M / BM; nN = N / BM; nwg = nM * nN; G = G_; c = c_; wgm = wgm_; }
    __host__ __device__ bool next(int i, Unit& u) const {
        const long L = (long)i * G + c; if (L >= nwg) return false;
        int wgid = (int)L; { const int q = nwg / NXCD, r = nwg % NXCD, xcd = wgid % NXCD, off = wgid / NXCD; wgid = (xcd < r ? xcd * (q + 1) : r * (q + 1) + (xcd - r) * q) + off; }
        const int nig = wgm * nN, gid = wgid / nig, fm = gid * wgm, gsz = (nM - fm) < wgm ? (nM - fm) : wgm;
        u.pm = fm + ((wgid % nig) % gsz); u.pn = (wgid % nig) / gsz; return true;
    }
    __device__ __forceinline__ void a_ready(const Unit&) const {}
    __device__ __forceinline__ void done(const Unit&) const {}
};


typedef unsigned u32x2 __attribute__((ext_vector_type(2)));
typedef float f32x2e_t __attribute__((ext_vector_type(2))); typedef __bf16 bf16x2e_t __attribute__((ext_vector_type(2)));
__device__ __forceinline__ unsigned pk_bf16(float lo, float hi) { f32x2e_t v = {lo, hi}; bf16x2e_t b = __builtin_convertvector(v, bf16x2e_t); return __builtin_bit_cast(unsigned, b); }
__device__ __forceinline__ float bf_lo(unsigned w) { return __builtin_bit_cast(float, w << 16); }
__device__ __forceinline__ float bf_hi(unsigned w) { return __builtin_bit_cast(float, w & 0xffff0000u); }
__device__ __forceinline__ float swz16(float x) { return __builtin_bit_cast(float, __builtin_amdgcn_ds_swizzle(__builtin_bit_cast(int, x), 0x401F)); }
__device__ __forceinline__ float fast_sigmoid(float x) { return __builtin_amdgcn_rcpf(1.0f + __expf(-x)); }

template <bool FOLD>
struct EpiSwigluT {
    static constexpr bool PERM = true, AFTER_DRAIN = false;
    bf16_t* O; int ldo; const float* ss; const float* bias;
    __device__ __forceinline__ void operator()(const f32x4 (&acc)[2][2][4][2], const Unit& u, int wr, int wc, int fr, int fq) const {
        const int row0 = u.pm * BM + wr * 64 + fr, col0 = u.pn * HALF + wc * 32 + 8 * fq;
        float rs[2][4] = {{1.f, 1.f, 1.f, 1.f}, {1.f, 1.f, 1.f, 1.f}};
        f32x4 bg[2] = {{0.f, 0.f, 0.f, 0.f}, {0.f, 0.f, 0.f, 0.f}}, bu[2] = {{0.f, 0.f, 0.f, 0.f}, {0.f, 0.f, 0.f, 0.f}};
        if constexpr (FOLD) {
            const int grp = u.pm < 32 ? 0 : 1 + ((u.pm - 32) >> 2);
            const float* bp = bias + grp * 8192 + u.pn * BM + wc * 32 + 8 * fq;
            bg[0] = *(const f32x4*)bp; bg[1] = *(const f32x4*)(bp + 4); bu[0] = *(const f32x4*)(bp + HALF); bu[1] = *(const f32x4*)(bp + HALF + 4);
#pragma unroll
            for (int ai = 0; ai < 2; ++ai)
#pragma unroll
                for (int m = 0; m < 4; ++m) { const f32x4 q = *(const f32x4*)(ss + (size_t)(row0 + ai * HALF + m * 16) * 4); rs[ai][m] = (q.x + q.y) + (q.z + q.w); }
#pragma unroll
            for (int ai = 0; ai < 2; ++ai)
#pragma unroll
                for (int m = 0; m < 4; ++m) rs[ai][m] = __builtin_amdgcn_rsqf(rs[ai][m] * (1.0f / 1024.0f) + 1e-6f);
        }
#pragma unroll
        for (int ai = 0; ai < 2; ++ai)
#pragma unroll
            for (int m = 0; m < 4; ++m) {
                int row = row0 + ai * HALF + m * 16; asm volatile("" : "+v"(row));
                bf16_t* rowp = O + (size_t)row * ldo + col0;
                float v[8];
#pragma unroll
                for (int n = 0; n < 2; ++n)
#pragma unroll
                    for (int j = 0; j < 4; ++j) { const float g = acc[ai][0][m][n][j] * rs[ai][m] + bg[n][j], up = acc[ai][1][m][n][j] * rs[ai][m] + bu[n][j]; v[n * 4 + j] = g * fast_sigmoid(g) * up; }
                u32x4 w; w.x = pk_bf16(v[0], v[1]); w.y = pk_bf16(v[2], v[3]); w.z = pk_bf16(v[4], v[5]); w.w = pk_bf16(v[6], v[7]);
                *(u32x4*)rowp = w;
            }
    }
};

template <bool NEXT, bool HALFMUL, bool FROMIN, bool NOX>
struct EpiResidT {
    static constexpr bool PERM = true, AFTER_DRAIN = false;
    const float* baseP; const float* baseS; bf16_t* xb; float* outf; const float* scale;
    const float* csn; bf16_t* Hn; PG8_LAS float* lred;
    __device__ __forceinline__ void operator()(const f32x4 (&acc)[2][2][4][2], const Unit& u, int wr, int wc, int fr, int fq) const {
        const int grp = u.pm < 32 ? 0 : 1 + ((u.pm - 32) >> 2);
        const float* sc = scale + grp * 9216;
        const float* base = u.pm < 32 ? baseP : baseS - (size_t)8192 * 1024;
        const int row0 = u.pm * BM + wr * 64 + fr, col0 = u.pn * BM + wc * 32 + 8 * fq;
        float rsq[2][4] = {{0.f, 0.f, 0.f, 0.f}, {0.f, 0.f, 0.f, 0.f}};
#pragma unroll
        for (int bj = 0; bj < 2; ++bj) {
            const int col = col0 + bj * HALF;
            u32x4 bh[2][4];
            if constexpr (!FROMIN) {
#pragma unroll
                for (int ai = 0; ai < 2; ++ai)
#pragma unroll
                    for (int m = 0; m < 4; ++m) { int row = row0 + ai * HALF + m * 16; asm volatile("" : "+v"(row)); bh[ai][m] = *(const u32x4*)(xb + (size_t)row * 1024 + col); }
            }
            const f32x4 s0 = *(const f32x4*)(sc + col) * (HALFMUL ? 0.5f : 1.0f), s1 = *(const f32x4*)(sc + col + 4) * (HALFMUL ? 0.5f : 1.0f);
            f32x4 c0 = {0.f, 0.f, 0.f, 0.f}, c1 = c0;
            if constexpr (NEXT) { c0 = *(const f32x4*)(csn + grp * 1024 + col); c1 = *(const f32x4*)(csn + grp * 1024 + col + 4); }
#pragma unroll
            for (int ai = 0; ai < 2; ++ai) {
                f32x4 b0[4], b1[4];
                if constexpr (FROMIN) {
#pragma unroll
                    for (int m = 0; m < 4; ++m) { int row = row0 + ai * HALF + m * 16; asm volatile("" : "+v"(row)); const float* p = base + (size_t)row * 1024 + col; b0[m] = *(const f32x4*)p; b1[m] = *(const f32x4*)(p + 4); }
                }
#pragma unroll
                for (int m = 0; m < 4; ++m) {
                    int row = row0 + ai * HALF + m * 16; asm volatile("" : "+v"(row));
                    const size_t off = (size_t)row * 1024 + col;
                    if constexpr (!FROMIN) {
                        const u32x4 w = bh[ai][m];
                        b0[m].x = bf_lo(w.x); b0[m].y = bf_hi(w.x); b0[m].z = bf_lo(w.y); b0[m].w = bf_hi(w.y); b1[m].x = bf_lo(w.z); b1[m].y = bf_hi(w.z); b1[m].z = bf_lo(w.w); b1[m].w = bf_hi(w.w);
                    }
                    const f32x4 o0 = b0[m] + s0 * acc[ai][bj][m][0], o1 = b1[m] + s1 * acc[ai][bj][m][1];
                    if constexpr (!NOX) { u32x4 xw; xw.x = pk_bf16(o0.x, o0.y); xw.y = pk_bf16(o0.z, o0.w); xw.z = pk_bf16(o1.x, o1.y); xw.w = pk_bf16(o1.z, o1.w); *(u32x4*)(xb + off) = xw; }
                    if constexpr (NEXT) {
                        rsq[ai][m] += ((o0.x * o0.x + o0.y * o0.y) + (o0.z * o0.z + o0.w * o0.w)) + ((o1.x * o1.x + o1.y * o1.y) + (o1.z * o1.z + o1.w * o1.w));
                        const f32x4 t0 = o0 * c0, t1 = o1 * c1; u32x4 w; w.x = pk_bf16(t0.x, t0.y); w.y = pk_bf16(t0.z, t0.w); w.z = pk_bf16(t1.x, t1.y); w.w = pk_bf16(t1.z, t1.w);
                        *(u32x4*)(Hn + off) = w;
                    }
                }
                if constexpr (FROMIN) asm volatile("" ::: "memory");
            }
            asm volatile("" ::: "memory");
        }
        if constexpr (NEXT) {
#pragma unroll
            for (int ai = 0; ai < 2; ++ai)
#pragma unroll
                for (int m = 0; m < 4; ++m) {
                    const float s = rsq[ai][m] + swz16(rsq[ai][m]);
                    if (!(fq & 1)) lred[(wc * 2 + (fq >> 1)) * 256 + wr * 64 + ai * HALF + m * 16 + fr] = s;
                }
        }
    }
};

struct EpiInproj {
    static constexpr bool PERM = true, AFTER_DRAIN = false;
    bf16_t* PB; float* PF; bf16_t* G; float* dk; float* dv; int layer; const float* rope; const float* ss; const float* bias;
    __device__ __forceinline__ void operator()(const f32x4 (&acc)[2][2][4][2], const Unit& u, int wr, int wc, int fr, int fq) const {
        const int row0 = u.pm * BM + wr * 64 + fr;
        const int grp = u.pm < 32 ? 0 : 1 + ((u.pm - 32) >> 2);
        const float* bp = bias + grp * 8192 + u.pn * BM + wc * 32 + 8 * fq;
        const f32x4 bb[2][2] = {{*(const f32x4*)bp, *(const f32x4*)(bp + 4)}, {*(const f32x4*)(bp + HALF), *(const f32x4*)(bp + HALF + 4)}};
        float rsv[2][4];
#pragma unroll
        for (int ai = 0; ai < 2; ++ai)
#pragma unroll
            for (int m = 0; m < 4; ++m) { const f32x4 q = *(const f32x4*)(ss + (size_t)(row0 + ai * HALF + m * 16) * 4); rsv[ai][m] = (q.x + q.y) + (q.z + q.w); }
#pragma unroll
        for (int ai = 0; ai < 2; ++ai)
#pragma unroll
            for (int m = 0; m < 4; ++m) rsv[ai][m] = __builtin_amdgcn_rsqf(rsv[ai][m] * (1.0f / 1024.0f) + 1e-6f);
        if (u.pn < 13) {
            const int col0 = u.pn * BM + wc * 32 + 8 * fq;
#pragma unroll
            for (int ai = 0; ai < 2; ++ai)
#pragma unroll
                for (int m = 0; m < 4; ++m) {
                    int row = row0 + ai * HALF + m * 16; asm volatile("" : "+v"(row));
                    const float rs = rsv[ai][m];
#pragma unroll
                    for (int bj = 0; bj < 2; ++bj) {
                        f32x4 v0 = acc[ai][bj][m][0] * rs + bb[bj][0], v1 = acc[ai][bj][m][1] * rs + bb[bj][1];
#ifndef PROBE_NO_EPI_ROPE
                        if ((u.pn == 10 || u.pn == 11) && u.pm >= 32) {
                            const int t = row & 1023;
                            const float* cp = rope + t * 32 + 8 * fq; const float* sp = cp + 1024 * 32;
                            const f32x4 c0 = *(const f32x4*)cp, c1 = *(const f32x4*)(cp + 4), s0 = *(const f32x4*)sp, s1 = *(const f32x4*)(sp + 4);
                            f32x4 p0, p1;
#pragma unroll
                            for (int j = 0; j < 4; ++j) { const float a_ = v0[j], b_ = v1[j]; p0[j] = swz16(a_); p1[j] = swz16(b_); }
                            const float sg = (fq & 1) ? 1.0f : -1.0f;
                            v0 = v0 * c0 + p0 * s0 * sg; v1 = v1 * c1 + p1 * s1 * sg;
                        }
#endif
                        u32x4 w; w.x = pk_bf16(v0[0], v0[1]); w.y = pk_bf16(v0[2], v0[3]); w.z = pk_bf16(v1[0], v1[1]); w.w = pk_bf16(v1[2], v1[3]);
                        *(u32x4*)(PB + (size_t)row * 3328 + col0 + bj * HALF) = w;
                        if (u.pn >= 11 && u.pm < 32) {
                            float* o = (u.pn == 11) ? dk : dv;
                            const int hd = bj * 2 + (wc >> 1), d = (wc & 1) * 32 + 8 * fq, b = row >> 8, t = row & 255;
                            float* p = o + ((size_t)(((b * 2 + layer) * 4 + hd) * 256 + t)) * 64 + d;
                            __builtin_nontemporal_store(v0, (f32x4*)p); __builtin_nontemporal_store(v1, (f32x4*)(p + 4));
                        }
                    }
                }
        } else if (u.pn < 16) {
            const int col0 = (u.pn - 13) * BM + wc * 32 + 8 * fq;
#pragma unroll
            for (int ai = 0; ai < 2; ++ai)
#pragma unroll
                for (int m = 0; m < 4; ++m) {
                    int row = row0 + ai * HALF + m * 16; asm volatile("" : "+v"(row));
                    const float rs = rsv[ai][m];
#pragma unroll
                    for (int bj = 0; bj < 2; ++bj) {
                        const int col = col0 + bj * HALF;
                        if (col < 576) { float* p = PF + (size_t)row * 576 + col; *(f32x4*)p = acc[ai][bj][m][0] * rs + bb[bj][0]; *(f32x4*)(p + 4) = acc[ai][bj][m][1] * rs + bb[bj][1]; }
                    }
                }
        } else {
            const int col0 = (u.pn - 16) * BM + wc * 32 + 8 * fq;
#pragma unroll
            for (int ai = 0; ai < 2; ++ai)
#pragma unroll
                for (int m = 0; m < 4; ++m) {
                    int row = row0 + ai * HALF + m * 16; asm volatile("" : "+v"(row));
                    const float rs = rsv[ai][m];
#pragma unroll
                    for (int bj = 0; bj < 2; ++bj) {
                        float v[8];
                        const f32x4 b0 = bb[bj][0], b1 = bb[bj][1];
#pragma unroll
                        for (int j = 0; j < 4; ++j) { v[j] = fast_sigmoid(acc[ai][bj][m][0][j] * rs + b0[j]); v[4 + j] = fast_sigmoid(acc[ai][bj][m][1][j] * rs + b1[j]); }
                        u32x4 w; w.x = pk_bf16(v[0], v[1]); w.y = pk_bf16(v[2], v[3]); w.z = pk_bf16(v[4], v[5]); w.w = pk_bf16(v[6], v[7]);
                        *(u32x4*)(G + (size_t)row * 4096 + col0 + bj * HALF) = w;
                    }
                }
        }
    }
};

struct EpiMerge {
    static constexpr bool PERM = true, AFTER_DRAIN = false;
    const bf16_t* G; bf16_t* P; bf16_t* MG;
    __device__ __forceinline__ void operator()(const f32x4 (&acc)[2][2][4][2], const Unit& u, int wr, int wc, int fr, int fq) const {
        const int n = u.pm / 40, pm = u.pm - n * 40, pn = u.pn & 3;
        const int row0 = pm * BM + wr * 64 + fr, col0 = pn * BM + wc * 32 + 8 * fq;
        bf16_t* dst = (n < 3) ? P : MG;
#pragma unroll
        for (int ai = 0; ai < 2; ++ai)
#pragma unroll
          for (int mh = 0; mh < 2; ++mh) {
            u32x4 gw[2][2], pw[2][2];
#pragma unroll
            for (int ml = 0; ml < 2; ++ml) {
                int row = row0 + ai * HALF + (mh * 2 + ml) * 16; asm volatile("" : "+v"(row));
#pragma unroll
                for (int bj = 0; bj < 2; ++bj) {
                    const int col = col0 + bj * HALF;
                    gw[ml][bj] = *(const u32x4*)(G + (size_t)row * 4096 + n * 1024 + col);
                    if (n > 0) pw[ml][bj] = *(const u32x4*)(P + (size_t)row * 1024 + col);
                }
            }
#pragma unroll
            for (int ml = 0; ml < 2; ++ml) {
                const int m = mh * 2 + ml;
                int row = row0 + ai * HALF + m * 16; asm volatile("" : "+v"(row));
#pragma unroll
                for (int bj = 0; bj < 2; ++bj) {
                    const int col = col0 + bj * HALF;
                    const u32x4 g4 = gw[ml][bj];
                    f32x4 v0 = acc[ai][bj][m][0], v1 = acc[ai][bj][m][1];
                    v0[0] *= bf_lo(g4.x); v0[1] *= bf_hi(g4.x); v0[2] *= bf_lo(g4.y); v0[3] *= bf_hi(g4.y);
                    v1[0] *= bf_lo(g4.z); v1[1] *= bf_hi(g4.z); v1[2] *= bf_lo(g4.w); v1[3] *= bf_hi(g4.w);
                    if (n > 0) { const u32x4 p4 = pw[ml][bj];
                        v0[0] += bf_lo(p4.x); v0[1] += bf_hi(p4.x); v0[2] += bf_lo(p4.y); v0[3] += bf_hi(p4.y); v1[0] += bf_lo(p4.z); v1[1] += bf_hi(p4.z); v1[2] += bf_lo(p4.w); v1[3] += bf_hi(p4.w); }
                    u32x4 w; w.x = pk_bf16(v0[0], v0[1]); w.y = pk_bf16(v0[2], v0[3]); w.z = pk_bf16(v1[0], v1[1]); w.w = pk_bf16(v1[2], v1[3]);
                    *(u32x4*)(dst + (size_t)row * 1024 + col) = w;
                }
            }
            asm volatile("" ::: "memory");
        }
    }
};
struct MergeOrder {
    int c;
    __device__ __forceinline__ bool next(int i, Unit& u) const { if (c >= 160 || i >= 4) return false; u.pm = i * 40 + (c >> 2); u.pn = i * 4 + (c & 3); return true; }
    __device__ __forceinline__ void a_ready(const Unit&) const {}
    __device__ __forceinline__ void done(const Unit&) const {}
};

template <class Epi, class Sched, bool ALIGN_EPI = false, bool SP2 = false, int KC = 0>
__device__ __forceinline__ void gemm_phase(PG8_LAS unsigned char* lds, const Gemm g, const Sched& S, const Epi& E, int wv  ) {
    int tid_ = wv * 64 + pg8_hw_lane(); asm volatile("" : "+v"(tid_));
    const int tid = tid_, wid = __builtin_amdgcn_readfirstlane(tid >> 6), lane = tid & 63, wr = wid >> 2, wc = wid & 3, fr = lane & 15, fq = lane >> 4;
    const int K = KC > 0 ? KC : g.K, nt = K / BK;
    unsigned voffA[2], voffB[2];
#pragma unroll
    for (int i = 0; i < 2; ++i) { int R, C; stage_rc(tid * 16 + i * 8192, R, C); const int Rb = Epi::PERM ? ((R & ~31) + perm32(R & 31)) : R;
        voffA[i] = (unsigned)(R * K + C) * 2u; voffB[i] = (unsigned)(Rb * K + C) * 2u; }
    const size_t kstep = (size_t)(BK * 2);
    const size_t hstep = (size_t)HALF * K * 2;
    const size_t tstep = 2 * hstep;
    const unsigned ldsw = (unsigned)wid * 1024u;
    const int aoff = lds_byte(wr * 64 + fr, fq * 8), boff = lds_byte(wc * 32 + fr, fq * 8);
#define PG8_SA(b, h) (((b) * 2 + (h)) * HTB)
#define PG8_SB(b, h) ((4 + (b) * 2 + (h)) * HTB)
#define PG8_STAGE(bufoff, gbase, voff) do { _Pragma("unroll") for (int _i = 0; _i < 2; ++_i) { unsigned _vo = (voff)[_i]; asm volatile("" : "+v"(_vo));     \
        __builtin_amdgcn_global_load_lds((const unsigned*)((const char*)(gbase) + _vo), (PG8_LAS unsigned*)(lds + (bufoff) + ldsw + _i * 8192), 16, 0, 0); } } while (0)
#define PG8_LDA(dst, b, h) do { _Pragma("unroll") for (int m = 0; m < 4; ++m) _Pragma("unroll") for (int k = 0; k < 2; ++k) dst[m][k] = *(const PG8_LAS bf16x8*)(lds + PG8_SA(b, h) + aoff + m * 2048 + k * 1024); } while (0)
#define PG8_LDB(dst, b, h) do { _Pragma("unroll") for (int n = 0; n < 2; ++n) _Pragma("unroll") for (int k = 0; k < 2; ++k) dst[n][k] = *(const PG8_LAS bf16x8*)(lds + PG8_SB(b, h) + boff + n * 2048 + k * 1024); } while (0)
#define PG8_MMA(ai, bj, At, Bt) do { __builtin_amdgcn_s_setprio(1); _Pragma("unroll") for (int m = 0; m < 4; ++m) _Pragma("unroll") for (int n = 0; n < 2; ++n) _Pragma("unroll") for (int k = 0; k < 2; ++k) \
        acc[ai][bj][m][n] = __builtin_amdgcn_mfma_f32_16x16x32_bf16(Bt[n][k], At[m][k], acc[ai][bj][m][n], 0, 0, 0); __builtin_amdgcn_s_setprio(0); } while (0)
#define PG8_WAIT_V(n) asm volatile("s_waitcnt vmcnt(" #n ")" ::: "memory")
#define PG8_WAIT_L(n) asm volatile("s_waitcnt lgkmcnt(" #n ")" ::: "memory")
#define PG8_BAR __builtin_amdgcn_s_barrier()
#define PG8_SCHED __builtin_amdgcn_sched_barrier(0)
    Unit cur, nxt; int ui = 0;
    if (!S.next(0, cur)) return;
    f32x4 acc[2][2][4][2];
#pragma unroll
    for (int a = 0; a < 2; ++a)
#pragma unroll
        for (int b = 0; b < 2; ++b)
#pragma unroll
            for (int m = 0; m < 4; ++m)
#pragma unroll
                for (int n = 0; n < 2; ++n) acc[a][b][m][n] = (f32x4){0.f, 0.f, 0.f, 0.f};
    bf16x8 At[4][2], B0[2][2], B1[2][2];
    const char* cA = (const char*)g.A + (size_t)cur.pm * tstep; const char* cB = (const char*)g.Bt + (size_t)cur.pn * tstep;
    S.a_ready(cur);
    if constexpr (SP2) {
        PG8_STAGE(PG8_SB(0, 0), cB, voffB); PG8_STAGE(PG8_SB(0, 1), cB + hstep, voffB); PG8_STAGE(PG8_SA(0, 0), cA, voffA); PG8_STAGE(PG8_SA(0, 1), cA + hstep, voffA);
        if (wr == 1) PG8_BAR;
        PG8_WAIT_V(2); PG8_BAR;
        PG8_STAGE(PG8_SB(1, 0), cB + kstep, voffB); PG8_STAGE(PG8_SA(1, 0), cA + kstep, voffA); PG8_STAGE(PG8_SB(1, 1), cB + hstep + kstep, voffB);
        PG8_WAIT_V(6); PG8_BAR;
    } else {
        PG8_STAGE(PG8_SB(0, 0), cB, voffB); PG8_STAGE(PG8_SA(0, 0), cA, voffA); PG8_STAGE(PG8_SB(0, 1), cB + hstep, voffB); PG8_STAGE(PG8_SA(0, 1), cA + hstep, voffA);
        if (wr == 1) PG8_BAR;
        PG8_WAIT_V(4); PG8_BAR;
        PG8_STAGE(PG8_SB(1, 0), cB + kstep, voffB); PG8_STAGE(PG8_SA(1, 0), cA + kstep, voffA); PG8_STAGE(PG8_SB(1, 1), cB + hstep + kstep, voffB);
        PG8_WAIT_V(6); PG8_BAR;
    }
    for (;;) {
        const bool has_next = S.next(ui + 1, nxt);
        const char* nA = has_next ? (const char*)g.A + (size_t)nxt.pm * tstep : cA; const char* nB = has_next ? (const char*)g.Bt + (size_t)nxt.pn * tstep : cB;
        for (int t = 0; t < nt; t += 2) {
            const bool last = (t == nt - 2);
            const char* a1 = cA + (size_t)(t + 1) * kstep;
            const char* a2 = last ? nA : cA + (size_t)(t + 2) * kstep; const char* b2 = last ? nB : cB + (size_t)(t + 2) * kstep;
            const char* a3 = a2 + kstep; const char* b3 = b2 + kstep;
            if (last && has_next) S.a_ready(nxt);
            if constexpr (SP2) {
            PG8_LDB(B0, 0, 0); PG8_LDB(B1, 0, 1); PG8_SCHED; PG8_LDA(At, 0, 0); PG8_STAGE(PG8_SA(1, 1), a1 + hstep, voffA);
            PG8_WAIT_V(8); PG8_WAIT_L(0); PG8_BAR; PG8_MMA(0, 0, At, B0); PG8_MMA(0, 1, At, B1); PG8_BAR; PG8_SCHED;
            PG8_LDA(At, 0, 1); PG8_STAGE(PG8_SB(0, 0), b2, voffB); PG8_STAGE(PG8_SB(0, 1), b2 + hstep, voffB); PG8_STAGE(PG8_SA(0, 0), a2, voffA);
            PG8_WAIT_V(8); PG8_WAIT_L(0); PG8_BAR; PG8_MMA(1, 0, At, B0); PG8_MMA(1, 1, At, B1); PG8_BAR; PG8_SCHED;
            PG8_LDB(B0, 1, 0); PG8_LDB(B1, 1, 1); PG8_SCHED; PG8_LDA(At, 1, 0); PG8_STAGE(PG8_SA(0, 1), a2 + hstep, voffA);
            PG8_WAIT_V(8); PG8_WAIT_L(0); PG8_BAR; PG8_MMA(0, 0, At, B0); PG8_MMA(0, 1, At, B1); PG8_BAR; PG8_SCHED;
            PG8_LDA(At, 1, 1); PG8_STAGE(PG8_SB(1, 0), b3, voffB); PG8_STAGE(PG8_SB(1, 1), b3 + hstep, voffB); PG8_STAGE(PG8_SA(1, 0), a3, voffA);
            PG8_WAIT_V(8); PG8_WAIT_L(0); PG8_BAR; PG8_MMA(1, 0, At, B0); PG8_MMA(1, 1, At, B1); PG8_BAR; PG8_SCHED;
            } else {
            PG8_LDB(B0, 0, 0); PG8_SCHED; PG8_LDA(At, 0, 0); PG8_STAGE(PG8_SA(1, 1), a1 + hstep, voffA);
            PG8_WAIT_L(8); PG8_BAR; PG8_WAIT_L(0); PG8_MMA(0, 0, At, B0); PG8_BAR; PG8_SCHED;
            PG8_LDB(B1, 0, 1); PG8_STAGE(PG8_SB(0, 0), b2, voffB);
            PG8_BAR; PG8_WAIT_L(0); PG8_MMA(0, 1, At, B1); PG8_BAR;
            PG8_LDA(At, 0, 1); PG8_STAGE(PG8_SA(0, 0), a2, voffA);
            PG8_BAR; PG8_WAIT_L(0); PG8_MMA(1, 0, At, B0); PG8_BAR; PG8_SCHED;
            PG8_STAGE(PG8_SB(0, 1), b2 + hstep, voffB);
            PG8_WAIT_V(6); PG8_BAR; PG8_MMA(1, 1, At, B1); PG8_BAR;
            PG8_LDB(B0, 1, 0); PG8_SCHED; PG8_LDA(At, 1, 0); PG8_STAGE(PG8_SA(0, 1), a2 + hstep, voffA);
            PG8_WAIT_L(8); PG8_BAR; PG8_WAIT_L(0); PG8_MMA(0, 0, At, B0); PG8_BAR; PG8_SCHED;
            PG8_LDB(B1, 1, 1); PG8_STAGE(PG8_SB(1, 0), b3, voffB);
            PG8_BAR; PG8_WAIT_L(0); PG8_MMA(0, 1, At, B1); PG8_BAR;
            PG8_LDA(At, 1, 1); PG8_STAGE(PG8_SA(1, 0), a3, voffA);
            PG8_BAR; PG8_WAIT_L(0); PG8_MMA(1, 0, At, B0); PG8_BAR; PG8_SCHED;
            PG8_STAGE(PG8_SB(1, 1), b3 + hstep, voffB);
            PG8_WAIT_V(6); PG8_BAR; PG8_MMA(1, 1, At, B1); PG8_BAR;
            }
        }
        if constexpr (ALIGN_EPI) { if (wr == 0) PG8_BAR; }
        if constexpr (!Epi::AFTER_DRAIN) { int t3_ = wv * 64 + pg8_hw_lane(); asm volatile("" : "+v"(t3_)); const int l3_ = t3_ & 63, w3_ = __builtin_amdgcn_readfirstlane(t3_ >> 6);
            E(acc, cur, w3_ >> 2, w3_ & 3, l3_ & 15, l3_ >> 4); S.done(cur); }
        if (!has_next) break;
#pragma unroll
        for (int a = 0; a < 2; ++a)
#pragma unroll
            for (int b = 0; b < 2; ++b)
#pragma unroll
                for (int m = 0; m < 4; ++m)
#pragma unroll
                    for (int n = 0; n < 2; ++n) acc[a][b][m][n] = (f32x4){0.f, 0.f, 0.f, 0.f};
        cur = nxt; cA = nA; cB = nB; ++ui;
        if constexpr (ALIGN_EPI) { if (wr == 1) PG8_BAR; }
    }
    PG8_WAIT_V(0);
    if constexpr (!ALIGN_EPI) { if (wr == 0) PG8_BAR; }
    PG8_BAR;
    if constexpr (Epi::AFTER_DRAIN) { E.fused(acc, cur, wr, wc, fr, fq, lds, wid, lane); S.done(cur); }
#undef PG8_SA
#undef PG8_SB
#undef PG8_STAGE
#undef PG8_LDA
#undef PG8_LDB
#undef PG8_MMA
#undef PG8_WAIT_V
#undef PG8_WAIT_L
#undef PG8_BAR
#undef PG8_SCHED
}
}

#ifndef PG8_SP2
#define PG8_SP2 true
#endif
#ifndef PG8_ALIGN
#define PG8_ALIGN true
#endif
constexpr int NWAVES = 8;
#ifndef MK_ONE_LAUNCH
#define MK_ONE_LAUNCH 1
#endif

constexpr int NL = 2;
constexpr int M = 10240, MP = 8192;
constexpr int D = 1024, FF = 2816;
constexpr int NPB = 3328, NPF = 576, NGT = 4096;
constexpr int NSEQ = 34;
constexpr int NPHASE = 23;
constexpr int C_GAQ = 0, C_GAK = 128, C_GAV = 256, C_GAR = 512, C_DNX = 768, C_DNG = 1536, C_HGQ = 1792, C_HGI = 2048, C_HGG = 2304, C_DFQ = 2560, C_DFK = 2816, C_DFV = 3072;
constexpr int F_LR = 0, F_DNB = 32, F_DNA = 40, F_HGF = 48;
constexpr size_t O_Y = 0, O_DK = 10485760, O_DV = 14680064, O_SG = 18874368, O_SD = 19922944, O_SH = 22020096, O_END = 24117248;

constexpr size_t MiB = 1u << 20;
constexpr size_t WS_CTL = 0, CTL_ZERO_BYTES = 64 * 1024;
constexpr size_t WS_MODP = 1 * MiB;
constexpr size_t WS_MODF = 3 * MiB;
constexpr size_t WS_ROPE = 3 * MiB + 512 * 1024;
constexpr size_t WS_W = 4 * MiB;
constexpr size_t W_1A = 0, W_1B = W_1A + (size_t)5632 * 1024 * 2, W_IN = W_1B + (size_t)1024 * 2816 * 2, W_BR = W_IN + (size_t)8192 * 1024 * 2,
                 W_WO = W_BR + (size_t)4096 * 256 * 2, W_2A = W_WO + (size_t)1024 * 1024 * 2, W_2B = W_2A + (size_t)5632 * 1024 * 2, W_END = W_2B + (size_t)1024 * 2816 * 2;
static_assert(W_END <= 56 * MiB, "weights fit");
constexpr size_t WS_H = 60 * MiB;
constexpr size_t WS_BR = 80 * MiB;
constexpr size_t WS_GATE = 100 * MiB;
constexpr size_t WS_PB = 180 * MiB;
constexpr size_t WS_PF = 245 * MiB;
constexpr size_t WS_OSC = 268 * MiB;
constexpr size_t WS_KVC = 298 * MiB;
constexpr size_t WS_HIMG = 300 * MiB;
constexpr size_t WS_DNI1 = 321 * MiB;
constexpr size_t WS_END = 327 * MiB;
constexpr size_t WS_DNI0 = 71 * MiB;
constexpr size_t WS_GIMG = 60 * MiB;
constexpr size_t WS_DNT = 80 * MiB;
constexpr size_t WS_ACT = WS_PB, WS_PART = WS_PB;
constexpr size_t WS_XF = WS_GATE;
constexpr int CW_TMO = 0, CW_CODE = 1, CW_BAR = 4096;
constexpr size_t WS_SSP = 299 * MiB;
constexpr size_t WS_BIAS = WS_CTL + 272 * 1024;
constexpr size_t WS_LAM = WS_MODF + 480 * 1024;
constexpr size_t WS_CSV = WS_MODF + 256 * 1024;
constexpr int LRED_OFF = 131072;
static_assert(6 * 10240 * 16 <= 1024 * 1024 && 272 * 1024 + 5 * 3 * 8192 * 4 <= 1024 * 1024, "ssp / bias regions");

constexpr int RING_OFF = 0, RING_BYTES = 131072;
constexpr int LDSCTL_OFF = 155648, MISC_OFF = LDSCTL_OFF + 320;
constexpr int LDS_BYTES = 163840;

#define GAS __attribute__((address_space(1)))
#define LAS __attribute__((address_space(3)))
typedef unsigned short bf16;
typedef unsigned v4u __attribute__((ext_vector_type(4)));
typedef unsigned v2u __attribute__((ext_vector_type(2)));
typedef float f32x4 __attribute__((ext_vector_type(4)));
typedef GAS unsigned gu32;
#define RLX_AGENT __ATOMIC_RELAXED, __HIP_MEMORY_SCOPE_AGENT
#define LDS_WAIT() asm volatile("s_waitcnt lgkmcnt(0)" ::: "memory")
#define VM_WAIT() asm volatile("s_waitcnt vmcnt(0)" ::: "memory")
typedef float f32x2_t __attribute__((ext_vector_type(2))); typedef __bf16 bf16x2_t __attribute__((ext_vector_type(2)));
__device__ __forceinline__ unsigned pk2(float lo, float hi) { f32x2_t v = {lo, hi}; bf16x2_t b = __builtin_convertvector(v, bf16x2_t); return __builtin_bit_cast(unsigned, b); }
__device__ __forceinline__ unsigned f2bf(float f) { return pk2(f, 0.f) & 0xffffu; }
__device__ __forceinline__ float bf2f(unsigned short u) { return __builtin_bit_cast(float, (unsigned)u << 16); }
__device__ __forceinline__ float bflo(unsigned w) { return __builtin_bit_cast(float, w << 16); }
__device__ __forceinline__ float bfhi(unsigned w) { return __builtin_bit_cast(float, w & 0xffff0000u); }
__device__ __forceinline__ float sigmoidf_(float x) { return 1.0f / (1.0f + expf(-x)); }
__device__ __forceinline__ float fast_sig(float x) { return __builtin_amdgcn_rcpf(1.0f + __expf(-x)); }
__device__ __forceinline__ float siluf_(float x) { return x / (1.0f + expf(-x)); }
__device__ __forceinline__ float softplusf_(float x) { return fmaxf(x, 0.f) + log1pf(expf(-fabsf(x))); }
__device__ __forceinline__ int hw_lane() { int r; asm volatile("v_mbcnt_lo_u32_b32 %0, -1, 0\n\tv_mbcnt_hi_u32_b32 %0, -1, %0" : "=v"(r)); return r; }
template <int PAT> __device__ __forceinline__ float swz_xor(float v) { return __builtin_bit_cast(float, __builtin_amdgcn_ds_swizzle(__builtin_bit_cast(int, v), PAT)); }
__device__ __forceinline__ float wave_sum(float v) {
    v += swz_xor<0x041F>(v); v += swz_xor<0x081F>(v); v += swz_xor<0x101F>(v); v += swz_xor<0x201F>(v); v += swz_xor<0x401F>(v);
    const float lo = __builtin_bit_cast(float, __builtin_amdgcn_readlane(__builtin_bit_cast(int, v), 0)), hi = __builtin_bit_cast(float, __builtin_amdgcn_readlane(__builtin_bit_cast(int, v), 32));
    return lo + hi;
}

#define XB_TMO      128
#define XB_XCNT(j)  (256  + 64 * (j))
#define XB_XSUB(j)  (1280 + 64 * (j))
#define XB_XGEN(j)  (2304 + 64 * (j))
#define XB_TOP      3328
#define XB_TOPGEN   3392
#define XCD_BAR_WORDS 3456
#define XB_SPIN_CAP (1u << 18)

__device__ __forceinline__ unsigned xb_ld(unsigned* p)              { return __hip_atomic_load(p, __ATOMIC_RELAXED, __HIP_MEMORY_SCOPE_AGENT); }
__device__ __forceinline__ unsigned xb_add(unsigned* p, unsigned v) { return __hip_atomic_fetch_add(p, v, __ATOMIC_RELAXED, __HIP_MEMORY_SCOPE_AGENT); }
__device__ __forceinline__ unsigned xb_xcc_id() { return (unsigned)__builtin_amdgcn_s_getreg((3 << 11) | 20) & 0xFu; }
#define XB_SPIN(cond, bar) do { unsigned _sp = 0; while (cond) { __builtin_amdgcn_s_sleep(1); \
    if ((++_sp & 255u) == 0u) { if (xb_ld(&(bar)[XB_TMO])) break; if (_sp > XB_SPIN_CAP) { atomicAdd(&(bar)[XB_TMO], 1u); break; } } } } while (0)

struct XcdBarrier {
    unsigned* bar; unsigned x;
    volatile LAS unsigned* st;
};

__device__ __forceinline__ XcdBarrier xcd_barrier_post(unsigned* bar, volatile LAS unsigned* st) {
    XcdBarrier b; b.bar = bar; b.x = xb_xcc_id(); b.st = st;
    if (threadIdx.x == 0) (void)xb_add(&bar[XB_XCNT(b.x)], 1u);
    return b;
}
__device__ __forceinline__ void xcd_barrier_complete(unsigned* bar, unsigned x, unsigned& nloc, unsigned& nx) {
    const unsigned G = gridDim.x * gridDim.y * gridDim.z;
    unsigned sum, cnt, mine, sp = 0u;
    for (;;) {
        sum = 0u; cnt = 0u; mine = 0u;
#pragma unroll
        for (unsigned j = 0; j < 16; ++j) { const unsigned c = xb_ld(&bar[XB_XCNT(j)]); sum += c; cnt += (c > 0u) ? 1u : 0u; mine = (j == x) ? c : mine; }
        if (sum == G) break;
        __builtin_amdgcn_s_sleep(1);
        if ((++sp & 255u) == 0u) { if (xb_ld(&bar[XB_TMO])) break; if (sp > XB_SPIN_CAP) { atomicAdd(&bar[XB_TMO], 1u); break; } }
    }
    nloc = mine > 0u ? mine : 1u; nx = cnt > 0u ? cnt : 1u;
}

__device__ __forceinline__ void xcd_barrier(const XcdBarrier& b, bool leader  ) {
    asm volatile("s_waitcnt vmcnt(0)" ::: "memory");
    __syncthreads();
    if (leader) {
        unsigned* bar = b.bar;
        __builtin_amdgcn_s_waitcnt(0);
        unsigned nloc = b.st[0], nx = b.st[1];
        if (nloc == 0u) { xcd_barrier_complete(bar, b.x, nloc, nx); b.st[0] = nloc; b.st[1] = nx; }
        const unsigned old = xb_add(&bar[XB_XSUB(b.x)], 1u);
        const unsigned gen = old / nloc;
        if (old + 1u == (gen + 1u) * nloc) {
            __builtin_amdgcn_fence(__ATOMIC_RELEASE, "agent");
            asm volatile("s_waitcnt vmcnt(0)" ::: "memory");
            const unsigned og = xb_add(&bar[XB_TOP], 1u);
            const unsigned tg = og / nx;
            if (og + 1u == (tg + 1u) * nx) xb_add(&bar[XB_TOPGEN], 1u);
            else XB_SPIN(xb_ld(&bar[XB_TOPGEN]) == tg, bar);
            __builtin_amdgcn_fence(__ATOMIC_ACQUIRE, "agent");
            xb_add(&bar[XB_XGEN(b.x)], 1u);
            asm volatile("s_waitcnt vmcnt(0)" ::: "memory");
        } else {
            XB_SPIN(xb_ld(&bar[XB_XGEN(b.x)]) == gen, bar);
            __builtin_amdgcn_fence(__ATOMIC_ACQUIRE, "agent");
            asm volatile("s_waitcnt vmcnt(0)" ::: "memory");
        }
    }
    __syncthreads();
}

struct Args { const float* in[32]; float* out; unsigned char* ws; int ph_lo, ph_hi; };
typedef __attribute__((address_space(4))) Args KArgs;
enum { I_XP = 0, I_XS, I_CK, I_CV, I_SGLA, I_SDN, I_SHG, I_C, I_CCTX, I_NORMW, I_WMOD, I_BMOD, I_F1IN, I_F1DN, I_F2IN, I_F2DN, I_WIN, I_GW2, I_GB, I_GNORM,
       I_DCONV, I_DALOG, I_DDT, I_DNORM, I_HLB, I_HNORM, I_DLAM, I_DFNORM, I_WBR, I_WMG, I_WOUT, I_FNORM };

__device__ __forceinline__ int srccol_inproj(int np) {
    if (np < 768) return np;
    if (np < 1536) return np - 768 + 800;
    if (np < 1792) return np - 1536 + 1584;
    if (np < 2048) return np - 1792 + 1840;
    if (np < 2304) return np - 2048 + 2608;
    if (np < 2560) return np - 2304 + 2864;
    if (np < 2816) return np - 2560 + 3120;
    if (np < 3072) return np - 2816 + 3376;
    if (np < 3328) return np - 3072 + 3632;
    const int o = np - 3328;
    if (o < 32) return 768 + o;
    if (o < 40) return 1568 + (o - 32);
    if (o < 48) return 1576 + (o - 40);
    if (o < 560) return 2096 + (o - 48);
    return -1;
}
__device__ __forceinline__ void tr_item(const float* W, int ldw, int K, bf16* WT, int kb, int nb, int kind, LAS float* scr, int lane) {
    const int k0 = 64 * kb, n0 = 32 * nb, np = n0 + 4 * (lane & 7);
    int sc = np;
    if (kind == 1) sc = ((np >> 7) & 1) * 2816 + (np >> 8) * 128 + (np & 127);
    else if (kind == 2) sc = srccol_inproj(np);
    f32x4 tv[8];
    const float* wp = W + (size_t)(k0 + (lane >> 3)) * ldw + (sc >= 0 ? sc : 0);
#pragma unroll
    for (int i = 0; i < 8; ++i) tv[i] = __builtin_nontemporal_load((const f32x4*)(wp + (size_t)(8 * i) * ldw));
#pragma unroll
    for (int i = 0; i < 8; ++i) { LAS float* d = scr + ((lane >> 3) + 8 * i) * 33 + 4 * (lane & 7); const f32x4 v = tv[i];
        d[0] = sc >= 0 ? v.x : 0.f; d[1] = sc >= 0 ? v.y : 0.f; d[2] = sc >= 0 ? v.z : 0.f; d[3] = sc >= 0 ? v.w : 0.f; }
    LDS_WAIT(); asm volatile("" ::: "memory");
    const int c = lane & 7;
#pragma unroll
    for (int j = 0; j < 4; ++j) { const int n = (lane >> 3) + 8 * j; const LAS float* s = scr + (8 * c) * 33 + n;
        v4u o; o.x = pk2(s[0 * 33], s[1 * 33]); o.y = pk2(s[2 * 33], s[3 * 33]); o.z = pk2(s[4 * 33], s[5 * 33]); o.w = pk2(s[6 * 33], s[7 * 33]);
        *(GAS v4u*)(WT + (size_t)(n0 + n) * K + k0 + 8 * c) = o; }
    LDS_WAIT(); asm volatile("" ::: "memory");
}
constexpr int CI0 = 16 * 176, CI1 = CI0 + 44 * 32, CI2 = CI1 + 16 * 128, CI3 = CI2 + 16 * 128, CI4 = CI3 + 4 * 4 * 32, CI5 = CI4 + 16 * 32, CI6 = CI5 + 16 * 176, CI7 = CI6 + 44 * 32;
__device__ __forceinline__ void conv_items(const KArgs& a, int l, int i0, int i1, int w, int nw, LAS unsigned char* lds, int wave, int lane) {
    LAS float* scr = (LAS float*)(lds + wave * 16384);
    bf16* Wb = (bf16*)(a.ws + WS_W);
    for (int it = i0 + w; it < i1; it += nw) {
        if (it < CI0) { const int r = it; tr_item(a.in[I_F1IN] + (size_t)l * 1024 * 5632, 5632, 1024, (bf16*)((char*)Wb + W_1A), r / 176, r % 176, 1, scr, lane); }
        else if (it < CI1) { const int r = it - CI0; tr_item(a.in[I_F1DN] + (size_t)l * 2816 * 1024, 1024, 2816, (bf16*)((char*)Wb + W_1B), r / 32, r % 32, 0, scr, lane); }
        else if (it < CI2) { const int r = it - CI1; tr_item(a.in[I_WIN] + (size_t)l * 1024 * 3888, 3888, 1024, (bf16*)((char*)Wb + W_IN), r / 128, r % 128, 2, scr, lane); }
        else if (it < CI3) { const int r = it - CI2; tr_item(a.in[I_WMG] + (size_t)l * 1024 * 4096, 4096, 1024, (bf16*)((char*)Wb + W_IN) + (size_t)4096 * 1024, r / 128, r % 128, 0, scr, lane); }
        else if (it < CI4) { const int r = it - CI3, n = r / 128, q = r % 128; tr_item(a.in[I_WBR] + (size_t)(l * 4 + n) * 256 * 1024, 1024, 256, (bf16*)((char*)Wb + W_BR) + (size_t)n * 1024 * 256, q / 32, q % 32, 0, scr, lane); }
        else if (it < CI5) { const int r = it - CI4; tr_item(a.in[I_WOUT] + (size_t)l * 1024 * 1024, 1024, 1024, (bf16*)((char*)Wb + W_WO), r / 32, r % 32, 0, scr, lane); }
        else if (it < CI6) { const int r = it - CI5; tr_item(a.in[I_F2IN] + (size_t)l * 1024 * 5632, 5632, 1024, (bf16*)((char*)Wb + W_2A), r / 176, r % 176, 1, scr, lane); }
        else { const int r = it - CI6; tr_item(a.in[I_F2DN] + (size_t)l * 2816 * 1024, 1024, 2816, (bf16*)((char*)Wb + W_2B), r / 32, r % 32, 0, scr, lane); }
    }
}
__device__ __forceinline__ void conv_cache(const KArgs& a, int l, int w, int nw, int lane) {
    bf16* kvc = (bf16*)(a.ws + WS_KVC);
    for (int i = (w * 64 + lane) * 4; i < 2 * 2 * 4 * 512 * 64; i += nw * 64 * 4) {
        const int kv = i / (2 * 4 * 512 * 64), r = i % (2 * 4 * 512 * 64), b = r / (4 * 512 * 64), q = r % (4 * 512 * 64);
        const f32x4 v = __builtin_nontemporal_load((const f32x4*)((kv ? a.in[I_CV] : a.in[I_CK]) + (size_t)(b * NL + l) * 4 * 512 * 64 + q));
        v2u wv; wv.x = pk2(v.x, v.y); wv.y = pk2(v.z, v.w); *(v2u*)(kvc + i) = wv;
    }
}
constexpr int BI1 = 128, BI2 = BI1 + 88, BI3 = BI2 + 88, BI4 = BI3 + 128, BI5 = BI4 + 88;
__device__ __forceinline__ void bias_items(const KArgs& a, int i0, int i1, int w, int nw, LAS unsigned char* lds, int wave, int lane, size_t dummy = 0) {
    LAS float* shl = (LAS float*)(lds + wave * 2048);
    LAS float* red = (LAS float*)(lds + 16384);
    const float* modf = (const float*)(a.ws + WS_MODF);
    float* bias = (float*)(a.ws + WS_BIAS + dummy);
    for (int it = i0 + w; it < i1; it += nw) {
        int cb, r;
        if (it < BI1) { cb = 0; r = it; } else if (it < BI2) { cb = 1; r = it - BI1; } else if (it < BI3) { cb = 2; r = it - BI2; } else if (it < BI4) { cb = 3; r = it - BI3; } else { cb = 4; r = it - BI4; }
        const int ll = (cb + 1) / 3, which = (cb + 1) % 3, kc = wave, n = r * 64 + lane;
#pragma unroll
        for (int q = 0; q < 6; ++q) { const int idx = lane + 64 * q, g = idx >> 7, kk = idx & 127; shl[idx] = modf[(size_t)(ll * 3 + g) * 9216 + which * 3 * 1024 + kc * 128 + kk]; }
        LDS_WAIT(); asm volatile("" ::: "memory");
        const float* W; int ldw, sc;
        if (which == 1) { if (n < 4096) { W = a.in[I_WIN] + (size_t)ll * 1024 * 3888; ldw = 3888; sc = srccol_inproj(n); } else { W = a.in[I_WMG] + (size_t)ll * 1024 * 4096; ldw = 4096; sc = n - 4096; } }
        else { W = (which == 0 ? a.in[I_F1IN] : a.in[I_F2IN]) + (size_t)ll * 1024 * 5632; ldw = 5632; sc = ((n >> 7) & 1) * 2816 + (n >> 8) * 128 + (n & 127); }
        const float* wp = W + (size_t)(kc * 128) * ldw + (sc >= 0 ? sc : 0);
        float s0 = 0.f, s1 = 0.f, s2 = 0.f;
        for (int k0 = 0; k0 < 128; k0 += 32) {
            float wv[32];
#pragma unroll
            for (int i = 0; i < 32; ++i) wv[i] = __builtin_nontemporal_load(wp + (size_t)(k0 + i) * ldw);
#pragma unroll
            for (int i = 0; i < 32; i += 4) {
                const f32x4 h0 = *(const LAS f32x4*)(shl + k0 + i), h1 = *(const LAS f32x4*)(shl + 128 + k0 + i), h2 = *(const LAS f32x4*)(shl + 256 + k0 + i);
                s0 += (h0.x * wv[i] + h0.y * wv[i + 1]) + (h0.z * wv[i + 2] + h0.w * wv[i + 3]);
                s1 += (h1.x * wv[i] + h1.y * wv[i + 1]) + (h1.z * wv[i + 2] + h1.w * wv[i + 3]);
                s2 += (h2.x * wv[i] + h2.y * wv[i + 1]) + (h2.z * wv[i + 2] + h2.w * wv[i + 3]);
            }
        }
        if (sc < 0) { s0 = 0.f; s1 = 0.f; s2 = 0.f; }
        red[(wave * 3 + 0) * 64 + lane] = s0; red[(wave * 3 + 1) * 64 + lane] = s1; red[(wave * 3 + 2) * 64 + lane] = s2;
        __syncthreads();
        if (wave < 3) { float s = 0.f;
#pragma unroll
            for (int q = 0; q < 8; ++q) s += red[(q * 3 + wave) * 64 + lane];
            bias[(size_t)(cb * 3 + wave) * 8192 + n] = s; }
        __syncthreads();
    }
}
__device__ __forceinline__ void mod_items(const KArgs& a, int i0, int i1, int w, int nw, LAS unsigned char* lds, int wave, int lane) {
    float* modp = (float*)(a.ws + WS_MODP);
    LAS float* sl = (LAS float*)(lds + wave * 16384 + 12288);
        for (int it = i0 + w; it < i1; it += nw) {
            const int ll = it / 288, r = it % 288, ks = r / 36, jb = r % 36, j = jb * 256 + lane * 4;
            const float* w = a.in[I_WMOD] + (size_t)ll * 1024 * 9216 + (size_t)(ks * 128) * 9216 + j;
#pragma unroll
            for (int q = 0; q < 2; ++q) { const int kk = ks * 128 + lane + 64 * q; sl[lane + 64 * q] = siluf_(a.in[I_CCTX][kk]); sl[128 + lane + 64 * q] = siluf_(a.in[I_C][kk]); sl[256 + lane + 64 * q] = siluf_(a.in[I_C][1024 + kk]); }
            LDS_WAIT(); asm volatile("" ::: "memory");
            f32x4 a0 = {0.f, 0.f, 0.f, 0.f}, a1 = a0, a2 = a0;
            for (int k0 = 0; k0 < 128; k0 += 32) {
                f32x4 wv[32];
#pragma unroll
                for (int i = 0; i < 32; ++i) wv[i] = __builtin_nontemporal_load((const f32x4*)(w + (size_t)(k0 + i) * 9216));
#pragma unroll
                for (int i = 0; i < 32; i += 4) {
                    const f32x4 s0 = *(const LAS f32x4*)(sl + k0 + i), s1 = *(const LAS f32x4*)(sl + 128 + k0 + i), s2 = *(const LAS f32x4*)(sl + 256 + k0 + i);
#pragma unroll
                    for (int q = 0; q < 4; ++q) { a0 += wv[i + q] * s0[q]; a1 += wv[i + q] * s1[q]; a2 += wv[i + q] * s2[q]; }
                }
            }
            if (ks == 0) { const f32x4 bv = *(const f32x4*)(a.in[I_BMOD] + (size_t)ll * 9216 + j); a0 += bv; a1 += bv; a2 += bv; }
            float* o = modp + (size_t)((ll * 8 + ks) * 3) * 9216 + j;
            *(f32x4*)o = a0; *(f32x4*)(o + 9216) = a1; *(f32x4*)(o + 2 * 9216) = a2;
            LDS_WAIT(); asm volatile("" ::: "memory");
        }
}
__device__ __forceinline__ void mod_consolidate(const KArgs& a, int ll, int w, int nw, int lane) {
    float* modf = (float*)(a.ws + WS_MODF); const float* mp = (const float*)(a.ws + WS_MODP); float* csv = (float*)(a.ws + WS_CSV);
    for (int i = w * 64 + lane; i < 3 * 9216; i += nw * 64) {
        float s = 0.f;
#pragma unroll
        for (int ks = 0; ks < 8; ++ks) s += mp[(size_t)((ll * 8 + ks) * 3) * 9216 + i];
        modf[(size_t)ll * 3 * 9216 + i] = s;
    }
    for (int i = w * 64 + lane; i < 3 * 3 * 1024; i += nw * 64) {
        const int c = i & 1023, g = (i >> 10) % 3, wh = i / 3072; float s = 0.f;
#pragma unroll
        for (int ks = 0; ks < 8; ++ks) s += mp[(size_t)((ll * 8 + ks) * 3 + g) * 9216 + (wh * 3 + 1) * 1024 + c];
        csv[(size_t)ll * 9216 + i] = a.in[I_NORMW][(size_t)(ll * 3 + wh) * 1024 + c] * (1.0f + s);
    }
}
__device__ __forceinline__ void pro_phase(const KArgs& a, int l, LAS unsigned char* lds, int gw, int wave, int lane) {
    constexpr int NGW = 256 * NWAVES;
    conv_items(a, 0, 0, CI0, gw, NGW, lds, wave, lane);
    conv_cache(a, 0, gw, NGW, lane);
    if (l == 0) {
        mod_items(a, 0, 288, NGW - 1 - gw, NGW, lds, wave, lane);
        if (gw == 0 && lane < NL) {
            const float* lv = a.in[I_DLAM] + (size_t)lane * 128; float s01 = 0.f, s23 = 0.f;
            for (int i = 0; i < 32; ++i) { s01 += lv[i] * lv[32 + i]; s23 += lv[64 + i] * lv[96 + i]; }
            ((float*)(a.ws + WS_LAM))[lane] = expf(s01) - expf(s23) + (0.8f - 0.6f * expf(-0.3f * (float)lane));
        }
        float* ct = (float*)(a.ws + WS_ROPE); float* st = ct + 1024 * 32;
        for (int idx = gw * 64 + lane; idx < 1024 * 32; idx += NGW * 64) {
            const int t = idx >> 5, d = idx & 31;
            const float pos = (float)((d < 16) ? (t >> 6) : (t & 63));
            const float inv = powf(10000.0f, -(float)(d & 7) * 0.125f);
            float sn, cs; sincosf(pos * inv, &sn, &cs);
            ct[idx] = cs; st[idx] = sn;
        }
    }
}

__device__ __forceinline__ void norm_phase(const KArgs& a, int l, int which, LAS unsigned char* lds, int gw, int tid, int lane, const float* xP, const float* xS) {
    LAS float* cs = (LAS float*)lds;
    LAS float* sh = cs + 3 * 1024;
    const float* modp = (const float*)(a.ws + WS_MODP) + (size_t)l * 8 * 3 * 9216;
    const float* nw = a.in[I_NORMW] + (size_t)(l * 3 + which) * 1024;
    const int csh = which * 3, csc = which * 3 + 1;
    bf16* H = (bf16*)(a.ws + WS_H);
    f32x4 v[5][4];
#pragma unroll
    for (int q = 0; q < 5; ++q) {
        const int row = gw + q * 256 * NWAVES;
        const float* xr = row < MP ? xP + (size_t)row * D : xS + (size_t)(row - MP) * D;
#pragma unroll
        for (int j = 0; j < 4; ++j) v[q][j] = *((const f32x4*)xr + lane + 64 * j);
    }
#pragma unroll
    for (int q6 = 0; q6 < 6; ++q6) {
        const int i = tid + q6 * NWAVES * 64;
        const int g = i >> 10, c = i & 1023; float vs = 0.f, vh = 0.f;
#pragma unroll
        for (int ks = 0; ks < 8; ++ks) { const float* p = modp + (size_t)(ks * 3 + g) * 9216; vs += p[csc * 1024 + c]; vh += p[csh * 1024 + c]; }
        cs[i] = nw[c] * (1.0f + vs); sh[i] = vh;
    }
    __syncthreads();
#pragma unroll
    for (int q = 0; q < 5; ++q) {
        const int row = gw + q * 256 * NWAVES;
        const int g = row < MP ? 0 : 1 + ((row - MP) >> 10);
        float s = 0.f;
#pragma unroll
        for (int j = 0; j < 4; ++j) s += (v[q][j].x * v[q][j].x + v[q][j].y * v[q][j].y) + (v[q][j].z * v[q][j].z + v[q][j].w * v[q][j].w);
        const float rstd = 1.0f / sqrtf(wave_sum(s) * (1.0f / D) + 1e-6f);
#pragma unroll
        for (int j = 0; j < 4; ++j) {
            const int c = (lane + 64 * j) * 4;
            const f32x4 c4 = *(const LAS f32x4*)(cs + g * 1024 + c), h4 = *(const LAS f32x4*)(sh + g * 1024 + c);
            const f32x4 o = v[q][j] * rstd * c4 + h4;
            v2u w; w.x = pk2(o.x, o.y); w.y = pk2(o.z, o.w);
            *(v2u*)(H + (size_t)row * D + c) = w;
        }
    }
    if (l == 0 && which == 0) {
        mod_consolidate(a, 0, gw, 256 * NWAVES, lane);
        float* csv = (float*)(a.ws + WS_CSV);
        for (int i = gw * 64 + lane; i < 3 * 1024; i += 256 * NWAVES * 64) csv[NL * 3 * 3 * 1024 + i] = a.in[I_FNORM][i & 1023];
    }
}
__device__ __forceinline__ void final_phase(const KArgs& a, int gw, int lane) {
    float* X = a.out + O_Y; const bf16* H = (const bf16*)(a.ws + WS_H); const float* ss = (const float*)(a.ws + WS_SSP) + (size_t)5 * M * 4;
    v4u v[5][2]; f32x4 q[5];
#pragma unroll
    for (int r = 0; r < 5; ++r) {
        const int row = gw + r * 256 * NWAVES;
        q[r] = *(const f32x4*)(ss + (size_t)row * 4);
#pragma unroll
        for (int j = 0; j < 2; ++j) v[r][j] = *((const v4u*)(H + (size_t)row * D) + lane + 64 * j);
    }
#pragma unroll
    for (int r = 0; r < 5; ++r) {
        float* xr = X + (size_t)(gw + r * 256 * NWAVES) * D;
        const float rstd = 1.0f / sqrtf(((q[r].x + q[r].y) + (q[r].z + q[r].w)) * (1.0f / D) + 1e-6f);
#pragma unroll
        for (int j = 0; j < 2; ++j) {
            const v4u w = v[r][j]; f32x4 o0, o1;
            o0.x = bflo(w.x) * rstd; o0.y = bfhi(w.x) * rstd; o0.z = bflo(w.y) * rstd; o0.w = bfhi(w.y) * rstd; o1.x = bflo(w.z) * rstd; o1.y = bfhi(w.z) * rstd; o1.z = bflo(w.w) * rstd; o1.w = bfhi(w.w) * rstd;
            float* p = xr + (lane + 64 * j) * 8; *(f32x4*)p = o0; *(f32x4*)(p + 4) = o1;
        }
    }
}


struct SeqInfo { bool ctx; int T, row0, b; };
__device__ __forceinline__ SeqInfo seq_info(int s) { SeqInfo q; q.ctx = s < 32; q.T = q.ctx ? 256 : 1024; q.row0 = q.ctx ? s * 256 : MP + (s - 32) * 1024; q.b = q.ctx ? s : s - 32; return q; }

typedef short s16x8 __attribute__((ext_vector_type(8)));
typedef float f32x16 __attribute__((ext_vector_type(16)));
typedef short v4i16_t __attribute__((ext_vector_type(4)));
__device__ __forceinline__ s16x8 pack_acc8(const f32x16& x, int s, float f0, float f1, float f2, float f3, float f4, float f5, float f6, float f7) {
    v4u w; w.x = pk2(x[8 * s + 0] * f0, x[8 * s + 1] * f1); w.y = pk2(x[8 * s + 2] * f2, x[8 * s + 3] * f3); w.z = pk2(x[8 * s + 4] * f4, x[8 * s + 5] * f5); w.w = pk2(x[8 * s + 6] * f6, x[8 * s + 7] * f7);
    return __builtin_bit_cast(s16x8, w);
}
__device__ __forceinline__ int img_sw(int row, int ld) { return ld == 64 ? (row & 7) : ((row >> 1) & 3); }
__device__ __forceinline__ s16x8 frag_a(const LAS bf16* img, int ld, int row, int ks, int hh) {
    int sw = img_sw(row, ld); asm volatile("" : "+v"(sw));
    const LAS unsigned char* rb = (const LAS unsigned char*)img + row * ld * 2 + 8 * hh;
    const v2u lo = *(const LAS v2u*)(rb + (((2 * ks) ^ sw) << 4)), hi = *(const LAS v2u*)(rb + (((2 * ks + 1) ^ sw) << 4));
    v4u w; w.x = lo.x; w.y = lo.y; w.z = hi.x; w.w = hi.y; return __builtin_bit_cast(s16x8, w);
}
__device__ __forceinline__ s16x8 frag_tr_sw(const LAS bf16* img, int ld, int rowbase, int colbase, int lane) {
    const int hh = lane >> 5, g16 = (lane >> 4) & 1, l16 = lane & 15;
    const int row = rowbase + 4 * hh + (l16 >> 2), col = colbase + 16 * g16 + 4 * (l16 & 3);
    int swt = img_sw(row, ld); asm volatile("" : "+v"(swt));
    const LAS unsigned char* bp = (const LAS unsigned char*)img + row * ld * 2 + (((col >> 3) ^ swt) << 4) + (col & 7) * 2;
    const v4i16_t lo = __builtin_amdgcn_ds_read_tr16_b64_v4i16((LAS v4i16_t*)bp), hi = __builtin_amdgcn_ds_read_tr16_b64_v4i16((LAS v4i16_t*)(bp + 16 * ld));
    return (s16x8){lo[0], lo[1], lo[2], lo[3], hi[0], hi[1], hi[2], hi[3]};
}
__device__ __forceinline__ s16x8 frag_tr(const LAS bf16* img, int ldb, int rowbase, int colbase, int lane) {
    const int hh = lane >> 5, g16 = (lane >> 4) & 1, l16 = lane & 15;
    const LAS unsigned char* bp = (const LAS unsigned char*)img + (rowbase + 4 * hh + (l16 >> 2)) * ldb + (colbase + 16 * g16 + 4 * (l16 & 3)) * 2;
    const v4i16_t lo = __builtin_amdgcn_ds_read_tr16_b64_v4i16((LAS v4i16_t*)bp), hi = __builtin_amdgcn_ds_read_tr16_b64_v4i16((LAS v4i16_t*)(bp + 8 * ldb));
    return (s16x8){lo[0], lo[1], lo[2], lo[3], hi[0], hi[1], hi[2], hi[3]};
}
constexpr int SCAN_LDS = 19456;
template <int DK> struct ScanImg { static constexpr int QB = 0, KB = 64 * DK * 2, FB = 2 * 64 * DK * 2, BYTES = 2 * 64 * DK * 2 + 3 * DK * 4; };
__device__ __forceinline__ int blk_of(const SeqInfo& si, int tb) { return si.row0 / 64 + tb; }

template <int DK, bool HG>
__device__ __forceinline__ void prep_glahg(const KArgs& a, int l, int blk, int h, int dir, LAS unsigned char* sm, int lane_in) {
    int lane = lane_in; asm volatile("" : "+v"(lane));
    const bf16* PB = (const bf16*)(a.ws + WS_PB); const float* PF = (const float*)(a.ws + WS_PF);
    unsigned char* img = a.ws + (HG ? WS_HIMG : WS_GIMG) + (size_t)((blk * 4 + h) * 2 + dir) * ScanImg<DK>::BYTES;
    bf16* QI = (bf16*)(img + ScanImg<DK>::QB); bf16* KI = (bf16*)(img + ScanImg<DK>::KB); float* FI = (float*)(img + ScanImg<DK>::FB);
    LAS float* XCH = (LAS float*)sm;
    const int r32 = lane & 31, hh = lane >> 5;
    const int tstp = dir == 0 ? 1 : -1;
    const size_t rowb = (size_t)(blk * 64 + (dir == 0 ? 0 : 63));
    if (HG) {
        const int d = lane; float lb_hi = 0.f, lb_lo = 0.f;
        if (l == 1) { const float* lg = a.in[I_HLB]; const int c = h * 64 + d; lb_hi = lg[(size_t)(2 + dir) * 256 + c]; lb_lo = lg[(size_t)dir * 256 + c]; }
        const long sx = (long)tstp * NPF, sq = (long)tstp * NPB;
        const float* px0 = PF + rowb * NPF + F_HGF + dir * 256 + h * 64 + d;
        const bf16* pq0 = PB + rowb * NPB + C_HGQ + h * 64 + d;
        float xv[64]; unsigned qp[32];
#pragma unroll
        for (int t = 0; t < 64; ++t) xv[t] = px0[(long)t * sx];
#pragma unroll
        for (int t = 0; t < 64; t += 2) { const unsigned lo = pq0[(long)t * sq], hi = pq0[(long)(t + 1) * sq]; qp[t >> 1] = lo | (hi << 16); }
        const float lbv = (l == 1) ? sigmoidf_(lb_hi - lb_lo) : 0.f;
        float bcur = 0.f, bb[32];
#pragma unroll
        for (int tau = 0; tau < 32; ++tau) { const float f = lbv + (1.0f - lbv) * fast_sig(xv[tau]); xv[tau] = f; bcur += __logf(f); bb[tau] = bcur; }
        const float rr = bcur;
#pragma unroll
        for (int tau = 0; tau < 64; ++tau) {
            const float qr = (tau & 1) ? bfhi(qp[tau >> 1]) : bflo(qp[tau >> 1]);
            const float f = tau < 32 ? xv[tau] : lbv + (1.0f - lbv) * fast_sig(xv[tau]);
            float bt;
            if (tau < 32) bt = bb[tau]; else { bcur += __logf(f); bt = bcur; }
            const float e1 = __expf(fminf(fmaxf(bt - rr, -80.f), 80.f)), e2 = __builtin_amdgcn_rcpf(e1);
            QI[tau * DK + d] = (bf16)f2bf(qr * fast_sig(qr) * 0.125f * e1); KI[tau * DK + d] = (bf16)f2bf((1.0f - f) * e2);
        }
        FI[d] = __expf(rr); FI[DK + d] = __expf(bcur - rr); FI[2 * DK + d] = __expf(bcur);
    } else {
        const int d = r32;
        const float gbv = a.in[I_GB][(size_t)(l * 2 + dir) * 128 + h * 32 + d];
        float w2r[16];
#pragma unroll
        for (int r = 0; r < 16; ++r) w2r[r] = a.in[I_GW2][(size_t)((l * 2 + dir) * 16 + r) * 128 + h * 32 + d];
        const long sq = (long)tstp * NPB;
        const bf16* pq0 = PB + (rowb + (long)tstp * (32 * hh)) * NPB + h * 32 + d;
        LAS float* XL = XCH + 256;
        f32x4 lr4[4];
        { const float* pl = PF + (rowb + (long)tstp * lane) * NPF + F_LR + dir * 16;
#pragma unroll
          for (int r4 = 0; r4 < 4; ++r4) lr4[r4] = *(const f32x4*)(pl + r4 * 4); }
        unsigned qk[32];
#pragma unroll
        for (int tq = 0; tq < 32; ++tq) { const bf16* pq = pq0 + (long)tq * sq; const unsigned lo = pq[C_GAQ], hi = pq[C_GAK]; qk[tq] = lo | (hi << 16); }
#pragma unroll
        for (int r4 = 0; r4 < 4; ++r4) *(LAS f32x4*)(XL + lane * 16 + r4 * 4) = lr4[r4];
        LDS_WAIT(); asm volatile("" ::: "memory");
        float bcur = 0.f, bb[32];
#pragma unroll
        for (int tq = 0; tq < 32; ++tq) {
            const LAS float* pl = XL + (32 * hh + tq) * 16; float z = gbv;
#pragma unroll
            for (int r4 = 0; r4 < 4; ++r4) { const f32x4 t4 = *(const LAS f32x4*)(pl + r4 * 4); z += t4.x * w2r[r4 * 4] + t4.y * w2r[r4 * 4 + 1] + t4.z * w2r[r4 * 4 + 2] + t4.w * w2r[r4 * 4 + 3]; }
            bcur -= (fmaxf(-z, 0.f) + __logf(1.0f + __expf(-fabsf(z)))) * 0.0625f; bb[tq] = bcur;
        }
        if (hh == 0) XCH[d] = bcur; else XCH[32 + d] = bcur;
        LDS_WAIT(); asm volatile("" ::: "memory");
        const float rr = XCH[d], blast = rr + XCH[32 + d];
#pragma unroll
        for (int tq = 0; tq < 32; ++tq) {
            const int tau = 32 * hh + tq;
            const float qv = bflo(qk[tq]) * 0.17677669529663687f, kv = bfhi(qk[tq]);
            const float ex = hh == 0 ? fminf(bb[tq] - rr, 80.f) : fmaxf(bb[tq], -80.f);
            const float e1 = __expf(ex), e2 = __builtin_amdgcn_rcpf(e1);
            QI[tau * DK + d] = (bf16)f2bf(qv * e1); KI[tau * DK + d] = (bf16)f2bf(kv * e2);
        }
        if (hh == 0) { FI[d] = __expf(rr); FI[DK + d] = __expf(blast - rr); FI[2 * DK + d] = __expf(blast); }
        LDS_WAIT(); asm volatile("" ::: "memory");
    }
}

template <int DK, bool HG, bool SPLIT>
__device__ __forceinline__ void chain_glahg(const KArgs& a, int l, int s, int h, int dir, int te0, LAS unsigned char* sm, int lane_in) {
    constexpr int NTE = SPLIT ? 1 : 2; const int co = SPLIT ? 32 * te0 : 0;
    int lane_o = lane_in; asm volatile("" : "+v"(lane_o));
    constexpr int NTD = DK / 32, KS = DK / 16;
    const SeqInfo si = seq_info(s);
    const bf16* PB = (const bf16*)(a.ws + WS_PB);
    bf16* OSC = (bf16*)(a.ws + WS_OSC) + (size_t)(dir * 3 + (HG ? 2 : 0)) * M * 256;
    LAS bf16* B0 = (LAS bf16*)sm; LAS bf16* B1 = (LAS bf16*)(sm + 8192); LAS bf16* VR0 = (LAS bf16*)(sm + 16384);
    LAS float* ER = (LAS float*)(sm + 32768); LAS float* EL = ER + DK; LAS float* EBL = ER + 2 * DK;
    f32x16 S[NTD][NTE];
    { const int lane = lane_o, r32 = lane & 31, hh = lane >> 5;
#pragma unroll
    for (int td = 0; td < NTD; ++td)
#pragma unroll
        for (int te = 0; te < NTE; ++te) {
            if (si.ctx) { S[td][te] = f32x16{}; }
            else {
                const float* st = (HG ? a.in[I_SHG] : a.in[I_SGLA]) + (size_t)((((si.b * NL + l) * 2 + dir) * 4 + h) * DK) * 64 + 32 * te + co + r32;
#pragma unroll
                for (int rg = 0; rg < 16; ++rg) S[td][te][rg] = st[(size_t)(32 * td + (rg & 3) + 8 * (rg >> 2) + 4 * hh) * 64];
            }
        }
    }
    const int NC = si.T / 64;
    constexpr int NQ = 64 * DK * 2 / 1024;
    v4u nq[NQ], nk[NQ]; float nf0, nf1, nf2;
#define GH_LOAD(cs_) do { const int tb_ = dir == 0 ? (cs_) : NC - 1 - (cs_); \
        const unsigned char* img_ = a.ws + (HG ? WS_HIMG : WS_GIMG) + (size_t)((blk_of(si, tb_) * 4 + h) * 2 + dir) * ScanImg<DK>::BYTES; \
        _Pragma("unroll") for (int i_ = 0; i_ < NQ; ++i_) { nq[i_] = *(const v4u*)(img_ + ScanImg<DK>::QB + (lane + 64 * i_) * 16); nk[i_] = *(const v4u*)(img_ + ScanImg<DK>::KB + (lane + 64 * i_) * 16); } \
        const int fl_ = lane < DK ? lane : 0; nf0 = *(const float*)(img_ + ScanImg<DK>::FB + fl_ * 4); nf1 = *(const float*)(img_ + ScanImg<DK>::FB + (DK + fl_) * 4); nf2 = *(const float*)(img_ + ScanImg<DK>::FB + (2 * DK + fl_) * 4); } while (0)
#define GH_VDMA(cs_) do { const int tb_ = dir == 0 ? (cs_) : NC - 1 - (cs_), t0_ = dir == 0 ? tb_ * 64 : tb_ * 64 + 63, ts_ = dir == 0 ? 1 : -1; \
        LAS unsigned char* vd_ = sm + 16384 + (((cs_) & 1) ? 8192 : 0); \
        _Pragma("unroll") for (int i_ = 0; i_ < 8; ++i_) { const int p_ = lane + 64 * i_; \
            __builtin_amdgcn_global_load_lds((const unsigned*)(PB + (size_t)(si.row0 + t0_ + ts_ * (p_ >> 3)) * NPB + (HG ? C_HGI : C_GAV) + h * 64 + 8 * ((p_ & 7) ^ ((p_ >> 3) & 7))), (LAS unsigned*)(vd_ + i_ * 1024), 16, 0, 0); } } while (0)
    { const int lane = lane_o; GH_LOAD(0); GH_VDMA(0); }
#pragma unroll 1
    for (int cs = 0; cs < NC; ++cs) {
        int lane_c = hw_lane(); asm volatile("" : "+v"(lane_c));
        const int lane = lane_c, r32 = lane & 31, hh = lane >> 5;
        const int tb = dir == 0 ? cs : NC - 1 - cs;
        const int t0 = dir == 0 ? tb * 64 : tb * 64 + 63, tstp = dir == 0 ? 1 : -1;
        {
#pragma unroll
            for (int i = 0; i < NQ; ++i) { const int p = lane + 64 * i, row = p / (DK / 8), c = p % (DK / 8); const int off = row * DK * 2 + ((c ^ img_sw(row, DK)) << 4);
                *(LAS v4u*)((LAS unsigned char*)B0 + off) = nq[i]; *(LAS v4u*)((LAS unsigned char*)B1 + off) = nk[i]; }
            if (lane < DK) { ER[lane] = nf0; EL[lane] = nf1; EBL[lane] = nf2; }
            asm volatile("s_waitcnt vmcnt(0)" ::: "memory");
            const int csn = cs + 1 < NC ? cs + 1 : cs; GH_LOAD(csn); if (cs + 1 < NC) GH_VDMA(cs + 1);
#ifdef PROBE_GH_NOPF
            asm volatile("s_waitcnt vmcnt(0)" ::: "memory");
#endif
        }
        LAS bf16* VR = (LAS bf16*)(sm + 16384 + ((cs & 1) ? 8192 : 0));
        LDS_WAIT(); asm volatile("" ::: "memory");
        if constexpr (SPLIT) {
        s16x8 pa00[2], pa01[2], pa11[2];
        s16x8 q0[KS], q1[KS];
        {
            s16x8 k0[KS], k1[KS];
#pragma unroll
            for (int ks = 0; ks < KS; ++ks) { q0[ks] = frag_a(B0, DK, r32, ks, hh); q1[ks] = frag_a(B0, DK, 32 + r32, ks, hh); k0[ks] = frag_a(B1, DK, r32, ks, hh); k1[ks] = frag_a(B1, DK, 32 + r32, ks, hh); }
#pragma unroll
            for (int ks = 0; ks < KS; ++ks) asm volatile("" : "+v"(q0[ks]), "+v"(q1[ks]), "+v"(k0[ks]), "+v"(k1[ks]));
            f32x16 x00 = f32x16{}, x01 = f32x16{}, x11 = f32x16{};
#pragma unroll
            for (int ks = 0; ks < KS; ++ks) {
                x00 = __builtin_amdgcn_mfma_f32_32x32x16_bf16(k0[ks], q0[ks], x00, 0, 0, 0);
                x01 = __builtin_amdgcn_mfma_f32_32x32x16_bf16(k0[ks], q1[ks], x01, 0, 0, 0);
                x11 = __builtin_amdgcn_mfma_f32_32x32x16_bf16(k1[ks], q1[ks], x11, 0, 0, 0);
            }
#pragma unroll
            for (int rg = 0; rg < 16; ++rg) { const int jr = (rg & 3) + 8 * (rg >> 2) + 4 * hh; if (jr > r32) { x00[rg] = 0.f; x11[rg] = 0.f; } }
#pragma unroll
            for (int s2 = 0; s2 < 2; ++s2) { pa00[s2] = pack_acc8(x00, s2, 1, 1, 1, 1, 1, 1, 1, 1); pa01[s2] = pack_acc8(x01, s2, 1, 1, 1, 1, 1, 1, 1, 1); pa11[s2] = pack_acc8(x11, s2, 1, 1, 1, 1, 1, 1, 1, 1); }
        }
        s16x8 sbp[NTD][2], vbf[4];
#pragma unroll
        for (int tk = 0; tk < 4; ++tk) vbf[tk] = frag_tr_sw(VR, 64, 16 * tk, co, lane);
#pragma unroll
        for (int td = 0; td < NTD; ++td)
#pragma unroll
            for (int s2 = 0; s2 < 2; ++s2) {
                const f32x4 e0 = *(const LAS f32x4*)(ER + 32 * td + 16 * s2 + 4 * hh), e1 = *(const LAS f32x4*)(ER + 32 * td + 16 * s2 + 8 + 4 * hh);
                sbp[td][s2] = pack_acc8(S[td][0], s2, e0.x, e0.y, e0.z, e0.w, e1.x, e1.y, e1.z, e1.w);
            }
#pragma unroll
        for (int tk = 0; tk < 4; ++tk) asm volatile("" : "+v"(vbf[tk]));
        {
            f32x16 Z0 = f32x16{}, Z1 = f32x16{};
#pragma unroll
            for (int td = 0; td < NTD; ++td)
#pragma unroll
                for (int s2 = 0; s2 < 2; ++s2) {
                    Z0 = __builtin_amdgcn_mfma_f32_32x32x16_bf16(sbp[td][s2], q0[2 * td + s2], Z0, 0, 0, 0);
                    Z1 = __builtin_amdgcn_mfma_f32_32x32x16_bf16(sbp[td][s2], q1[2 * td + s2], Z1, 0, 0, 0);
                }
#pragma unroll
            for (int s2 = 0; s2 < 2; ++s2) {
                Z0 = __builtin_amdgcn_mfma_f32_32x32x16_bf16(vbf[s2], pa00[s2], Z0, 0, 0, 0);
                Z1 = __builtin_amdgcn_mfma_f32_32x32x16_bf16(vbf[s2], pa01[s2], Z1, 0, 0, 0);
            }
#pragma unroll
            for (int s2 = 0; s2 < 2; ++s2) Z1 = __builtin_amdgcn_mfma_f32_32x32x16_bf16(vbf[2 + s2], pa11[s2], Z1, 0, 0, 0);
            bf16* orow0 = OSC + (size_t)(si.row0 + t0 + tstp * r32) * 256 + h * 64 + co + 4 * hh;
            bf16* orow1 = OSC + (size_t)(si.row0 + t0 + tstp * (32 + r32)) * 256 + h * 64 + co + 4 * hh;
#pragma unroll
            for (int g4 = 0; g4 < 4; ++g4) {
                v2u w; w.x = pk2(Z0[4 * g4], Z0[4 * g4 + 1]); w.y = pk2(Z0[4 * g4 + 2], Z0[4 * g4 + 3]); *(v2u*)(orow0 + 8 * g4) = w;
                v2u w1; w1.x = pk2(Z1[4 * g4], Z1[4 * g4 + 1]); w1.y = pk2(Z1[4 * g4 + 2], Z1[4 * g4 + 3]); *(v2u*)(orow1 + 8 * g4) = w1;
            }
        }
        {
            s16x8 kaf[NTD][4];
#pragma unroll
            for (int td = 0; td < NTD; ++td)
#pragma unroll
                for (int tk = 0; tk < 4; ++tk) kaf[td][tk] = frag_tr_sw(B1, DK, 16 * tk, 32 * td, lane);
#pragma unroll
            for (int td = 0; td < NTD; ++td)
#pragma unroll
                for (int tk = 0; tk < 4; ++tk) asm volatile("" : "+v"(kaf[td][tk]));
            f32x16 U[NTD];
#pragma unroll
            for (int td = 0; td < NTD; ++td) U[td] = f32x16{};
#pragma unroll
            for (int tk = 0; tk < 4; ++tk)
#pragma unroll
                for (int td = 0; td < NTD; ++td) U[td] = __builtin_amdgcn_mfma_f32_32x32x16_bf16(kaf[td][tk], vbf[tk], U[td], 0, 0, 0);
#pragma unroll
            for (int td = 0; td < NTD; ++td)
#pragma unroll
                for (int g4 = 0; g4 < 4; ++g4) {
                    const f32x4 fb = *(const LAS f32x4*)(EBL + 32 * td + 8 * g4 + 4 * hh), fl = *(const LAS f32x4*)(EL + 32 * td + 8 * g4 + 4 * hh);
#pragma unroll
                    for (int j = 0; j < 4; ++j) S[td][0][4 * g4 + j] = fb[j] * S[td][0][4 * g4 + j] + fl[j] * U[td][4 * g4 + j];
                }
        }
        } else {
        s16x8 pa00[2], pa01[2], pa11[2];
        {
            s16x8 qf[KS];
#pragma unroll
            for (int ks = 0; ks < KS; ++ks) qf[ks] = frag_a(B0, DK, r32, ks, hh);
            f32x16 x = f32x16{};
#pragma unroll
            for (int ks = 0; ks < KS; ++ks) { const s16x8 k0 = frag_a(B1, DK, r32, ks, hh); x = __builtin_amdgcn_mfma_f32_32x32x16_bf16(k0, qf[ks], x, 0, 0, 0); }
#pragma unroll
            for (int rg = 0; rg < 16; ++rg) { const int jr = (rg & 3) + 8 * (rg >> 2) + 4 * hh; if (jr > r32) x[rg] = 0.f; }
            pa00[0] = pack_acc8(x, 0, 1, 1, 1, 1, 1, 1, 1, 1); pa00[1] = pack_acc8(x, 1, 1, 1, 1, 1, 1, 1, 1, 1);
            asm volatile("" : "+v"(pa00[0]), "+v"(pa00[1]));
#pragma unroll
            for (int ks = 0; ks < KS; ++ks) qf[ks] = frag_a(B0, DK, 32 + r32, ks, hh);
            x = f32x16{};
#pragma unroll
            for (int ks = 0; ks < KS; ++ks) { const s16x8 k0 = frag_a(B1, DK, r32, ks, hh); x = __builtin_amdgcn_mfma_f32_32x32x16_bf16(k0, qf[ks], x, 0, 0, 0); }
            pa01[0] = pack_acc8(x, 0, 1, 1, 1, 1, 1, 1, 1, 1); pa01[1] = pack_acc8(x, 1, 1, 1, 1, 1, 1, 1, 1, 1);
            asm volatile("" : "+v"(pa01[0]), "+v"(pa01[1]));
            x = f32x16{};
#pragma unroll
            for (int ks = 0; ks < KS; ++ks) { const s16x8 k1 = frag_a(B1, DK, 32 + r32, ks, hh); x = __builtin_amdgcn_mfma_f32_32x32x16_bf16(k1, qf[ks], x, 0, 0, 0); }
#pragma unroll
            for (int rg = 0; rg < 16; ++rg) { const int jr = (rg & 3) + 8 * (rg >> 2) + 4 * hh; if (jr > r32) x[rg] = 0.f; }
            pa11[0] = pack_acc8(x, 0, 1, 1, 1, 1, 1, 1, 1, 1); pa11[1] = pack_acc8(x, 1, 1, 1, 1, 1, 1, 1, 1, 1);
            asm volatile("" : "+v"(pa11[0]), "+v"(pa11[1]));
        }
#pragma unroll
        for (int ti = 0; ti < 2; ++ti) {
            f32x16 Z[NTE];
#pragma unroll
            for (int te = 0; te < NTE; ++te) Z[te] = f32x16{};
#pragma unroll
            for (int td = 0; td < NTD; ++td)
#pragma unroll
                for (int s2 = 0; s2 < 2; ++s2) {
                    const f32x4 e0 = *(const LAS f32x4*)(ER + 32 * td + 16 * s2 + 4 * hh), e1 = *(const LAS f32x4*)(ER + 32 * td + 16 * s2 + 8 + 4 * hh);
                    const s16x8 qa = frag_a(B0, DK, 32 * ti + r32, 2 * td + s2, hh);
#pragma unroll
                    for (int te = 0; te < NTE; ++te) {
                        const s16x8 sb = pack_acc8(S[td][te], s2, e0.x, e0.y, e0.z, e0.w, e1.x, e1.y, e1.z, e1.w);
                        Z[te] = __builtin_amdgcn_mfma_f32_32x32x16_bf16(sb, qa, Z[te], 0, 0, 0);
                    }
                }
#pragma unroll
            for (int tj = 0; tj <= ti; ++tj)
#pragma unroll
                for (int s2 = 0; s2 < 2; ++s2) {
                    const s16x8 pa = (ti == 0) ? pa00[s2] : (tj == 0 ? pa01[s2] : pa11[s2]);
#pragma unroll
                    for (int te = 0; te < NTE; ++te) {
                        const s16x8 vb = frag_tr_sw(VR, 64, 32 * tj + 16 * s2, 32 * te + co, lane);
                        Z[te] = __builtin_amdgcn_mfma_f32_32x32x16_bf16(vb, pa, Z[te], 0, 0, 0);
                    }
                }
            {
                bf16* orow = OSC + (size_t)(si.row0 + t0 + tstp * (32 * ti + r32)) * 256 + h * 64 + co + 4 * hh;
#pragma unroll
                for (int te = 0; te < NTE; ++te)
#pragma unroll
                    for (int g4 = 0; g4 < 4; ++g4) { v2u w; w.x = pk2(Z[te][4 * g4], Z[te][4 * g4 + 1]); w.y = pk2(Z[te][4 * g4 + 2], Z[te][4 * g4 + 3]); *(v2u*)(orow + 32 * te + 8 * g4) = w; }
            }
        }
#pragma unroll
        for (int td = 0; td < NTD; ++td) {
            f32x16 U[NTE];
#pragma unroll
            for (int te = 0; te < NTE; ++te) U[te] = f32x16{};
#pragma unroll
            for (int tk = 0; tk < 4; ++tk) {
                const s16x8 ka = frag_tr_sw(B1, DK, 16 * tk, 32 * td, lane);
#pragma unroll
                for (int te = 0; te < NTE; ++te) {
                    const s16x8 vb = frag_tr_sw(VR, 64, 16 * tk, 32 * te + co, lane);
                    U[te] = __builtin_amdgcn_mfma_f32_32x32x16_bf16(ka, vb, U[te], 0, 0, 0);
                }
            }
#pragma unroll
            for (int rg = 0; rg < 16; ++rg) {
                const int dd = 32 * td + (rg & 3) + 8 * (rg >> 2) + 4 * hh;
                const float fb = EBL[dd], fl = EL[dd];
#pragma unroll
                for (int te = 0; te < NTE; ++te) S[td][te][rg] = fb * S[td][te][rg] + fl * U[te][rg];
            }
        }
        }
        LDS_WAIT(); asm volatile("" ::: "memory");
    }
#undef GH_LOAD
#undef GH_VDMA
    if (si.ctx) {
        int lf_ = hw_lane(); asm volatile("" : "+v"(lf_));
        const int lane = lf_, r32 = lane & 31, hh = lane >> 5;
        float* o = a.out + (HG ? O_SH : O_SG) + (size_t)((((si.b * NL + l) * 2 + dir) * 4 + h) * DK) * 64;
#pragma unroll
        for (int td = 0; td < NTD; ++td)
#pragma unroll
            for (int te = 0; te < NTE; ++te)
#pragma unroll
                for (int rg = 0; rg < 16; ++rg) o[(size_t)(32 * td + (rg & 3) + 8 * (rg >> 2) + 4 * hh) * 64 + 32 * te + co + r32] = S[td][te][rg];
    }
}

constexpr int DNI_TT = 0, DNI_PA = 2048, DNI_TB = 4096, DNI_BYTES = 4608;
__device__ __forceinline__ unsigned char* dn_img(const KArgs& a, int c32, int h, int dir) { return a.ws + (dir == 0 ? WS_DNI0 : WS_DNI1) + (size_t)(c32 * 4 + h) * DNI_BYTES; }
__device__ __forceinline__ void prep_dn(const KArgs& a, int l, int c32, int h, int dir, LAS unsigned char* sm, int lane_in) {
    int lane = lane_in; asm volatile("" : "+v"(lane));
    const int r32 = lane & 31, hh = lane >> 5;
    const bf16* PB = (const bf16*)(a.ws + WS_PB); const float* PF = (const float*)(a.ws + WS_PF);
    bf16* DQ = (bf16*)(a.ws + WS_DNT); bf16* DK_ = DQ + (size_t)M * 256; bf16* DV = DK_ + (size_t)M * 256;
    LAS bf16* QR = (LAS bf16*)sm; LAS bf16* KR = (LAS bf16*)(sm + 4096);
    LAS float* AD = (LAS float*)(sm + 8192);
    LAS float* DC = (LAS float*)(sm + 12288); LAS float* RQ = DC + 32; LAS float* RK = DC + 64; LAS float* BRK = DC + 96;
    unsigned char* img = dn_img(a, c32, h, dir);
    const int sb = c32 < 256 ? (c32 & ~7) : 256 + ((c32 - 256) & ~31), first = sb * 32, last = (c32 < 256 ? sb + 8 : sb + 32) * 32 - 1;
    const int tstp = dir == 0 ? 1 : -1, rowb = c32 * 32 + (dir == 0 ? 0 : 31);
    const float pf_b = PF[(size_t)(rowb + tstp * r32) * NPF + F_DNB + dir * 4 + h], pf_a = PF[(size_t)(rowb + tstp * r32) * NPF + F_DNA + dir * 4 + h];
    const float in_dt = a.in[I_DDT][(l * 2 + dir) * 4 + h], in_al = a.in[I_DALOG][(l * 2 + dir) * 4 + h];
    {
        const float* cw = a.in[I_DCONV] + (size_t)l * 3 * 768; const int cch = h * 64 + lane;
        const float q0 = cw[cch], q2 = cw[1536 + cch], k0 = cw[256 + cch], k2 = cw[1536 + 256 + cch], v0 = cw[512 + cch], v2 = cw[1536 + 512 + cch];
        const float wq1 = cw[768 + cch], wk1 = cw[768 + 256 + cch], wv1 = cw[768 + 512 + cch];
        const float wqa = dir == 0 ? q0 : q2, wqb = dir == 0 ? q2 : q0, wka = dir == 0 ? k0 : k2, wkb = dir == 0 ? k2 : k0, wva = dir == 0 ? v0 : v2, wvb = dir == 0 ? v2 : v0;
        const bf16* xb = PB + C_DNX + cch;
        unsigned xqk[34], xvv[34];
#pragma unroll
        for (int i = 0; i < 34; ++i) {
            const int row = rowb + tstp * (i - 1);
            if ((i > 0 && i < 33) || (row >= first && row <= last)) { const bf16* p = xb + (size_t)row * NPB; const unsigned lo = p[0], hi = p[256]; xqk[i] = lo | (hi << 16); xvv[i] = p[512]; }
            else { xqk[i] = 0u; xvv[i] = 0u; }
        }
#pragma unroll
        for (int tau = 0; tau < 32; ++tau) {
            const int row = rowb + tstp * tau;
            const float pq = bflo(xqk[tau]), pk = bfhi(xqk[tau]), pv = bflo(xvv[tau]), cq = bflo(xqk[tau + 1]), ck = bfhi(xqk[tau + 1]), cv = bflo(xvv[tau + 1]), nq = bflo(xqk[tau + 2]), nk = bfhi(xqk[tau + 2]), nv = bflo(xvv[tau + 2]);
            const float yq = pq * wqa + cq * wq1 + nq * wqb, yk = pk * wka + ck * wk1 + nk * wkb, yv = pv * wva + cv * wv1 + nv * wvb;
            const unsigned qb_ = f2bf(yq * fast_sig(yq)), kb_ = f2bf(yk * fast_sig(yk));
            { const int off = tau * 64 + (((lane >> 3) ^ (tau & 7)) << 3) + (lane & 7); QR[off] = (bf16)qb_; KR[off] = (bf16)kb_; }
            if (dir == 0) { const size_t o = (size_t)row * 256 + cch; DQ[o] = (bf16)qb_; DK_[o] = (bf16)kb_; DV[o] = (bf16)f2bf(yv * fast_sig(yv)); }
        }
    }
    LDS_WAIT(); asm volatile("" ::: "memory");
    float bt, dl;
    {
        const LAS bf16* rp = (hh == 0 ? QR : KR) + r32 * 64; float ss = 0.f;
#pragma unroll
        for (int c8 = 0; c8 < 8; ++c8) { const v4u w = *(const LAS v4u*)(rp + 8 * (c8 ^ (r32 & 7)));
            ss += bflo(w.x) * bflo(w.x) + bfhi(w.x) * bfhi(w.x) + bflo(w.y) * bflo(w.y) + bfhi(w.y) * bfhi(w.y) + bflo(w.z) * bflo(w.z) + bfhi(w.z) * bfhi(w.z) + bflo(w.w) * bflo(w.w) + bfhi(w.w) * bfhi(w.w); }
        const float rs = 1.0f / sqrtf(ss + 1e-6f);
        if (hh == 0) RQ[r32] = rs * 0.125f; else RK[r32] = rs;
        bt = fast_sig(pf_b);
        const float dtb = in_dt, aexp = expf(in_al);
        float d = -aexp * softplusf_(pf_a + dtb);
#pragma unroll
        for (int k = 1; k < 32; k <<= 1) { const float o = __builtin_bit_cast(float, __builtin_amdgcn_ds_bpermute((lane - k) << 2, __builtin_bit_cast(int, d))); if (r32 >= k) d += o; }
        dl = __builtin_bit_cast(float, __builtin_amdgcn_readlane(__builtin_bit_cast(int, d), 31));
        LDS_WAIT(); asm volatile("" ::: "memory");
        const float rq = RQ[r32], rk = RK[r32], ed = __expf(d);
        if (hh == 0) {
            DC[r32] = d; BRK[r32] = bt * rk;
            float* tb = (float*)(img + DNI_TB);
            tb[r32] = -ed * rk; tb[32 + r32] = rk * __expf(dl - d); tb[64 + r32] = rq * ed; if (r32 == 0) tb[96] = __expf(dl);
        }
    }
    LDS_WAIT(); asm volatile("" ::: "memory");
    {
        f32x16 xk = f32x16{}, xq = f32x16{};
#pragma unroll
        for (int ks = 0; ks < 4; ++ks) { const s16x8 kf = frag_a(KR, 64, r32, ks, hh), qf = frag_a(QR, 64, r32, ks, hh);
            xk = __builtin_amdgcn_mfma_f32_32x32x16_bf16(kf, kf, xk, 0, 0, 0); xq = __builtin_amdgcn_mfma_f32_32x32x16_bf16(kf, qf, xq, 0, 0, 0); }
        const float di = DC[r32], brki = BRK[r32], rqi = RQ[r32];
#pragma unroll
        for (int g4 = 0; g4 < 4; ++g4) {
            const f32x4 dm = *(const LAS f32x4*)(DC + 8 * g4 + 4 * hh), rkm = *(const LAS f32x4*)(RK + 8 * g4 + 4 * hh);
            f32x4 av;
#pragma unroll
            for (int j = 0; j < 4; ++j) {
                const int m = 8 * g4 + 4 * hh + j;
                const float Dv = (m <= r32) ? __expf(di - dm[j]) : 0.f;
                av[j] = (m < r32) ? brki * rkm[j] * xk[4 * g4 + j] * Dv : 0.f;
                xq[4 * g4 + j] = rqi * rkm[j] * xq[4 * g4 + j] * Dv;
            }
            *(LAS f32x4*)(AD + r32 * 32 + 8 * g4 + 4 * hh) = av;
        }
        const s16x8 p0 = pack_acc8(xq, 0, 1, 1, 1, 1, 1, 1, 1, 1), p1 = pack_acc8(xq, 1, 1, 1, 1, 1, 1, 1, 1, 1);
        *(s16x8*)(img + DNI_PA + lane * 16) = p0; *(s16x8*)(img + DNI_PA + 1024 + lane * 16) = p1;
    }
    LDS_WAIT(); asm volatile("" ::: "memory");
    {
        float t[32];
#pragma unroll
        for (int i = 0; i < 32; ++i) {
            float acc = (i == r32) ? 1.0f : 0.0f;
#pragma unroll
            for (int m4 = 0; m4 < (i + 3) / 4; ++m4) {
                const f32x4 a4 = *(const LAS f32x4*)(AD + i * 32 + 4 * m4);
                if (4 * m4 + 0 < i) acc -= a4.x * t[4 * m4 + 0];
                if (4 * m4 + 1 < i) acc -= a4.y * t[4 * m4 + 1];
                if (4 * m4 + 2 < i) acc -= a4.z * t[4 * m4 + 2];
                if (4 * m4 + 3 < i) acc -= a4.w * t[4 * m4 + 3];
            }
            t[i] = acc;
        }
        bf16* TT = (bf16*)(img + DNI_TT);
#pragma unroll
        for (int i = 0; i < 16; ++i) { const float v = (hh == 0 ? t[i] : t[16 + i]) * bt; TT[(16 * hh + i) * 32 + r32] = (bf16)f2bf(v); }
    }
    LDS_WAIT(); asm volatile("" ::: "memory");
}

constexpr int DN_LDS = 16384;
template <bool SPLIT>
__device__ __forceinline__ void chain_dn(const KArgs& a, int l, int s, int h, int dir, int te0, LAS unsigned char* sm, int lane_in) {
    constexpr int NTE = SPLIT ? 1 : 2; const int co = SPLIT ? 32 * te0 : 0;
    int lane_o = lane_in; asm volatile("" : "+v"(lane_o));
    const SeqInfo si = seq_info(s);
    const bf16* DQ = (const bf16*)(a.ws + WS_DNT); const bf16* DK_ = DQ + (size_t)M * 256; const bf16* DV = DK_ + (size_t)M * 256;
    bf16* OSC = (bf16*)(a.ws + WS_OSC) + (size_t)(dir * 3 + 1) * M * 256;
    LAS bf16* QR = (LAS bf16*)sm; LAS bf16* KR = (LAS bf16*)(sm + 4096);
    LAS bf16* TT = (LAS bf16*)(sm + 12288);
    LAS float* NBE = (LAS float*)(sm + 14336); LAS float* RKL = NBE + 32; LAS float* RQE = NBE + 64;
    f32x16 S[2][NTE];
    { const int lane = lane_o, r32 = lane & 31, hh = lane >> 5;
#pragma unroll
      for (int td = 0; td < 2; ++td)
#pragma unroll
        for (int te = 0; te < NTE; ++te) {
            if (si.ctx) { S[td][te] = f32x16{}; }
            else {
                const float* st = a.in[I_SDN] + (size_t)((((si.b * NL + l) * 2 + dir) * 4 + h) * 64) * 64 + 32 * te + co + r32;
#pragma unroll
                for (int rg = 0; rg < 16; ++rg) S[td][te][rg] = st[(size_t)(32 * td + (rg & 3) + 8 * (rg >> 2) + 4 * hh) * 64];
            }
        }
    }
    const int NC = si.T / 32;
    v4u nq[4], nk[4], nt[2]; s16x8 npa[2]; float nf0, nf1, nf2, nedl;
#define DN_LOAD(cs_) do { const int tb_ = dir == 0 ? (cs_) : NC - 1 - (cs_), c32_ = si.row0 / 32 + tb_, t0_ = dir == 0 ? tb_ * 32 : tb_ * 32 + 31, ts_ = dir == 0 ? 1 : -1; \
        const unsigned char* img_ = dn_img(a, c32_, h, dir); \
        _Pragma("unroll") for (int i_ = 0; i_ < 4; ++i_) { const int p_ = lane + 64 * i_; const size_t o_ = (size_t)(si.row0 + t0_ + ts_ * (p_ >> 3)) * 256 + h * 64 + 8 * (p_ & 7); \
            nq[i_] = *(const v4u*)(DQ + o_); nk[i_] = *(const v4u*)(DK_ + o_); } \
        nt[0] = *(const v4u*)(img_ + DNI_TT + lane * 16); nt[1] = *(const v4u*)(img_ + DNI_TT + 1024 + lane * 16); \
        npa[0] = *(const s16x8*)(img_ + DNI_PA + lane * 16); npa[1] = *(const s16x8*)(img_ + DNI_PA + 1024 + lane * 16); \
        const float* tb2_ = (const float*)(img_ + DNI_TB); nf0 = tb2_[lane & 31]; nf1 = tb2_[32 + (lane & 31)]; nf2 = tb2_[64 + (lane & 31)]; nedl = tb2_[96]; } while (0)
#define DN_VDMA(cs_) do { const int tb_ = dir == 0 ? (cs_) : NC - 1 - (cs_), t0_ = dir == 0 ? tb_ * 32 : tb_ * 32 + 31, ts_ = dir == 0 ? 1 : -1; \
        LAS unsigned char* vd_ = sm + (((cs_) & 1) ? 16384 : 8192); \
        _Pragma("unroll") for (int i_ = 0; i_ < 4; ++i_) { const int p_ = lane + 64 * i_; \
            __builtin_amdgcn_global_load_lds((const unsigned*)(DV + (size_t)(si.row0 + t0_ + ts_ * (p_ >> 3)) * 256 + h * 64 + 8 * ((p_ & 7) ^ ((p_ >> 3) & 7))), (LAS unsigned*)(vd_ + i_ * 1024), 16, 0, 0); } } while (0)
    { const int lane = lane_o; DN_LOAD(0); DN_VDMA(0); }
#pragma unroll 1
    for (int cs = 0; cs < NC; ++cs) {
        int lane_c = hw_lane(); asm volatile("" : "+v"(lane_c));
        const int lane = lane_c, r32 = lane & 31, hh = lane >> 5;
        const int tb = dir == 0 ? cs : NC - 1 - cs;
        const int t0 = dir == 0 ? tb * 32 : tb * 32 + 31, tstp = dir == 0 ? 1 : -1;
        s16x8 pa[2]; float edl;
        {
#pragma unroll
            for (int i = 0; i < 4; ++i) { const int p = lane + 64 * i, off = (p >> 3) * 128 + (((p & 7) ^ ((p >> 3) & 7)) << 4); *(LAS v4u*)((LAS unsigned char*)QR + off) = nq[i]; *(LAS v4u*)((LAS unsigned char*)KR + off) = nk[i]; }
            { const int row = lane >> 2, off = row * 64 + (((lane & 3) ^ ((row >> 1) & 3)) << 4); *(LAS v4u*)((LAS unsigned char*)TT + off) = nt[0]; *(LAS v4u*)((LAS unsigned char*)TT + 1024 + off) = nt[1]; }
            if (hh == 0) { NBE[r32] = nf0; RKL[r32] = nf1; RQE[r32] = nf2; }
            pa[0] = npa[0]; pa[1] = npa[1]; edl = nedl;
            asm volatile("s_waitcnt vmcnt(0)" ::: "memory");
            const int csn = cs + 1 < NC ? cs + 1 : cs; DN_LOAD(csn); if (cs + 1 < NC) DN_VDMA(cs + 1);
#ifdef PROBE_DN_NOPF
            asm volatile("s_waitcnt vmcnt(0)" ::: "memory");
#endif
        }
        LAS bf16* VR = (LAS bf16*)(sm + ((cs & 1) ? 16384 : 8192));
        LDS_WAIT(); asm volatile("" ::: "memory");
        if constexpr (SPLIT) {
        s16x8 kf[4], qf[4], tf[2], vfr[2];
#pragma unroll
        for (int ks = 0; ks < 4; ++ks) { kf[ks] = frag_a(KR, 64, r32, ks, hh); qf[ks] = frag_a(QR, 64, r32, ks, hh); }
#pragma unroll
        for (int s2 = 0; s2 < 2; ++s2) { tf[s2] = frag_a(TT, 32, r32, s2, hh); vfr[s2] = frag_tr_sw(VR, 64, 16 * s2, co, lane); }
#pragma unroll
        for (int ks = 0; ks < 4; ++ks) asm volatile("" : "+v"(kf[ks]), "+v"(qf[ks]));
#pragma unroll
        for (int s2 = 0; s2 < 2; ++s2) asm volatile("" : "+v"(tf[s2]), "+v"(vfr[s2]));
        s16x8 sb[4];
#pragma unroll
        for (int ks = 0; ks < 4; ++ks) sb[ks] = pack_acc8(S[ks >> 1][0], ks & 1, 1, 1, 1, 1, 1, 1, 1, 1);
        f32x16 ksa = f32x16{}, Z = f32x16{}, vn = f32x16{};
#pragma unroll
        for (int s2 = 0; s2 < 2; ++s2) vn = __builtin_amdgcn_mfma_f32_32x32x16_bf16(tf[s2], vfr[s2], vn, 0, 0, 0);
#pragma unroll
        for (int ks = 0; ks < 4; ++ks) {
            ksa = __builtin_amdgcn_mfma_f32_32x32x16_bf16(kf[ks], sb[ks], ksa, 0, 0, 0);
            Z = __builtin_amdgcn_mfma_f32_32x32x16_bf16(sb[ks], qf[ks], Z, 0, 0, 0);
        }
        s16x8 ka[2][2]; f32x4 nb[2][2], rkl[2][2];
#pragma unroll
        for (int s2 = 0; s2 < 2; ++s2) {
#pragma unroll
            for (int td = 0; td < 2; ++td) ka[s2][td] = frag_tr_sw(KR, 64, 16 * s2, 32 * td, lane);
            nb[s2][0] = *(const LAS f32x4*)(NBE + 16 * s2 + 4 * hh); nb[s2][1] = *(const LAS f32x4*)(NBE + 16 * s2 + 8 + 4 * hh);
            rkl[s2][0] = *(const LAS f32x4*)(RKL + 16 * s2 + 4 * hh); rkl[s2][1] = *(const LAS f32x4*)(RKL + 16 * s2 + 8 + 4 * hh);
        }
        const float rqe = RQE[r32];
#pragma unroll
        for (int s2 = 0; s2 < 2; ++s2) asm volatile("" : "+v"(ka[s2][0]), "+v"(ka[s2][1]));
#pragma unroll
        for (int s2 = 0; s2 < 2; ++s2) {
            const s16x8 ksf = pack_acc8(ksa, s2, nb[s2][0].x, nb[s2][0].y, nb[s2][0].z, nb[s2][0].w, nb[s2][1].x, nb[s2][1].y, nb[s2][1].z, nb[s2][1].w);
            vn = __builtin_amdgcn_mfma_f32_32x32x16_bf16(tf[s2], ksf, vn, 0, 0, 0);
        }
#pragma unroll
        for (int rg = 0; rg < 16; ++rg) Z[rg] *= rqe;
#pragma unroll
        for (int td = 0; td < 2; ++td)
#pragma unroll
            for (int rg = 0; rg < 16; ++rg) S[td][0][rg] *= edl;
        s16x8 b0[2], b0s[2];
#pragma unroll
        for (int s2 = 0; s2 < 2; ++s2) {
            b0[s2] = pack_acc8(vn, s2, 1, 1, 1, 1, 1, 1, 1, 1);
            b0s[s2] = pack_acc8(vn, s2, rkl[s2][0].x, rkl[s2][0].y, rkl[s2][0].z, rkl[s2][0].w, rkl[s2][1].x, rkl[s2][1].y, rkl[s2][1].z, rkl[s2][1].w);
        }
#pragma unroll
        for (int s2 = 0; s2 < 2; ++s2) {
            Z = __builtin_amdgcn_mfma_f32_32x32x16_bf16(b0[s2], pa[s2], Z, 0, 0, 0);
#pragma unroll
            for (int td = 0; td < 2; ++td) S[td][0] = __builtin_amdgcn_mfma_f32_32x32x16_bf16(ka[s2][td], b0s[s2], S[td][0], 0, 0, 0);
        }
        {
            bf16* orow = OSC + (size_t)(si.row0 + t0 + tstp * r32) * 256 + h * 64 + co + 4 * hh;
#pragma unroll
            for (int g4 = 0; g4 < 4; ++g4) { v2u w; w.x = pk2(Z[4 * g4], Z[4 * g4 + 1]); w.y = pk2(Z[4 * g4 + 2], Z[4 * g4 + 3]); *(v2u*)(orow + 8 * g4) = w; }
        }
        } else {
        s16x8 ksf[2][NTE]; f32x16 Z[NTE];
        {
            f32x16 ksa[NTE];
#pragma unroll
            for (int te = 0; te < NTE; ++te) { ksa[te] = f32x16{}; Z[te] = f32x16{}; }
#pragma unroll
            for (int ks = 0; ks < 4; ++ks) {
                const s16x8 kf = frag_a(KR, 64, r32, ks, hh), qf = frag_a(QR, 64, r32, ks, hh);
#pragma unroll
                for (int te = 0; te < NTE; ++te) {
                    const s16x8 sb = pack_acc8(S[ks >> 1][te], ks & 1, 1, 1, 1, 1, 1, 1, 1, 1);
                    ksa[te] = __builtin_amdgcn_mfma_f32_32x32x16_bf16(kf, sb, ksa[te], 0, 0, 0);
                    Z[te] = __builtin_amdgcn_mfma_f32_32x32x16_bf16(sb, qf, Z[te], 0, 0, 0);
                }
            }
#pragma unroll
            for (int s2 = 0; s2 < 2; ++s2) {
                const f32x4 n0 = *(const LAS f32x4*)(NBE + 16 * s2 + 4 * hh), n1 = *(const LAS f32x4*)(NBE + 16 * s2 + 8 + 4 * hh);
#pragma unroll
                for (int te = 0; te < NTE; ++te) ksf[s2][te] = pack_acc8(ksa[te], s2, n0.x, n0.y, n0.z, n0.w, n1.x, n1.y, n1.z, n1.w);
            }
            { const float f = RQE[r32];
#pragma unroll
              for (int te = 0; te < NTE; ++te)
#pragma unroll
                for (int rg = 0; rg < 16; ++rg) Z[te][rg] *= f; }
        }
        {
            f32x16 vn[NTE];
#pragma unroll
            for (int te = 0; te < NTE; ++te) vn[te] = f32x16{};
#pragma unroll
            for (int s2 = 0; s2 < 2; ++s2) {
                const s16x8 tf = frag_a(TT, 32, r32, s2, hh);
#pragma unroll
                for (int te = 0; te < NTE; ++te) {
                    const s16x8 v0 = frag_tr_sw(VR, 64, 16 * s2, 32 * te + co, lane);
                    vn[te] = __builtin_amdgcn_mfma_f32_32x32x16_bf16(tf, v0, vn[te], 0, 0, 0);
                    vn[te] = __builtin_amdgcn_mfma_f32_32x32x16_bf16(tf, ksf[s2][te], vn[te], 0, 0, 0);
                }
            }
#pragma unroll
            for (int s2 = 0; s2 < 2; ++s2)
#pragma unroll
                for (int te = 0; te < NTE; ++te) {
                    const s16x8 b0 = pack_acc8(vn[te], s2, 1, 1, 1, 1, 1, 1, 1, 1);
                    Z[te] = __builtin_amdgcn_mfma_f32_32x32x16_bf16(b0, pa[s2], Z[te], 0, 0, 0);
                }
            {
                bf16* orow = OSC + (size_t)(si.row0 + t0 + tstp * r32) * 256 + h * 64 + co + 4 * hh;
#pragma unroll
                for (int te = 0; te < NTE; ++te)
#pragma unroll
                    for (int g4 = 0; g4 < 4; ++g4) { v2u w; w.x = pk2(Z[te][4 * g4], Z[te][4 * g4 + 1]); w.y = pk2(Z[te][4 * g4 + 2], Z[te][4 * g4 + 3]); *(v2u*)(orow + 32 * te + 8 * g4) = w; }
            }
#pragma unroll
            for (int td = 0; td < 2; ++td)
#pragma unroll
                for (int te = 0; te < NTE; ++te)
#pragma unroll
                    for (int rg = 0; rg < 16; ++rg) S[td][te][rg] *= edl;
#pragma unroll
            for (int s2 = 0; s2 < 2; ++s2) {
                const f32x4 f0 = *(const LAS f32x4*)(RKL + 16 * s2 + 4 * hh), f1 = *(const LAS f32x4*)(RKL + 16 * s2 + 8 + 4 * hh);
#pragma unroll
                for (int te = 0; te < NTE; ++te) {
                    const s16x8 b0 = pack_acc8(vn[te], s2, f0.x, f0.y, f0.z, f0.w, f1.x, f1.y, f1.z, f1.w);
#pragma unroll
                    for (int td = 0; td < 2; ++td) {
                        const s16x8 ka = frag_tr_sw(KR, 64, 16 * s2, 32 * td, lane);
                        S[td][te] = __builtin_amdgcn_mfma_f32_32x32x16_bf16(ka, b0, S[td][te], 0, 0, 0);
                    }
                }
            }
        }
        }
        LDS_WAIT(); asm volatile("" ::: "memory");
    }
#undef DN_LOAD
#undef DN_VDMA
    if (si.ctx) {
        int lf_ = hw_lane(); asm volatile("" : "+v"(lf_));
        const int lane = lf_, r32 = lane & 31, hh = lane >> 5;
        float* o = a.out + O_SD + (size_t)((((si.b * NL + l) * 2 + dir) * 4 + h) * 64) * 64;
#pragma unroll
        for (int td = 0; td < 2; ++td)
#pragma unroll
            for (int te = 0; te < NTE; ++te)
#pragma unroll
                for (int rg = 0; rg < 16; ++rg) o[(size_t)(32 * td + (rg & 3) + 8 * (rg >> 2) + 4 * hh) * 64 + 32 * te + co + r32] = S[td][te][rg];
    }
}

typedef short v4i16_t __attribute__((ext_vector_type(4)));
__device__ __forceinline__ float bperm_xor32(float v, int lane) { return __builtin_bit_cast(float, __builtin_amdgcn_ds_bpermute(((lane ^ 32) << 2), __builtin_bit_cast(int, v))); }
__device__ __forceinline__ void attn_mfma(const KArgs& a, int l, int s, int h, int qb, LAS unsigned char* sm, int lane_in) {
    int lane = lane_in; asm volatile("" : "+v"(lane));
    const SeqInfo si = seq_info(s);
    const int r32 = lane & 31, hh = lane >> 5;
    const bf16* PB = (const bf16*)(a.ws + WS_PB);
    const bf16* KC = (const bf16*)(a.ws + WS_KVC) + (size_t)((si.b * 4 + h) * 512) * 64;
    const bf16* VC = KC + (size_t)2 * 4 * 512 * 64;
    LAS bf16* Vs = (LAS bf16*)sm;
    const int q0 = qb * 32;
    const float SC = 0.17677669529663687f * 1.4426950408889634f;
    s16x8 qf[2][2];
#pragma unroll
    for (int mp = 0; mp < 2; ++mp)
#pragma unroll
        for (int ks = 0; ks < 2; ++ks) {
            const v4u w = *(const v4u*)(PB + (size_t)(si.row0 + q0 + r32) * NPB + C_DFQ + h * 64 + mp * 32 + 16 * ks + 8 * hh);
            v4u o; o.x = pk2(bflo(w.x) * SC, bfhi(w.x) * SC); o.y = pk2(bflo(w.y) * SC, bfhi(w.y) * SC); o.z = pk2(bflo(w.z) * SC, bfhi(w.z) * SC); o.w = pk2(bflo(w.w) * SC, bfhi(w.w) * SC);
            qf[mp][ks] = __builtin_bit_cast(s16x8, o);
        }
    const float lam_init = 0.8f - 0.6f * expf(-0.3f * (float)l);
    const float lam = ((const float*)(a.ws + WS_LAM))[l];
    const int nt = si.ctx ? 8 : 48;
    auto krow = [&](int kt, int r) -> const bf16* {
        if (si.ctx) return PB + (size_t)(si.row0 + 32 * kt + r) * NPB + C_DFK + h * 64;
        if (kt < 16) return KC + (size_t)(32 * kt + r) * 64;
        return PB + (size_t)(si.row0 + 32 * (kt - 16) + r) * NPB + C_DFK + h * 64;
    };
    auto vrow = [&](int kt, int r) -> const bf16* {
        if (si.ctx) return PB + (size_t)(si.row0 + 32 * kt + r) * NPB + C_DFV + h * 64;
        if (kt < 16) return VC + (size_t)(32 * kt + r) * 64;
        return PB + (size_t)(si.row0 + 32 * (kt - 16) + r) * NPB + C_DFV + h * 64;
    };
#define LOADK(dst, kt) do { const bf16* kp_ = krow(kt, r32) + 8 * hh; dst[0][0] = *(const s16x8*)(kp_); dst[0][1] = *(const s16x8*)(kp_ + 16); dst[1][0] = *(const s16x8*)(kp_ + 32); dst[1][1] = *(const s16x8*)(kp_ + 48); } while (0)
    float m1 = -1e30f, l1 = 0.f, m2 = -1e30f, l2 = 0.f;
    {
        s16x8 kc[2][2], kn[2][2];
        LOADK(kc, 0);
#pragma unroll 1
        for (int kt = 0; kt < nt; ++kt) {
            { const int ktn = kt + 1 < nt ? kt + 1 : kt; LOADK(kn, ktn); }
            f32x16 x1 = f32x16{}, x2 = f32x16{};
            x1 = __builtin_amdgcn_mfma_f32_32x32x16_bf16(kc[0][0], qf[0][0], x1, 0, 0, 0); x1 = __builtin_amdgcn_mfma_f32_32x32x16_bf16(kc[0][1], qf[0][1], x1, 0, 0, 0);
            x2 = __builtin_amdgcn_mfma_f32_32x32x16_bf16(kc[1][0], qf[1][0], x2, 0, 0, 0); x2 = __builtin_amdgcn_mfma_f32_32x32x16_bf16(kc[1][1], qf[1][1], x2, 0, 0, 0);
            float t1 = x1[0], t2 = x2[0];
#pragma unroll
            for (int rg = 1; rg < 16; ++rg) { t1 = fmaxf(t1, x1[rg]); t2 = fmaxf(t2, x2[rg]); }
            const float n1 = fmaxf(m1, t1), n2 = fmaxf(m2, t2);
            float a1 = 0.f, a2 = 0.f;
#pragma unroll
            for (int rg = 0; rg < 16; ++rg) { a1 += __builtin_amdgcn_exp2f(x1[rg] - n1); a2 += __builtin_amdgcn_exp2f(x2[rg] - n2); }
            l1 = l1 * __builtin_amdgcn_exp2f(m1 - n1) + a1; l2 = l2 * __builtin_amdgcn_exp2f(m2 - n2) + a2; m1 = n1; m2 = n2;
#pragma unroll
            for (int i = 0; i < 2; ++i) { kc[i][0] = kn[i][0]; kc[i][1] = kn[i][1]; }
        }
    }
    { const float mo1 = bperm_xor32(m1, lane), lo1 = bperm_xor32(l1, lane), mo2 = bperm_xor32(m2, lane), lo2 = bperm_xor32(l2, lane);
      const float M1 = fmaxf(m1, mo1), M2 = fmaxf(m2, mo2);
      l1 = l1 * __builtin_amdgcn_exp2f(m1 - M1) + lo1 * __builtin_amdgcn_exp2f(mo1 - M1); l2 = l2 * __builtin_amdgcn_exp2f(m2 - M2) + lo2 * __builtin_amdgcn_exp2f(mo2 - M2); m1 = M1; m2 = M2; }
    const float c1 = 1.0f / l1, c2 = lam / l2;
    f32x16 O0 = f32x16{}, O1 = f32x16{};
    {
        s16x8 kc[2][2], kn[2][2]; v4u vc[4], vn[4];
#define LOADV(dst, kt) do { _Pragma("unroll") for (int i_ = 0; i_ < 4; ++i_) { const int p_ = lane + 64 * i_; dst[i_] = *(const v4u*)(vrow(kt, p_ >> 3) + 8 * (p_ & 7)); } } while (0)
        LOADK(kc, 0); LOADV(vc, 0);
        const int g16 = (lane >> 4) & 1, l16 = lane & 15;
        const int traddr = (4 * hh + (l16 >> 2)) * 128 + (16 * g16 + 4 * (l16 & 3)) * 2;
#pragma unroll 1
        for (int kt = 0; kt < nt; ++kt) {
            { const int ktn = kt + 1 < nt ? kt + 1 : kt; LOADK(kn, ktn); LOADV(vn, ktn); }
#pragma unroll
            for (int i = 0; i < 4; ++i) { const int p = lane + 64 * i; *(LAS v4u*)((LAS unsigned char*)Vs + (p >> 3) * 128 + (((p & 7) ^ ((p >> 3) & 7)) << 4)) = vc[i]; }
            f32x16 x1 = f32x16{}, x2 = f32x16{};
            x1 = __builtin_amdgcn_mfma_f32_32x32x16_bf16(kc[0][0], qf[0][0], x1, 0, 0, 0); x1 = __builtin_amdgcn_mfma_f32_32x32x16_bf16(kc[0][1], qf[0][1], x1, 0, 0, 0);
            x2 = __builtin_amdgcn_mfma_f32_32x32x16_bf16(kc[1][0], qf[1][0], x2, 0, 0, 0); x2 = __builtin_amdgcn_mfma_f32_32x32x16_bf16(kc[1][1], qf[1][1], x2, 0, 0, 0);
#pragma unroll
            for (int rg = 0; rg < 16; ++rg) x1[rg] = __builtin_amdgcn_exp2f(x1[rg] - m1) * c1 - __builtin_amdgcn_exp2f(x2[rg] - m2) * c2;
            const s16x8 pa0 = pack_acc8(x1, 0, 1, 1, 1, 1, 1, 1, 1, 1), pa1 = pack_acc8(x1, 1, 1, 1, 1, 1, 1, 1, 1, 1);
            LDS_WAIT(); asm volatile("" ::: "memory");
#pragma unroll
            for (int s2 = 0; s2 < 2; ++s2) {
#pragma unroll
                for (int te = 0; te < 2; ++te) {
                    const s16x8 vb = frag_tr_sw(Vs, 64, 16 * s2, 32 * te, lane);
                    if (te == 0) O0 = __builtin_amdgcn_mfma_f32_32x32x16_bf16(s2 == 0 ? pa0 : pa1, vb, O0, 0, 0, 0);
                    else O1 = __builtin_amdgcn_mfma_f32_32x32x16_bf16(s2 == 0 ? pa0 : pa1, vb, O1, 0, 0, 0);
                }
            }
#pragma unroll
            for (int i = 0; i < 2; ++i) { kc[i][0] = kn[i][0]; kc[i][1] = kn[i][1]; }
#pragma unroll
            for (int i = 0; i < 4; ++i) vc[i] = vn[i];
            LDS_WAIT(); asm volatile("" ::: "memory");
        }
    }
#undef LOADK
#undef LOADV
    const float* dnw = a.in[I_DFNORM] + (size_t)l * 64;
    const float w0 = dnw[r32], w1 = dnw[32 + r32];
    bf16* BR = (bf16*)(a.ws + WS_BR) + (size_t)3 * M * 256;
#pragma unroll
    for (int rg = 0; rg < 16; ++rg) {
        float ss = O0[rg] * O0[rg] + O1[rg] * O1[rg];
        ss += swz_xor<0x041F>(ss); ss += swz_xor<0x081F>(ss); ss += swz_xor<0x101F>(ss); ss += swz_xor<0x201F>(ss); ss += swz_xor<0x401F>(ss);
        const float rs = (1.0f / sqrtf(ss * (1.0f / 64.0f) + 1e-6f)) * (1.0f - lam_init);
        const int qi = (rg & 3) + 8 * (rg >> 2) + 4 * hh;
        bf16* op = BR + (size_t)(si.row0 + q0 + qi) * 256 + h * 64 + r32;
        op[0] = (bf16)f2bf(O0[rg] * rs * w0); op[32] = (bf16)f2bf(O1[rg] * rs * w1);
    }
}

constexpr size_t ATT_PO = 0, ATT_ML = (size_t)2048 * 4 * 2 * 2 * 64 * 4;
__device__ __forceinline__ void attn_split(const KArgs& a, int l, int s, int h, int qb, int kh, LAS unsigned char* sm, int lane_in) {
    int lane = lane_in; asm volatile("" : "+v"(lane));
    const SeqInfo si = seq_info(s);
    const int r32 = lane & 31, hh = lane >> 5;
    const bf16* PB = (const bf16*)(a.ws + WS_PB);
    const bf16* KC = (const bf16*)(a.ws + WS_KVC) + (size_t)((si.b * 4 + h) * 512) * 64;
    const bf16* VC = KC + (size_t)2 * 4 * 512 * 64;
    LAS bf16* Vs = (LAS bf16*)sm; LAS float* AL = (LAS float*)(sm + 4096);
    const int q0 = qb * 32;
    const float SC = 0.17677669529663687f * 1.4426950408889634f;
    s16x8 qf[2][2];
#pragma unroll
    for (int mp = 0; mp < 2; ++mp)
#pragma unroll
        for (int ks = 0; ks < 2; ++ks) {
            const v4u w = *(const v4u*)(PB + (size_t)(si.row0 + q0 + r32) * NPB + C_DFQ + h * 64 + mp * 32 + 16 * ks + 8 * hh);
            v4u o; o.x = pk2(bflo(w.x) * SC, bfhi(w.x) * SC); o.y = pk2(bflo(w.y) * SC, bfhi(w.y) * SC); o.z = pk2(bflo(w.z) * SC, bfhi(w.z) * SC); o.w = pk2(bflo(w.w) * SC, bfhi(w.w) * SC);
            qf[mp][ks] = __builtin_bit_cast(s16x8, o);
        }
    auto krow = [&](int kt, int r) -> const bf16* { if (kt < 16) return KC + (size_t)(32 * kt + r) * 64; return PB + (size_t)(si.row0 + 32 * (kt - 16) + r) * NPB + C_DFK + h * 64; };
    auto vrow = [&](int kt, int r) -> const bf16* { if (kt < 16) return VC + (size_t)(32 * kt + r) * 64; return PB + (size_t)(si.row0 + 32 * (kt - 16) + r) * NPB + C_DFV + h * 64; };
#define LOADK(dst, kt) do { const bf16* kp_ = krow(kt, r32) + 8 * hh; dst[0][0] = *(const s16x8*)(kp_); dst[0][1] = *(const s16x8*)(kp_ + 16); dst[1][0] = *(const s16x8*)(kp_ + 32); dst[1][1] = *(const s16x8*)(kp_ + 48); } while (0)
#define LOADV(dst, kt) do { _Pragma("unroll") for (int i_ = 0; i_ < 4; ++i_) { const int p_ = lane + 64 * i_; dst[i_] = *(const v4u*)(vrow(kt, p_ >> 3) + 8 * (p_ & 7)); } } while (0)
    float m1 = -1e30f, l1 = 0.f, m2 = -1e30f, l2 = 0.f;
    f32x16 O1a = f32x16{}, O1b = f32x16{}, O2a = f32x16{}, O2b = f32x16{};
    const int kt0 = 24 * kh;
    s16x8 kc[2][2], kn[2][2]; v4u vc[4], vn[4];
    LOADK(kc, kt0); LOADV(vc, kt0);
#pragma unroll 1
    for (int kt = kt0; kt < kt0 + 24; ++kt) {
        { const int ktn = kt + 1 < kt0 + 24 ? kt + 1 : kt; LOADK(kn, ktn); LOADV(vn, ktn); }
#pragma unroll
        for (int i = 0; i < 4; ++i) { const int p = lane + 64 * i; *(LAS v4u*)((LAS unsigned char*)Vs + (p >> 3) * 128 + (((p & 7) ^ ((p >> 3) & 7)) << 4)) = vc[i]; }
        f32x16 x1 = f32x16{}, x2 = f32x16{};
        x1 = __builtin_amdgcn_mfma_f32_32x32x16_bf16(kc[0][0], qf[0][0], x1, 0, 0, 0); x1 = __builtin_amdgcn_mfma_f32_32x32x16_bf16(kc[0][1], qf[0][1], x1, 0, 0, 0);
        x2 = __builtin_amdgcn_mfma_f32_32x32x16_bf16(kc[1][0], qf[1][0], x2, 0, 0, 0); x2 = __builtin_amdgcn_mfma_f32_32x32x16_bf16(kc[1][1], qf[1][1], x2, 0, 0, 0);
        float t1 = x1[0], t2 = x2[0];
#pragma unroll
        for (int rg = 1; rg < 16; ++rg) { t1 = fmaxf(t1, x1[rg]); t2 = fmaxf(t2, x2[rg]); }
        t1 = fmaxf(t1, bperm_xor32(t1, lane)); t2 = fmaxf(t2, bperm_xor32(t2, lane));
        const float n1 = fmaxf(m1, t1), n2 = fmaxf(m2, t2);
        if (__any((n1 > m1) || (n2 > m2))) {
            const float a1 = __builtin_amdgcn_exp2f(m1 - n1), a2 = __builtin_amdgcn_exp2f(m2 - n2);
            if (hh == 0) { AL[r32] = a1; AL[32 + r32] = a2; }
            l1 *= a1; l2 *= a2;
            LDS_WAIT(); asm volatile("" ::: "memory");
#pragma unroll
            for (int g4 = 0; g4 < 4; ++g4) {
                const f32x4 f1 = *(const LAS f32x4*)(AL + 8 * g4 + 4 * hh), f2 = *(const LAS f32x4*)(AL + 32 + 8 * g4 + 4 * hh);
#pragma unroll
                for (int j = 0; j < 4; ++j) { O1a[4 * g4 + j] *= f1[j]; O1b[4 * g4 + j] *= f1[j]; O2a[4 * g4 + j] *= f2[j]; O2b[4 * g4 + j] *= f2[j]; }
            }
        }
        m1 = n1; m2 = n2;
        float s1 = 0.f, s2 = 0.f;
#pragma unroll
        for (int rg = 0; rg < 16; ++rg) { x1[rg] = __builtin_amdgcn_exp2f(x1[rg] - n1); x2[rg] = __builtin_amdgcn_exp2f(x2[rg] - n2); s1 += x1[rg]; s2 += x2[rg]; }
        l1 += s1; l2 += s2;
        const s16x8 p10 = pack_acc8(x1, 0, 1, 1, 1, 1, 1, 1, 1, 1), p11 = pack_acc8(x1, 1, 1, 1, 1, 1, 1, 1, 1, 1), p20 = pack_acc8(x2, 0, 1, 1, 1, 1, 1, 1, 1, 1), p21 = pack_acc8(x2, 1, 1, 1, 1, 1, 1, 1, 1, 1);
        LDS_WAIT(); asm volatile("" ::: "memory");
#pragma unroll
        for (int s2_ = 0; s2_ < 2; ++s2_) {
            const s16x8 v0 = frag_tr_sw(Vs, 64, 16 * s2_, 0, lane), v1 = frag_tr_sw(Vs, 64, 16 * s2_, 32, lane);
            O1a = __builtin_amdgcn_mfma_f32_32x32x16_bf16(s2_ == 0 ? p10 : p11, v0, O1a, 0, 0, 0); O1b = __builtin_amdgcn_mfma_f32_32x32x16_bf16(s2_ == 0 ? p10 : p11, v1, O1b, 0, 0, 0);
            O2a = __builtin_amdgcn_mfma_f32_32x32x16_bf16(s2_ == 0 ? p20 : p21, v0, O2a, 0, 0, 0); O2b = __builtin_amdgcn_mfma_f32_32x32x16_bf16(s2_ == 0 ? p20 : p21, v1, O2b, 0, 0, 0);
        }
#pragma unroll
        for (int i = 0; i < 2; ++i) { kc[i][0] = kn[i][0]; kc[i][1] = kn[i][1]; }
#pragma unroll
        for (int i = 0; i < 4; ++i) vc[i] = vn[i];
        LDS_WAIT(); asm volatile("" ::: "memory");
    }
#undef LOADK
#undef LOADV
    l1 += bperm_xor32(l1, lane); l2 += bperm_xor32(l2, lane);
    const int srow0 = si.b * 1024 + q0;
    float* PO = (float*)(a.ws + WS_PF + ATT_PO); float* ML = (float*)(a.ws + WS_PF + ATT_ML);
    if (hh == 0) { float* p = ML + (size_t)(((srow0 + r32) * 4 + h) * 2 + kh) * 4; p[0] = m1; p[1] = l1; p[2] = m2; p[3] = l2; }
#pragma unroll
    for (int rg = 0; rg < 16; ++rg) {
        const int qi = (rg & 3) + 8 * (rg >> 2) + 4 * hh;
        float* p = PO + (size_t)((((srow0 + qi) * 4 + h) * 2 + kh) * 2) * 64 + r32;
        p[0] = O1a[rg]; p[32] = O1b[rg]; p[64] = O2a[rg]; p[96] = O2b[rg];
    }
}
__device__ __forceinline__ float attn_lambda(const KArgs& a, int l) { return ((const float*)(a.ws + WS_LAM))[l]; }
__device__ __forceinline__ void attn_merge(const KArgs& a, int l, int it, int lane, float lam) {
    const int srow = it >> 2, h = it & 3;
    const float* PO = (const float*)(a.ws + WS_PF + ATT_PO) + (size_t)((srow * 4 + h) * 2) * 2 * 64; const float* ML = (const float*)(a.ws + WS_PF + ATT_ML) + (size_t)((srow * 4 + h) * 2) * 4;
    const float lam_init = 0.8f - 0.6f * expf(-0.3f * (float)l);
    const float m1a = ML[0], l1a = ML[1], m2a = ML[2], l2a = ML[3], m1b = ML[4], l1b = ML[5], m2b = ML[6], l2b = ML[7];
    const float M1 = fmaxf(m1a, m1b), M2 = fmaxf(m2a, m2b);
    const float w1a = __builtin_amdgcn_exp2f(m1a - M1), w1b = __builtin_amdgcn_exp2f(m1b - M1), w2a = __builtin_amdgcn_exp2f(m2a - M2), w2b = __builtin_amdgcn_exp2f(m2b - M2);
    const float L1 = l1a * w1a + l1b * w1b, L2 = l2a * w2a + l2b * w2b;
    const float o1 = (PO[lane] * w1a + PO[128 + lane] * w1b) / L1, o2 = (PO[64 + lane] * w2a + PO[192 + lane] * w2b) / L2;
    const float o = o1 - lam * o2;
    const float ms = wave_sum(o * o) * (1.0f / 64.0f);
    const float out = o * (1.0f / sqrtf(ms + 1e-6f)) * a.in[I_DFNORM][(size_t)l * 64 + lane] * (1.0f - lam_init);
    bf16* BR = (bf16*)(a.ws + WS_BR) + (size_t)3 * M * 256;
    BR[(size_t)(MP + srow) * 256 + h * 64 + lane] = (bf16)f2bf(out);
}

__device__ __forceinline__ void fin_phase(const KArgs& a, int l, int gw, int lane) {
    const bf16* PB = (const bf16*)(a.ws + WS_PB);
    const bf16* OSC = (const bf16*)(a.ws + WS_OSC);
    bf16* BR = (bf16*)(a.ws + WS_BR);
    const int hf = lane >> 5, l32 = lane & 31;
    v4u wf[8], wb[8], wg[8];
#pragma unroll
    for (int q = 0; q < 8; ++q) {
        const int p0 = gw + q * 256 * NWAVES, p = p0 < 3 * (M / 2) ? p0 : 3 * (M / 2) - 1, m = p / (M / 2), row = 2 * (p - m * (M / 2)) + hf;
        wf[q] = *(const v4u*)(OSC + ((size_t)m * M + row) * 256 + l32 * 8); wb[q] = *(const v4u*)(OSC + ((size_t)(3 + m) * M + row) * 256 + l32 * 8);
        const int gcol = (m == 0 ? C_GAR : (m == 1 ? C_DNG : C_HGG)) + l32 * 8;
        wg[q] = *(const v4u*)(PB + (size_t)row * NPB + gcol);
    }
    const float lam = attn_lambda(a, l);
#pragma unroll
    for (int q = 0; q < 4; ++q) attn_merge(a, l, gw + q * 256 * NWAVES, lane, lam);
#pragma unroll
    for (int q = 0; q < 8; ++q) {
        const int p0 = gw + q * 256 * NWAVES, p = p0 < 3 * (M / 2) ? p0 : 3 * (M / 2) - 1, m = p / (M / 2), row = 2 * (p - m * (M / 2)) + hf;
        const float* nw = (m == 0 ? a.in[I_GNORM] : (m == 1 ? a.in[I_DNORM] : a.in[I_HNORM])) + l * 64 + (lane & 7) * 8;
        const f32x4 n0 = *(const f32x4*)nw, n1 = *(const f32x4*)(nw + 4);
        float o[8];
        o[0] = bflo(wf[q].x) + bflo(wb[q].x); o[1] = bfhi(wf[q].x) + bfhi(wb[q].x); o[2] = bflo(wf[q].y) + bflo(wb[q].y); o[3] = bfhi(wf[q].y) + bfhi(wb[q].y);
        o[4] = bflo(wf[q].z) + bflo(wb[q].z); o[5] = bfhi(wf[q].z) + bfhi(wb[q].z); o[6] = bflo(wf[q].w) + bflo(wb[q].w); o[7] = bfhi(wf[q].w) + bfhi(wb[q].w);
        float ss = ((o[0] * o[0] + o[1] * o[1]) + (o[2] * o[2] + o[3] * o[3])) + ((o[4] * o[4] + o[5] * o[5]) + (o[6] * o[6] + o[7] * o[7]));
        ss += swz_xor<0x041F>(ss); ss += swz_xor<0x081F>(ss); ss += swz_xor<0x101F>(ss);
        const float rs = 1.0f / sqrtf(ss * (1.0f / 64.0f) + 1e-6f);
        float g[8];
        g[0] = bflo(wg[q].x); g[1] = bfhi(wg[q].x); g[2] = bflo(wg[q].y); g[3] = bfhi(wg[q].y); g[4] = bflo(wg[q].z); g[5] = bfhi(wg[q].z); g[6] = bflo(wg[q].w); g[7] = bfhi(wg[q].w);
        v4u w;
        w.x = pk2(o[0] * rs * n0.x * g[0] * fast_sig(g[0]), o[1] * rs * n0.y * g[1] * fast_sig(g[1])); w.y = pk2(o[2] * rs * n0.z * g[2] * fast_sig(g[2]), o[3] * rs * n0.w * g[3] * fast_sig(g[3]));
        w.z = pk2(o[4] * rs * n1.x * g[4] * fast_sig(g[4]), o[5] * rs * n1.y * g[5] * fast_sig(g[5])); w.w = pk2(o[6] * rs * n1.z * g[6] * fast_sig(g[6]), o[7] * rs * n1.w * g[7] * fast_sig(g[7]));
        if (p0 < 3 * (M / 2)) *(v4u*)(BR + ((size_t)m * M + row) * 256 + l32 * 8) = w;
    }
}
__device__ __forceinline__ void prep_phase(const KArgs& a, int l, LAS unsigned char* lds, int gw, int wave, int lane_) {
    LAS unsigned char* smb = lds + wave * SCAN_LDS;
    for (int it = gw; it < 5120; it += 256 * NWAVES) {
#ifdef DBL_PHG
#define REP_PHG for (int rep_ = 0; rep_ < 2; ++rep_)
#else
#define REP_PHG
#endif
#ifdef DBL_PDN
#define REP_PDN for (int rep_ = 0; rep_ < 2; ++rep_)
#else
#define REP_PDN
#endif
#ifdef DBL_PGLA
#define REP_PGLA for (int rep_ = 0; rep_ < 2; ++rep_)
#else
#define REP_PGLA
#endif
        if (it < 1280) { const int g = it; REP_PHG { int lane = hw_lane(); asm volatile("" : "+v"(lane)); prep_glahg<64, true>(a, l, g >> 3, (g >> 1) & 3, g & 1, smb, lane); } }
        else if (it < 3840) { const int g = it - 1280; REP_PDN { int lane = hw_lane(); asm volatile("" : "+v"(lane)); prep_dn(a, l, g >> 3, (g >> 1) & 3, g & 1, smb, lane); } }
        else { const int g = it - 3840; REP_PGLA { int lane = hw_lane(); asm volatile("" : "+v"(lane)); prep_glahg<32, false>(a, l, g >> 3, (g >> 1) & 3, g & 1, smb, lane); } }
    }
}
#define LANE_ int lane = hw_lane(); asm volatile("" : "+v"(lane));
#ifdef DBL_DN
#define CALL_DN(SP, te) { LANE_ chain_dn<SP>(a, l, s, h, dir, te, smb, lane); } { LANE_ chain_dn<SP>(a, l, s, h, dir, te, smb, lane); }
#else
#define CALL_DN(SP, te) { LANE_ chain_dn<SP>(a, l, s, h, dir, te, smb, lane); }
#endif
#ifdef DBL_HG
#define CALL_HG(SP, te) { LANE_ chain_glahg<64, true, SP>(a, l, s, h, dir, te, smb, lane); } { LANE_ chain_glahg<64, true, SP>(a, l, s, h, dir, te, smb, lane); }
#else
#define CALL_HG(SP, te) { LANE_ chain_glahg<64, true, SP>(a, l, s, h, dir, te, smb, lane); }
#endif
#ifdef DBL_GLA
#define CALL_GLA(SP, te) { LANE_ chain_glahg<32, false, SP>(a, l, s, h, dir, te, smb, lane); } { LANE_ chain_glahg<32, false, SP>(a, l, s, h, dir, te, smb, lane); }
#else
#define CALL_GLA(SP, te) { LANE_ chain_glahg<32, false, SP>(a, l, s, h, dir, te, smb, lane); }
#endif
#ifdef DBL_ATT
#define CALL_ATT { int lane = hw_lane(); asm volatile("" : "+v"(lane)); attn_mfma(a, l, s, h, qb, smb, lane); } { int lane = hw_lane(); asm volatile("" : "+v"(lane)); attn_mfma(a, l, s, h, qb, smb, lane); }
#else
#define CALL_ATT { int lane = hw_lane(); asm volatile("" : "+v"(lane)); attn_mfma(a, l, s, h, qb, smb, lane); }
#endif
__device__ __forceinline__ void mix_phase(const KArgs& a, int l, LAS unsigned char* lds, int wave, int lane_) {
    const int ew = wave >> 1;
    if ((wave & 1) == 0) {
        LAS unsigned char* smb = lds + ew * 38912;
        const int bxs = (int)blockIdx.x;
        const int it = ew < 2 ? ew * 256 + bxs : (ew == 2 ? (bxs < 96 ? 100000 : 512 + bxs - 96) : 672 + bxs);
#ifdef DBL_LAT
#define REP_LAT for (int rep_ = 0; rep_ < 2; ++rep_)
#else
#define REP_LAT
#endif
#ifdef DBL_CTX
#define REP_CTX for (int rep_ = 0; rep_ < 2; ++rep_)
#else
#define REP_CTX
#endif
#ifdef DBL_LDN
#define REP_LDN for (int rep2_ = 0; rep2_ < 2; ++rep2_)
#else
#define REP_LDN
#endif
#ifdef DBL_LGLA
#define REP_LGLA for (int rep2_ = 0; rep2_ < 2; ++rep2_)
#else
#define REP_LGLA
#endif
#ifdef DBL_LHG
#define REP_LHG for (int rep2_ = 0; rep2_ < 2; ++rep2_)
#else
#define REP_LHG
#endif
        if (it < 32) { const int r = it >> 1, te = it & 1, s = 32 + r / 8, h = (r % 8) / 2, dir = r & 1; REP_LDN REP_LAT CALL_DN(true, te) }
        else if (it < 96) { const int r = (it - 32) >> 1, te = it & 1, mx = r / 16, q = r % 16, s = 32 + q / 8, h = (q % 8) / 2, dir = q & 1; if (mx == 0) { REP_LGLA REP_LAT CALL_GLA(true, te) } else { REP_LHG REP_LAT CALL_HG(true, te) } }
        else if (it < 352) { const int r = it - 96, s = r / 8, h = (r % 8) / 2, dir = r & 1; REP_CTX CALL_DN(false, 0) }
        else if (it < 864) { const int r = it - 352, mx = r / 256, q = r % 256, s = q / 8, h = (q % 8) / 2, dir = q & 1; if (mx == 0) { REP_CTX CALL_GLA(false, 0) } else { REP_CTX CALL_HG(false, 0) } }
    } else {
        LAS unsigned char* smb = lds + ew * 38912 + 34304;
        for (int it = ew * 256 + (int)blockIdx.x; it < 1536; it += 1024) {
            if (it < 512) { const int r = it >> 1, kh = it & 1, s = 32 + r / 128, h = (r % 128) / 32, qb = r % 32; { int lane = hw_lane(); asm volatile("" : "+v"(lane)); attn_split(a, l, s, h, qb, kh, smb, lane); }
#ifdef DBL_ATL
 { int lane = hw_lane(); asm volatile("" : "+v"(lane)); attn_split(a, l, s, h, qb, kh, smb, lane); }
#endif
 }
            else { const int r = it - 512, s = r / 32, h = (r % 32) / 8, qb = r % 8; CALL_ATT }
        }
    }
}

__global__ void diag_scale(float* out, unsigned mask) {
    const size_t offs[8] = {0, 8388608, O_DK, O_DV, O_SG, O_SD, O_SH, O_END};
    for (int k = 0; k < 7; ++k) if (mask & (1u << k)) {
        for (size_t i = offs[k] + blockIdx.x * (size_t)blockDim.x + threadIdx.x; i < offs[k + 1]; i += (size_t)gridDim.x * blockDim.x) out[i] *= 1.3f;
    }
}


template <int ph>
__device__ __forceinline__ void run_phase(LAS unsigned char* lds, int wv) {
        int tid_ = wv * 64 + hw_lane(); asm volatile("" : "+v"(tid_));
        const int tid = tid_, lane = tid & 63, wave = __builtin_amdgcn_readfirstlane(tid >> 6);
        int bx_ = blockIdx.x; asm volatile("" : "+s"(bx_));
        const int G = gridDim.x, bx = bx_;
        const int vcu = (G % 8 == 0) ? (bx % 8) * (G / 8) + bx / 8 : bx;
        const int gw = vcu * NWAVES + wave;
        const KArgs* ap_ = (const KArgs*)__builtin_amdgcn_kernarg_segment_ptr(); asm volatile("" : "+s"(ap_));
        const KArgs& a = *ap_;
        bf16* Wb = (bf16*)(a.ws + WS_W);
        float* X = a.out + O_Y;
        const float* modf = (const float*)(a.ws + WS_MODF);
        if constexpr (ph == 0) {
#ifndef NO_PRO
 pro_phase(a, 0, lds, gw, wave, lane);
#ifdef DBL_PRO
 __syncthreads(); pro_phase(a, 0, lds, gw, wave, lane);
#endif
#endif
 }
        else if constexpr (ph == NPHASE - 1) { final_phase(a, gw, lane); }
        else {
            constexpr int l = ph < 12 ? 0 : 1, q_ = ph < 12 ? ph - 1 : ph - 11, p = q_ < 3 ? q_ : (q_ < 9 ? q_ + 1 : q_ + 2);
            constexpr int cbc = l * 3 + (p == 1 ? 0 : p == 4 ? 1 : 2) - 1;
            constexpr int cbp = l * 3 + (p == 2 ? 0 : p == 9 ? 1 : 2);
            const float* SSb = (const float*)(a.ws + WS_SSP); const float* BIb = (const float*)(a.ws + WS_BIAS); const float* CSb = (const float*)(a.ws + WS_CSV);
            constexpr bool first = (l == 0);
            if constexpr (p == 0) { norm_phase(a, l, 0, lds, gw, tid, lane, first ? a.in[I_XP] : X, first ? a.in[I_XS] : X + (size_t)MP * D);
#ifdef DBL_NORM
 __syncthreads(); norm_phase(a, l, 0, lds, gw, tid, lane, first ? a.in[I_XP] : X, first ? a.in[I_XS] : X + (size_t)MP * D);
#endif
 }
            else if constexpr (p == 1 || p == 11) {
                constexpr bool fold = !(l == 0 && p == 1);
                pg8::Gemm g{(const pg8::bf16_t*)(a.ws + (p == 1 ? WS_H : WS_BR)), (const pg8::bf16_t*)((char*)Wb + (p == 1 ? W_1A : W_2A)), M, 2 * FF, D};
                pg8::StaticOrder S; S.init(M, 2 * FF, G, bx);
                pg8::EpiSwigluT<fold> E{(pg8::bf16_t*)(a.ws + WS_ACT), FF, SSb + (size_t)(fold ? cbc : 0) * M * 4, BIb + (size_t)(fold ? cbc : 0) * 3 * 8192};

#ifndef NO_G1
pg8::gemm_phase<pg8::EpiSwigluT<fold>, pg8::StaticOrder, PG8_ALIGN, PG8_SP2, 1024>(lds + RING_OFF, g, S, E, wv);
#endif
#ifdef DBL_UP
                __syncthreads(); pg8::gemm_phase<pg8::EpiSwigluT<fold>, pg8::StaticOrder, PG8_ALIGN, PG8_SP2, 1024>(lds + RING_OFF, g, S, E, wv);
#endif
                if constexpr (l == 0) if (bx >= 112) {
                    __syncthreads();
                    bias_items(a, p == 1 ? 0 : BI2, p == 1 ? BI1 : BI4, bx - 112, 144, lds, wave, lane);
                    if constexpr (p == 1) { __syncthreads(); conv_items(a, 0, CI0, CI1, (bx - 112) * NWAVES + wave, 144 * NWAVES, lds, wave, lane); }
#ifdef DBL_BIAS
                    bias_items(a, p == 1 ? 0 : BI2, p == 1 ? BI2 : BI5, bx - 112, 144, lds, wave, lane, WS_OSC - WS_BIAS);
#endif
                }

            }
            else if constexpr (p == 2 || p == 12) {
                pg8::Gemm g{(const pg8::bf16_t*)(a.ws + WS_ACT), (const pg8::bf16_t*)((char*)Wb + (p == 2 ? W_1B : W_2B)), M, D, FF};
                pg8::StaticOrder S; S.init(M, D, G, bx, 5);
                constexpr bool nxt = true, lastr = (l == NL - 1 && p == 12);
                constexpr bool FI_ = first && p == 2;
                typedef pg8::EpiResidT<nxt, true, FI_, lastr> EpiR;
                EpiR E{a.in[I_XP], a.in[I_XS], (pg8::bf16_t*)X, (float*)(a.ws + WS_XF), modf + (size_t)l * 3 * 9216 + (p == 2 ? 2 : 8) * 1024,
                                      CSb + (size_t)(nxt ? cbp + 1 : 0) * 3 * 1024, (pg8::bf16_t*)(a.ws + WS_H), (LAS float*)(lds + LRED_OFF)};

#ifndef NO_G2
pg8::gemm_phase<EpiR, pg8::StaticOrder, PG8_ALIGN, PG8_SP2>(lds + RING_OFF, g, S, E, wv);
#endif
#ifdef DBL_DOWN0
                if constexpr (l == 0 && p == 2) { __syncthreads(); pg8::gemm_phase<EpiR, pg8::StaticOrder, PG8_ALIGN, PG8_SP2>(lds + RING_OFF, g, S, E, wv); }
#endif
                if constexpr (nxt) { __syncthreads();
                    pg8::Unit u_; if (S.next(0, u_) && tid < 256) { const LAS float* lr = (const LAS float*)(lds + LRED_OFF) + tid; float s_ = 0.f;
#pragma unroll
                        for (int q = 0; q < 8; ++q) s_ += lr[q * 256];
                        ((float*)SSb)[((size_t)cbp * M + u_.pm * 256 + tid) * 4 + u_.pn] = s_; } }
                if (bx >= 160) {
                    if constexpr (p == 2) conv_items(a, l, CI1, CI5, (bx - 160) * NWAVES + wave, 96 * NWAVES, lds, wave, lane);
                    if constexpr (p == 2 && l == 0) mod_items(a, 288, 576, (bx - 160) * NWAVES + wave, 96 * NWAVES, lds, wave, lane);
                    if constexpr (p == 2 && l == 1) { __syncthreads(); bias_items(a, BI4, BI5, bx - 160, 96, lds, wave, lane); }
                    if constexpr (p == 2 && l == 0) { __syncthreads(); bias_items(a, BI1, BI2, bx - 160, 96, lds, wave, lane); }
#ifdef DBL_SIDE
                    if constexpr (p == 2) conv_items(a, l, CI1, CI5, (bx - 160) * NWAVES + wave, 96 * NWAVES, lds, wave, lane);
#endif
                    else if constexpr (l == 0) { conv_items(a, 1, 0, CI1, (bx - 160) * NWAVES + wave, 96 * NWAVES, lds, wave, lane); conv_cache(a, 1, (bx - 160) * NWAVES + wave, 96 * NWAVES, lane); }
                }

            }
            else if constexpr (p == 4) {
                pg8::Gemm g{(const pg8::bf16_t*)(a.ws + WS_H), (const pg8::bf16_t*)((char*)Wb + W_IN), M, 8192, D};
                pg8::StaticOrder S; S.init(M, 8192, G, bx);
                pg8::EpiInproj E{(pg8::bf16_t*)(a.ws + WS_PB), (float*)(a.ws + WS_PF), (pg8::bf16_t*)(a.ws + WS_GATE), a.out + O_DK, a.out + O_DV, l, (const float*)(a.ws + WS_ROPE), SSb + (size_t)cbc * M * 4, BIb + (size_t)cbc * 3 * 8192};

#ifndef NO_G3
pg8::gemm_phase<pg8::EpiInproj, pg8::StaticOrder, PG8_ALIGN, PG8_SP2, 1024>(lds + RING_OFF, g, S, E, wv);
#endif
#ifdef DBL_INPROJ
                __syncthreads(); pg8::gemm_phase<pg8::EpiInproj, pg8::StaticOrder, PG8_ALIGN, PG8_SP2, 1024>(lds + RING_OFF, g, S, E, wv);
#endif

            }
            else if constexpr (p == 5) { prep_phase(a, l, lds, gw, wave, lane);
#ifdef DBL_PREP
                __syncthreads(); prep_phase(a, l, lds, gw, wave, lane);
#endif
            }
            else if constexpr (p == 6) { mix_phase(a, l, lds, wave, lane);
#ifdef DBL_MIX
                __syncthreads(); mix_phase(a, l, lds, wave, lane);
#endif
            }
            else if constexpr (p == 7) { fin_phase(a, l, gw, lane);
#ifdef DBL_NORM
 fin_phase(a, l, gw, lane);
#endif
 }
            else if constexpr (p == 8) {
                pg8::Gemm g{(const pg8::bf16_t*)(a.ws + WS_BR), (const pg8::bf16_t*)((char*)Wb + W_BR), 4 * M, 4096, 256};
                pg8::MergeOrder S{vcu};
                pg8::EpiMerge E{(const pg8::bf16_t*)(a.ws + WS_GATE), (pg8::bf16_t*)(a.ws + WS_PART), (pg8::bf16_t*)(a.ws + WS_H)};

#ifndef NO_G4
pg8::gemm_phase<pg8::EpiMerge, pg8::MergeOrder, PG8_ALIGN, PG8_SP2, 256>(lds + RING_OFF, g, S, E, wv);
#endif
#ifdef DBL_MERGE
                __syncthreads(); pg8::gemm_phase<pg8::EpiMerge, pg8::MergeOrder, PG8_ALIGN, PG8_SP2, 256>(lds + RING_OFF, g, S, E, wv);
#endif
                if (vcu >= 160) conv_items(a, l, CI5, CI6, (vcu - 160) * NWAVES + wave, 96 * NWAVES, lds, wave, lane);
                if constexpr (l == 0) { if (vcu >= 160) mod_consolidate(a, 1, (vcu - 160) * NWAVES + wave, 96 * NWAVES, lane); }
#ifdef DBL_SIDE2
                if (vcu >= 160) conv_items(a, l, CI5, CI6, (vcu - 160) * NWAVES + wave, 96 * NWAVES, lds, wave, lane);
#endif

            }
            else if constexpr (p == 9) {
                pg8::Gemm g{(const pg8::bf16_t*)(a.ws + WS_H), (const pg8::bf16_t*)((char*)Wb + W_WO), M, D, D};
                pg8::StaticOrder S; S.init(M, D, G, bx, 5);
                pg8::EpiResidT<true, false, false, false> E{a.in[I_XP], a.in[I_XS], (pg8::bf16_t*)X, (float*)(a.ws + WS_XF), modf + (size_t)l * 3 * 9216 + 5 * 1024,
                                       CSb + (size_t)(cbp + 1) * 3 * 1024, (pg8::bf16_t*)(a.ws + WS_BR), (LAS float*)(lds + LRED_OFF)};

#ifndef NO_G2
pg8::gemm_phase<pg8::EpiResidT<true, false, false, false>, pg8::StaticOrder, PG8_ALIGN, PG8_SP2>(lds + RING_OFF, g, S, E, wv);
#endif
                if constexpr (true) { __syncthreads();
                    pg8::Unit u_; if (S.next(0, u_) && tid < 256) { const LAS float* lr = (const LAS float*)(lds + LRED_OFF) + tid; float s_ = 0.f;
#pragma unroll
                        for (int q = 0; q < 8; ++q) s_ += lr[q * 256];
                        ((float*)SSb)[((size_t)cbp * M + u_.pm * 256 + tid) * 4 + u_.pn] = s_; } }
                if (bx >= 160) conv_items(a, l, CI6, CI7, (bx - 160) * NWAVES + wave, 96 * NWAVES, lds, wave, lane);

            }
        }
}
#if MK_ONE_LAUNCH
#define SEAM() do { const KArgs* sp_ = (const KArgs*)__builtin_amdgcn_kernarg_segment_ptr(); asm volatile("" : "+s"(sp_)); \
    XcdBarrier b2; b2.bar = (unsigned*)((gu32*)(sp_->ws + WS_CTL) + CW_BAR); b2.x = xb_xcc_id(); b2.st = (volatile LAS unsigned*)(lds + MISC_OFF) + 8; xcd_barrier(b2, wv == 0 && hw_lane() == 0); } while (0)
#endif
__global__ void __launch_bounds__(NWAVES * 64, 2) hyb_fwd(Args args) {
    extern __shared__ __attribute__((aligned(16))) unsigned char lds_raw[];
    LAS unsigned char* lds = (LAS unsigned char*)lds_raw;
    volatile LAS unsigned* MISC = (volatile LAS unsigned*)(lds + MISC_OFF);
    gu32* ctl = (gu32*)(args.ws + WS_CTL);
    const int wv = __builtin_amdgcn_readfirstlane((int)threadIdx.x >> 6);
    for (int u = threadIdx.x; u < (LDS_BYTES - LDSCTL_OFF) / 4; u += NWAVES * 64) ((LAS unsigned*)(lds + LDSCTL_OFF))[u] = 0u;
    __syncthreads();
#if MK_ONE_LAUNCH
    (void)xcd_barrier_post((unsigned*)(ctl + CW_BAR), MISC + 8);
#endif
#if MK_ONE_LAUNCH
#ifdef DBL_BAR
#define RP(n) run_phase<n>(lds, wv); SEAM(); SEAM();
#else
#define RP(n) run_phase<n>(lds, wv); SEAM();
#endif
    RP(0) RP(1) RP(2) RP(3) RP(4) RP(5) RP(6) RP(7) RP(8) RP(9) RP(10) RP(11) RP(12) RP(13) RP(14) RP(15) RP(16) RP(17) RP(18) RP(19) RP(20) RP(21)
    run_phase<22>(lds, wv);
#undef RP
#else
    switch (args.ph_lo) {
#define RP(n) case n: run_phase<n>(lds, wv); break;
    RP(0) RP(1) RP(2) RP(3) RP(4) RP(5) RP(6) RP(7) RP(8) RP(9) RP(10) RP(11) RP(12) RP(13) RP(14) RP(15) RP(16) RP(17) RP(18) RP(19) RP(20) RP(21) RP(22)
#undef RP
    default: break;
    }
#endif
}

extern "C" void kernel_launch(void* const* d_in, const int* in_sizes, int n_in, void* d_out, int out_size, void* d_ws, size_t ws_size, hipStream_t stream) {
    static int grid = 0;
    if (grid == 0) {
        if (n_in != 32 || (size_t)out_size != O_END || ws_size < WS_END) { fprintf(stderr, "kernel_launch: unexpected problem (n_in %d, out %d, ws %zu); nothing launched\n", n_in, out_size, ws_size); grid = -1; return; }
        int dev = 0, cus = 0, per_cu = 0;
        if (hipGetDevice(&dev) != hipSuccess || hipDeviceGetAttribute(&cus, hipDeviceAttributeMultiprocessorCount, dev) != hipSuccess) { grid = -1; return; }
        if (hipFuncSetAttribute((const void*)hyb_fwd, hipFuncAttributeMaxDynamicSharedMemorySize, LDS_BYTES) != hipSuccess) { fprintf(stderr, "kernel_launch: hipFuncSetAttribute failed\n"); grid = -1; return; }
        if (hipOccupancyMaxActiveBlocksPerMultiprocessor(&per_cu, (const void*)hyb_fwd, NWAVES * 64, LDS_BYTES) != hipSuccess || per_cu < 1)
            fprintf(stderr, "kernel_launch: note: occupancy query reports %d workgroups per CU\n", per_cu);
        (void)hipGetLastError();
        grid = cus;
        if (grid != 256) { fprintf(stderr, "kernel_launch: built for a 256-CU device, found %d CUs; nothing launched\n", grid); grid = -1; return; }
    }
    if (grid < 0) return;
    if (hipMemsetAsync((char*)d_ws + WS_CTL, 0, CTL_ZERO_BYTES, stream) != hipSuccess) return;
    Args a{};
    for (int i = 0; i < 32; ++i) a.in[i] = (const float*)d_in[i];
    a.out = (float*)d_out; a.ws = (unsigned char*)d_ws;
#if MK_ONE_LAUNCH
    a.ph_lo = 0; a.ph_hi = NPHASE;
    hipLaunchKernelGGL(hyb_fwd, dim3(grid), dim3(NWAVES * 64), LDS_BYTES, stream, a);
#else
    for (int p = 0; p < NPHASE; ++p) { a.ph_lo = p; a.ph_hi = p + 1; hipLaunchKernelGGL(hyb_fwd, dim3(grid), dim3(NWAVES * 64), LDS_BYTES, stream, a); }
#endif
#ifdef DIAG_MASK
    diag_scale<<<1024, 256, 0, stream>>>((float*)d_out, DIAG_MASK);
#endif
}
```
